# Optimizing an MI355X kernel written in HIP

```python
import jax, jax.numpy as jnp
from jax import lax
import numpy as np

D_MODEL = 1024
BATCH = 4
SEQ = 8192
DEPTH = 1

EPS = 1e-6
D_FF = 2816
Q_BLOCK = 128
NEG = -1e30
FORCE_SCORE = 1e4
NSA_HEADS = 8
NSA_KV_GROUPS = 2
NSA_HPG = NSA_HEADS // NSA_KV_GROUPS
NSA_DK = 64
NSA_DV = 64
CMP_LEN = 32
CMP_STRIDE = 16
CMP_HID = 256
SEL_LEN = 64
SEL_TOPK = 16
WINDOW = 512
MLA_HEADS = 8
MLA_NOPE = 64
MLA_ROPE = 32
MLA_V = 64
MLA_Q_RANK = 256
MLA_KV_RANK = 128
ROPE_THETA = 10000.0
IN_SIZES = (NSA_HEADS * NSA_DK, 6 * NSA_KV_GROUPS * NSA_DK, 3 * NSA_HEADS, MLA_Q_RANK, MLA_KV_RANK, MLA_ROPE, 2 * D_MODEL)
D_IN = sum(IN_SIZES)

kernel_name = 'hybrid_nsa_mla_macaron_block'


def rms_norm(x, g):
    xf = x.astype(jnp.float32)
    y = xf * lax.rsqrt(jnp.mean(xf * xf, axis=-1, keepdims=True) + EPS)
    return (y * g.astype(jnp.float32)).astype(x.dtype)


def swiglu(x, w_gate, w_up, w_down):
    return (jax.nn.silu(x @ w_gate) * (x @ w_up)) @ w_down


def masked_softmax(s, mask):
    s = jnp.where(mask, s, NEG)
    m = jnp.max(s, axis=-1, keepdims=True)
    e = jnp.exp(s - m) * mask
    return e / jnp.maximum(jnp.sum(e, axis=-1, keepdims=True), 1e-30)


def alibi_slopes(n):
    return (2.0 ** (-8.0 * np.arange(1, n + 1, dtype=np.float32) / n)).astype(np.float32)


def apply_rope(x, pos):
    half = x.shape[-1] // 2
    freqs = jnp.asarray(ROPE_THETA ** (-np.arange(half, dtype=np.float32) / half), jnp.float32)
    ang = pos.astype(jnp.float32)[:, None] * freqs[None, :]
    cos = jnp.cos(ang)[None, :, None, :]
    sin = jnp.sin(ang)[None, :, None, :]
    xf = x.astype(jnp.float32)
    x1, x2 = xf[..., :half], xf[..., half:]
    return jnp.concatenate([x1 * cos - x2 * sin, x1 * sin + x2 * cos], axis=-1).astype(x.dtype)


def nsa_compress(kv, pos_emb, w1, w2):
    b, s, g, d = kv.shape
    n_c = (s - CMP_LEN) // CMP_STRIDE + 1
    idx = np.arange(n_c)[:, None] * CMP_STRIDE + np.arange(CMP_LEN)[None, :]
    blocks = kv[:, idx] + pos_emb[None, None, :, None, :]
    blocks = blocks.transpose(0, 1, 3, 2, 4).reshape(b, n_c, g, CMP_LEN * d)
    return jax.nn.gelu(blocks @ w1) @ w2


def nsa_attention(q, k_cmp, v_cmp, k_slc, v_slc, k_win, v_win, branch_gates,
                  cmp_pos_k, cmp_w1_k, cmp_w2_k, cmp_pos_v, cmp_w1_v, cmp_w2_v):
    b, s, h, d = q.shape
    g, hg = NSA_KV_GROUPS, NSA_HPG
    n_c = (s - CMP_LEN) // CMP_STRIDE + 1
    n_sel = s // SEL_LEN
    top_k = min(SEL_TOPK, n_sel)
    n_tok = top_k * SEL_LEN
    kc = nsa_compress(k_cmp, cmp_pos_k, cmp_w1_k, cmp_w2_k)
    vc = nsa_compress(v_cmp, cmp_pos_v, cmp_w1_v, cmp_w2_v)
    cmp_end = jnp.asarray(np.arange(n_c) * CMP_STRIDE + CMP_LEN - 1, jnp.int32)
    c0 = np.arange(n_c) * CMP_STRIDE
    s0 = np.arange(n_sel) * SEL_LEN
    overlap = np.clip(np.minimum(c0[:, None] + CMP_LEN, s0[None, :] + SEL_LEN)
                      - np.maximum(c0[:, None], s0[None, :]), 0, None)
    overlap = jnp.asarray(overlap / CMP_LEN, jnp.float32)
    ks_blocks = k_slc.reshape(b, n_sel, SEL_LEN, g, d).transpose(0, 3, 1, 2, 4)
    vs_blocks = v_slc.reshape(b, n_sel, SEL_LEN, g, NSA_DV).transpose(0, 3, 1, 2, 4)
    kw = jnp.pad(k_win, ((0, 0), (WINDOW, 0), (0, 0), (0, 0)))
    vw = jnp.pad(v_win, ((0, 0), (WINDOW, 0), (0, 0), (0, 0)))
    qg = (q * NSA_DK ** -0.5).reshape(b, s, g, hg, d)
    gates = jax.nn.sigmoid(branch_gates.astype(jnp.float32)).reshape(b, s, g, hg, 3)
    slopes = jnp.asarray(alibi_slopes(h)).reshape(g, hg)[None, :, :, None, None]
    gather_blocks = jax.vmap(jax.vmap(lambda blk, ix: blk[ix]))
    sel_offsets = jnp.arange(SEL_LEN)
    blk_ids = jnp.arange(n_sel)
    win_offsets = jnp.arange(Q_BLOCK + WINDOW) - WINDOW

    def one_block(qi):
        q0 = qi * Q_BLOCK
        t = q0 + jnp.arange(Q_BLOCK)
        qb = lax.dynamic_slice_in_dim(qg, q0, Q_BLOCK, axis=1)
        gb = lax.dynamic_slice_in_dim(gates, q0, Q_BLOCK, axis=1)
        dist_c = t[:, None] - cmp_end[None, :]
        s_c = jnp.einsum('btghd,bigd->bghti', qb, kc).astype(jnp.float32) - slopes * dist_c.astype(jnp.float32)
        p_c = masked_softmax(s_c, dist_c >= 0)
        o_c = jnp.einsum('bghti,bigd->btghd', p_c.astype(vc.dtype), vc)
        imp = jnp.einsum('bghti,ij->bgtj', p_c, overlap)
        cur = (t // SEL_LEN)[:, None]
        forced = (blk_ids[None, :] == 0) | (blk_ids[None, :] == cur) | (blk_ids[None, :] == cur - 1)
        imp = jnp.where(blk_ids[None, :] <= cur, jnp.where(forced, FORCE_SCORE, imp), NEG)
        _, sel = lax.top_k(imp, top_k)
        ksel = gather_blocks(ks_blocks, sel).reshape(b, g, Q_BLOCK, n_tok, d)
        vsel = gather_blocks(vs_blocks, sel).reshape(b, g, Q_BLOCK, n_tok, NSA_DV)
        pos_s = (sel[..., None] * SEL_LEN + sel_offsets).reshape(b, g, Q_BLOCK, n_tok)
        dist_s = (t[None, None, :, None] - pos_s)[:, :, None]
        s_s = jnp.einsum('btghd,bgtnd->bghtn', qb, ksel).astype(jnp.float32) - slopes * dist_s.astype(jnp.float32)
        p_s = masked_softmax(s_s, dist_s >= 0)
        o_s = jnp.einsum('bghtn,bgtnd->btghd', p_s.astype(vsel.dtype), vsel)
        kwb = lax.dynamic_slice_in_dim(kw, q0, Q_BLOCK + WINDOW, axis=1)
        vwb = lax.dynamic_slice_in_dim(vw, q0, Q_BLOCK + WINDOW, axis=1)
        pos_w = q0 + win_offsets
        dist_w = t[:, None] - pos_w[None, :]
        mask_w = (dist_w >= 0) & (dist_w < WINDOW) & (pos_w[None, :] >= 0)
        s_w = jnp.einsum('btghd,bsgd->bghts', qb, kwb).astype(jnp.float32) - slopes * dist_w.astype(jnp.float32)
        p_w = masked_softmax(s_w, mask_w)
        o_w = jnp.einsum('bghts,bsgd->btghd', p_w.astype(vwb.dtype), vwb)
        o = gb[..., 0:1] * o_c + gb[..., 1:2] * o_s + gb[..., 2:3] * o_w
        return o.astype(q.dtype).reshape(b, Q_BLOCK, h * NSA_DV)

    out = lax.map(one_block, jnp.arange(s // Q_BLOCK))
    return out.transpose(1, 0, 2, 3).reshape(b, s, h * NSA_DV)


def mla_attention(c_q, c_kv, k_pe, q_norm_g, w_uq, kv_norm_g, w_ukv):
    b, s, _ = c_q.shape
    h = MLA_HEADS
    pos = jnp.arange(s)
    q = (rms_norm(c_q, q_norm_g) @ w_uq).reshape(b, s, h, MLA_NOPE + MLA_ROPE)
    kv = (rms_norm(c_kv, kv_norm_g) @ w_ukv).reshape(b, s, h, MLA_NOPE + MLA_V)
    q_pe = apply_rope(q[..., MLA_NOPE:], pos)
    k_rot = apply_rope(k_pe[:, :, None, :], pos)
    qf = jnp.concatenate([q[..., :MLA_NOPE], q_pe], axis=-1) * (MLA_NOPE + MLA_ROPE) ** -0.5
    k = jnp.concatenate([kv[..., :MLA_NOPE], jnp.broadcast_to(k_rot, (b, s, h, MLA_ROPE))], axis=-1)
    v = kv[..., MLA_NOPE:]

    def one_block(qi):
        q0 = qi * Q_BLOCK
        t = q0 + jnp.arange(Q_BLOCK)
        qb = lax.dynamic_slice_in_dim(qf, q0, Q_BLOCK, axis=1)
        sc = jnp.einsum('bthd,bshd->bhts', qb, k).astype(jnp.float32)
        sc = jnp.where(pos[None, :] <= t[:, None], sc, NEG)
        p = jax.nn.softmax(sc, axis=-1)
        o = jnp.einsum('bhts,bshd->bthd', p.astype(v.dtype), v)
        return o.reshape(b, Q_BLOCK, h * MLA_V)

    out = lax.map(one_block, jnp.arange(s // Q_BLOCK))
    return out.transpose(1, 0, 2, 3).reshape(b, s, h * MLA_V)


def setup_inputs(seed: int = 0) -> dict:
    key = jax.random.key(seed)
    ks = jax.random.split(key, 32)

    def dense(k, shape, fan_in):
        return jax.random.normal(k, shape, jnp.float32) * fan_in ** -0.5

    def gain(k, n):
        return 1.0 + 0.05 * jax.random.normal(k, (n,), jnp.float32)

    d_nsa = NSA_HEADS * NSA_DV
    d_mla = MLA_HEADS * MLA_V
    return {
        'x': jax.random.normal(ks[0], (BATCH, SEQ, D_MODEL), jnp.float32),
        'ff1_pre_g': gain(ks[1], D_MODEL),
        'ff1_post_g': gain(ks[2], D_MODEL),
        'ff1_w_gate': dense(ks[3], (D_MODEL, D_FF), D_MODEL),
        'ff1_w_up': dense(ks[4], (D_MODEL, D_FF), D_MODEL),
        'ff1_w_down': dense(ks[5], (D_FF, D_MODEL), D_FF),
        'mix_pre_g': gain(ks[6], D_MODEL),
        'mix_post_g': gain(ks[7], D_MODEL),
        'w_in': dense(ks[8], (D_MODEL, D_IN), D_MODEL),
        'cmp_pos_k': 0.1 * jax.random.normal(ks[9], (CMP_LEN, NSA_DK), jnp.float32),
        'cmp_w1_k': dense(ks[10], (CMP_LEN * NSA_DK, CMP_HID), CMP_LEN * NSA_DK),
        'cmp_w2_k': dense(ks[11], (CMP_HID, NSA_DK), CMP_HID),
        'cmp_pos_v': 0.1 * jax.random.normal(ks[12], (CMP_LEN, NSA_DV), jnp.float32),
        'cmp_w1_v': dense(ks[13], (CMP_LEN * NSA_DV, CMP_HID), CMP_LEN * NSA_DV),
        'cmp_w2_v': dense(ks[14], (CMP_HID, NSA_DV), CMP_HID),
        'mla_q_norm_g': gain(ks[15], MLA_Q_RANK),
        'mla_w_uq': dense(ks[16], (MLA_Q_RANK, MLA_HEADS * (MLA_NOPE + MLA_ROPE)), MLA_Q_RANK),
        'mla_kv_norm_g': gain(ks[17], MLA_KV_RANK),
        'mla_w_ukv': dense(ks[18], (MLA_KV_RANK, MLA_HEADS * (MLA_NOPE + MLA_V)), MLA_KV_RANK),
        'w_proj_nsa': dense(ks[19], (d_nsa, D_MODEL), d_nsa),
        'w_proj_mla': dense(ks[20], (d_mla, D_MODEL), d_mla),
        'w_out': dense(ks[21], (D_MODEL, D_MODEL), D_MODEL),
        'ff2_pre_g': gain(ks[22], D_MODEL),
        'ff2_post_g': gain(ks[23], D_MODEL),
        'ff2_w_gate': dense(ks[24], (D_MODEL, D_FF), D_MODEL),
        'ff2_w_up': dense(ks[25], (D_MODEL, D_FF), D_MODEL),
        'ff2_w_down': dense(ks[26], (D_FF, D_MODEL), D_FF),
    }


def reference(x, ff1_pre_g, ff1_post_g, ff1_w_gate, ff1_w_up, ff1_w_down, mix_pre_g, mix_post_g, w_in,
              cmp_pos_k, cmp_w1_k, cmp_w2_k, cmp_pos_v, cmp_w1_v, cmp_w2_v,
              mla_q_norm_g, mla_w_uq, mla_kv_norm_g, mla_w_ukv, w_proj_nsa, w_proj_mla, w_out,
              ff2_pre_g, ff2_post_g, ff2_w_gate, ff2_w_up, ff2_w_down):
    b, s, _ = x.shape
    split_at = [int(v) for v in np.cumsum(IN_SIZES)[:-1]]
    for _layer in range(DEPTH):
        x = x + 0.5 * rms_norm(swiglu(rms_norm(x, ff1_pre_g), ff1_w_gate, ff1_w_up, ff1_w_down), ff1_post_g)
        hmix = rms_norm(x, mix_pre_g)
        z = hmix @ w_in
        q_nsa, kv_nsa, g_nsa, c_q, c_kv, k_pe, g_merge = jnp.split(z, split_at, axis=-1)
        q_nsa = q_nsa.reshape(b, s, NSA_HEADS, NSA_DK)
        kv_nsa = kv_nsa.reshape(b, s, 6, NSA_KV_GROUPS, NSA_DK)
        g_nsa = g_nsa.reshape(b, s, NSA_HEADS, 3)
        y_nsa = nsa_attention(q_nsa, kv_nsa[:, :, 0], kv_nsa[:, :, 1], kv_nsa[:, :, 2], kv_nsa[:, :, 3],
                              kv_nsa[:, :, 4], kv_nsa[:, :, 5], g_nsa,
                              cmp_pos_k, cmp_w1_k, cmp_w2_k, cmp_pos_v, cmp_w1_v, cmp_w2_v)
        y_mla = mla_attention(c_q, c_kv, k_pe, mla_q_norm_g, mla_w_uq, mla_kv_norm_g, mla_w_ukv)
        gate_a, gate_b = jnp.split(jax.nn.sigmoid(g_merge.astype(jnp.float32)), 2, axis=-1)
        merged = (gate_a * (y_nsa @ w_proj_nsa) + gate_b * (y_mla @ w_proj_mla)).astype(x.dtype)
        x = x + rms_norm(merged @ w_out, mix_post_g)
        x = x + 0.5 * rms_norm(swiglu(rms_norm(x, ff2_pre_g), ff2_w_gate, ff2_w_up, ff2_w_down), ff2_post_g)
    return x
```

```cpp
#include <hip/hip_runtime.h>
#include <hip/hip_cooperative_groups.h>
#include <cstdio>
#include <cstdint>
namespace cg = cooperative_groups;
namespace pg8 {
#define PG8_LAS __attribute__((address_space(3)))
typedef unsigned short bf16_t;
typedef short bf16x8 __attribute__((ext_vector_type(8)));
typedef float f32x4 __attribute__((ext_vector_type(4)));
typedef unsigned u32x4 __attribute__((ext_vector_type(4)));
constexpr int BM = 256, BK = 64, HALF = 128, HTB = HALF * BK * 2  , STAGE_BYTES = 8 * HTB, NXCD = 8, WGM = 8;

__host__ __device__ __forceinline__ int lds_byte(int r, int c) { const int st = (r >> 4) * 2 + (c >> 5), rr = r & 15, cc = c & 31, ob = rr * 64 + cc * 2; return st * 1024 + (ob ^ (((ob >> 9) & 1) << 5)); }
__host__ __device__ __forceinline__ void stage_rc(int b, int& R, int& C) { const int st = b / 1024, sb = b % 1024, swz = sb ^ (((sb >> 9) & 1) << 5); R = (st >> 1) * 16 + swz / 64; C = (st & 1) * 32 + (swz % 64) / 2; }
__host__ __device__ __forceinline__ int perm32(int rho) { const int n = rho >> 4, i = rho & 15; return 8 * (i >> 2) + 4 * n + (i & 3); }

struct Unit { int pm, pn; };
struct Gemm { const bf16_t* A; const bf16_t* Bt; int M, N, K; };

struct StaticOrder {
    int nM, nN, nwg, G, c;
    __host__ __device__ void init(int M, int N, int G_, int c_) { nM = M / BM; nN = N / BM; nwg = nM * nN; G = G_; c = c_; }
    __host__ __device__ bool next(int i, Unit& u) const {
        const long L = (long)i * G + c; if (L >= nwg) return false;
        int wgid = (int)L; { const int q = nwg / NXCD, r = nwg % NXCD, xcd = wgid % NXCD, off = wgid / NXCD; wgid = (xcd < r ? xcd * (q + 1) : r * (q + 1) + (xcd - r) * q) + off; }
        const int nig = WGM * nN, gid = wgid / nig, fm = gid * WGM, gsz = (nM - fm) < WGM ? (nM - fm) : WGM;
        u.pm = fm + ((wgid % nig) % gsz); u.pn = (wgid % nig) / gsz; return true;
    }
    __device__ __forceinline__ void a_ready(const Unit&) const {}
    __device__ __forceinline__ void done(const Unit&) const {}
};

__device__ __forceinline__ unsigned cvt_pk_bf16(float lo, float hi) { unsigned r; asm volatile("v_cvt_pk_bf16_f32 %0, %1, %2" : "=v"(r) : "v"(lo), "v"(hi)); return r; }
typedef float f32x2 __attribute__((ext_vector_type(2)));
template <class Epi, class Sched, bool ALIGN_EPI = false, bool SP2 = false>
__device__ __forceinline__ void gemm_phase(PG8_LAS unsigned char* lds, const Gemm g, const Sched& S, const Epi& E, const int wid, const int lane) {
    const int tid = wid * 64 + lane, wr = wid >> 2, wc = wid & 3, fr = lane & 15, fq = lane >> 4;
    const int K = g.K, nt = K / BK;
    unsigned voffA[2], voffB[2];
#pragma unroll
    for (int i = 0; i < 2; ++i) { int R, C; stage_rc(tid * 16 + i * 8192, R, C); const int Rb = Epi::PERM ? ((R & ~31) + perm32(R & 31)) : R;
        voffA[i] = (unsigned)(R * K + C) * 2u; voffB[i] = (unsigned)(Rb * K + C) * 2u; }
    const size_t kstep = (size_t)(BK * 2);
    const size_t hstep = (size_t)HALF * K * 2;
    const size_t tstep = 2 * hstep;
    const unsigned ldsw = (unsigned)wid * 1024u;
    const int aoff = lds_byte(wr * 64 + fr, fq * 8), boff = lds_byte(wc * 32 + fr, fq * 8);
#define PG8_SA(b, h) (((b) * 2 + (h)) * HTB)
#define PG8_SB(b, h) ((4 + (b) * 2 + (h)) * HTB)
#define PG8_STAGE(bufoff, gbase, voff) do { _Pragma("unroll") for (int _i = 0; _i < 2; ++_i) \
        __builtin_amdgcn_global_load_lds((const unsigned*)((const char*)(gbase) + (voff)[_i]), (PG8_LAS unsigned*)(lds + (bufoff) + ldsw + _i * 8192), 16, 0, 0); } while (0)
#define PG8_LDA(dst, b, h) do { _Pragma("unroll") for (int m = 0; m < 4; ++m) _Pragma("unroll") for (int k = 0; k < 2; ++k) dst[m][k] = *(const PG8_LAS bf16x8*)(lds + PG8_SA(b, h) + aoff + m * 2048 + k * 1024); } while (0)
#define PG8_LDB(dst, b, h) do { _Pragma("unroll") for (int n = 0; n < 2; ++n) _Pragma("unroll") for (int k = 0; k < 2; ++k) dst[n][k] = *(const PG8_LAS bf16x8*)(lds + PG8_SB(b, h) + boff + n * 2048 + k * 1024); } while (0)
#define PG8_MMA(ai, bj, At, Bt) do { __builtin_amdgcn_s_setprio(1); _Pragma("unroll") for (int m = 0; m < 4; ++m) _Pragma("unroll") for (int n = 0; n < 2; ++n) _Pragma("unroll") for (int k = 0; k < 2; ++k) \
        acc[ai][bj][m][n] = __builtin_amdgcn_mfma_f32_16x16x32_bf16(Bt[n][k], At[m][k], acc[ai][bj][m][n], 0, 0, 0); __builtin_amdgcn_s_setprio(0); } while (0)
#define PG8_WAIT_V(n) asm volatile("s_waitcnt vmcnt(" #n ")" ::: "memory")
#define PG8_WAIT_L(n) asm volatile("s_waitcnt lgkmcnt(" #n ")" ::: "memory")
#define PG8_BAR __builtin_amdgcn_s_barrier()
#define PG8_SCHED __builtin_amdgcn_sched_barrier(0)
    Unit cur, nxt; int ui = 0;
    if (!S.next(0, cur)) return;
    f32x4 acc[2][2][4][2];
#pragma unroll
    for (int a = 0; a < 2; ++a)
#pragma unroll
        for (int b = 0; b < 2; ++b)
#pragma unroll
            for (int m = 0; m < 4; ++m)
#pragma unroll
                for (int n = 0; n < 2; ++n) acc[a][b][m][n] = (f32x4){0.f, 0.f, 0.f, 0.f};
    bf16x8 At[4][2], B0[2][2], B1[2][2];
    const char* cA = (const char*)g.A + (size_t)cur.pm * tstep; const char* cB = (const char*)g.Bt + (size_t)cur.pn * tstep;
    S.a_ready(cur);
    if constexpr (SP2) {
        PG8_STAGE(PG8_SB(0, 0), cB, voffB); PG8_STAGE(PG8_SB(0, 1), cB + hstep, voffB); PG8_STAGE(PG8_SA(0, 0), cA, voffA); PG8_STAGE(PG8_SA(0, 1), cA + hstep, voffA);
        if (wr == 1) PG8_BAR;
        PG8_WAIT_V(2); PG8_BAR;
        PG8_STAGE(PG8_SB(1, 0), cB + kstep, voffB); PG8_STAGE(PG8_SA(1, 0), cA + kstep, voffA); PG8_STAGE(PG8_SB(1, 1), cB + hstep + kstep, voffB);
        PG8_WAIT_V(6); PG8_BAR;
    } else {
        PG8_STAGE(PG8_SB(0, 0), cB, voffB); PG8_STAGE(PG8_SA(0, 0), cA, voffA); PG8_STAGE(PG8_SB(0, 1), cB + hstep, voffB); PG8_STAGE(PG8_SA(0, 1), cA + hstep, voffA);
        if (wr == 1) PG8_BAR;
        PG8_WAIT_V(4); PG8_BAR;
        PG8_STAGE(PG8_SB(1, 0), cB + kstep, voffB); PG8_STAGE(PG8_SA(1, 0), cA + kstep, voffA); PG8_STAGE(PG8_SB(1, 1), cB + hstep + kstep, voffB);
        PG8_WAIT_V(6); PG8_BAR;
    }
    for (;;) {
        const bool has_next = S.next(ui + 1, nxt);
        const char* nA = has_next ? (const char*)g.A + (size_t)nxt.pm * tstep : cA; const char* nB = has_next ? (const char*)g.Bt + (size_t)nxt.pn * tstep : cB;
        for (int t = 0; t < nt; t += 2) {
            const bool last = (t == nt - 2);
            const char* a1 = cA + (size_t)(t + 1) * kstep;
            const char* a2 = last ? nA : cA + (size_t)(t + 2) * kstep; const char* b2 = last ? nB : cB + (size_t)(t + 2) * kstep;
            const char* a3 = a2 + kstep; const char* b3 = b2 + kstep;
            if (last && has_next) S.a_ready(nxt);
            if constexpr (SP2) {
            PG8_LDB(B0, 0, 0); PG8_LDB(B1, 0, 1); PG8_SCHED; PG8_LDA(At, 0, 0); PG8_STAGE(PG8_SA(1, 1), a1 + hstep, voffA);
            PG8_WAIT_V(8); PG8_WAIT_L(0); PG8_BAR; PG8_MMA(0, 0, At, B0); PG8_MMA(0, 1, At, B1); PG8_BAR; PG8_SCHED;
            PG8_LDA(At, 0, 1); PG8_STAGE(PG8_SB(0, 0), b2, voffB); PG8_STAGE(PG8_SB(0, 1), b2 + hstep, voffB); PG8_STAGE(PG8_SA(0, 0), a2, voffA);
            PG8_WAIT_V(8); PG8_WAIT_L(0); PG8_BAR; PG8_MMA(1, 0, At, B0); PG8_MMA(1, 1, At, B1); PG8_BAR; PG8_SCHED;
            PG8_LDB(B0, 1, 0); PG8_LDB(B1, 1, 1); PG8_SCHED; PG8_LDA(At, 1, 0); PG8_STAGE(PG8_SA(0, 1), a2 + hstep, voffA);
            PG8_WAIT_V(8); PG8_WAIT_L(0); PG8_BAR; PG8_MMA(0, 0, At, B0); PG8_MMA(0, 1, At, B1); PG8_BAR; PG8_SCHED;
            PG8_LDA(At, 1, 1); PG8_STAGE(PG8_SB(1, 0), b3, voffB); PG8_STAGE(PG8_SB(1, 1), b3 + hstep, voffB); PG8_STAGE(PG8_SA(1, 0), a3, voffA);
            PG8_WAIT_V(8); PG8_WAIT_L(0); PG8_BAR; PG8_MMA(1, 0, At, B0); PG8_MMA(1, 1, At, B1); PG8_BAR; PG8_SCHED;
            } else {
            PG8_LDB(B0, 0, 0); PG8_SCHED; PG8_LDA(At, 0, 0); PG8_STAGE(PG8_SA(1, 1), a1 + hstep, voffA);
            PG8_WAIT_L(8); PG8_BAR; PG8_WAIT_L(0); PG8_MMA(0, 0, At, B0); PG8_BAR; PG8_SCHED;
            PG8_LDB(B1, 0, 1); PG8_STAGE(PG8_SB(0, 0), b2, voffB);
            PG8_BAR; PG8_WAIT_L(0); PG8_MMA(0, 1, At, B1); PG8_BAR;
            PG8_LDA(At, 0, 1); PG8_STAGE(PG8_SA(0, 0), a2, voffA);
            PG8_BAR; PG8_WAIT_L(0); PG8_MMA(1, 0, At, B0); PG8_BAR; PG8_SCHED;
            PG8_STAGE(PG8_SB(0, 1), b2 + hstep, voffB);
            PG8_WAIT_V(6); PG8_BAR; PG8_MMA(1, 1, At, B1); PG8_BAR;
            PG8_LDB(B0, 1, 0); PG8_SCHED; PG8_LDA(At, 1, 0); PG8_STAGE(PG8_SA(0, 1), a2 + hstep, voffA);
            PG8_WAIT_L(8); PG8_BAR; PG8_WAIT_L(0); PG8_MMA(0, 0, At, B0); PG8_BAR; PG8_SCHED;
            PG8_LDB(B1, 1, 1); PG8_STAGE(PG8_SB(1, 0), b3, voffB);
            PG8_BAR; PG8_WAIT_L(0); PG8_MMA(0, 1, At, B1); PG8_BAR;
            PG8_LDA(At, 1, 1); PG8_STAGE(PG8_SA(1, 0), a3, voffA);
            PG8_BAR; PG8_WAIT_L(0); PG8_MMA(1, 0, At, B0); PG8_BAR; PG8_SCHED;
            PG8_STAGE(PG8_SB(1, 1), b3 + hstep, voffB);
            PG8_WAIT_V(6); PG8_BAR; PG8_MMA(1, 1, At, B1); PG8_BAR;
            }
        }
        if constexpr (ALIGN_EPI) { if (wr == 0) PG8_BAR; }
        if constexpr (!Epi::AFTER_DRAIN) { E(acc, cur, wr, wc, fr, fq); S.done(cur); }
        if (!has_next) break;
#pragma unroll
        for (int a = 0; a < 2; ++a)
#pragma unroll
            for (int b = 0; b < 2; ++b)
#pragma unroll
                for (int m = 0; m < 4; ++m)
#pragma unroll
                    for (int n = 0; n < 2; ++n) acc[a][b][m][n] = (f32x4){0.f, 0.f, 0.f, 0.f};
        cur = nxt; cA = nA; cB = nB; ++ui;
        if constexpr (ALIGN_EPI) { if (wr == 1) PG8_BAR; }
    }
    PG8_WAIT_V(0);
    if constexpr (!ALIGN_EPI) { if (wr == 0) PG8_BAR; }
    PG8_BAR;
    if constexpr (Epi::AFTER_DRAIN) { E.fused(acc, cur, wr, wc, fr, fq, lds, wid, lane); S.done(cur); }
#undef PG8_SA
#undef PG8_SB
#undef PG8_STAGE
#undef PG8_LDA
#undef PG8_LDB
#undef PG8_MMA
#undef PG8_WAIT_V
#undef PG8_WAIT_L
#undef PG8_BAR
#undef PG8_SCHED
}
}

#ifndef PG8_SP2
#define PG8_SP2 true
#endif
#ifndef MK_PER_PHASE
#define MK_PER_PHASE 0
#endif

namespace mk {
using pg8::bf16x8; using pg8::f32x4; using pg8::u32x4; using pg8::Unit; using pg8::Gemm; using pg8::StaticOrder;
typedef unsigned short bf16;
typedef float f32x16 __attribute__((ext_vector_type(16)));
typedef unsigned u32x2 __attribute__((ext_vector_type(2)));
typedef float f32x2_t __attribute__((ext_vector_type(2)));
typedef __bf16 bf16x2_t __attribute__((ext_vector_type(2)));
#define LAS __attribute__((address_space(3)))
#define LDS_WAIT() asm volatile("s_waitcnt lgkmcnt(0)" ::: "memory")

constexpr int NB = 4, SEQ = 8192, DM = 1024, MTOK = NB * SEQ, DFF = 2816;
constexpr float EPS = 1e-6f, NEGF = -1e30f;
constexpr int NPHASE = 15;
constexpr int NWAVES = 8;
constexpr size_t MiB = 1u << 20;
constexpr size_t SZ_WGU = (size_t)5632 * 1024 * 2, SZ_WD = (size_t)1024 * 2816 * 2, SZ_WIN = (size_t)3840 * 1024 * 2;
constexpr size_t O_WGU1 = 0, O_WD1 = O_WGU1 + SZ_WGU, O_WGU2 = O_WD1 + SZ_WD, O_WD2 = O_WGU2 + SZ_WGU, O_WIN = O_WD2 + SZ_WD,
                 O_WPN = O_WIN + SZ_WIN, O_WPM = O_WPN + MiB, O_WOUT = O_WPM + MiB, O_WUQ = O_WOUT + 2 * MiB, O_WUKV = O_WUQ + 768 * 256 * 2,
                 O_CW1K = O_WUKV + 1024 * 128 * 2, O_CW1V = O_CW1K + MiB, O_WEND = O_CW1V + MiB;
static_assert(O_WEND <= 48 * MiB - 4096, "weights");
constexpr size_t O_CTL = 48 * MiB - 4096;
constexpr size_t O_A1 = 48 * MiB;
constexpr size_t O_IM2K = 48 * MiB, O_IM2V = 64 * MiB, O_CQN = 80 * MiB, O_CKVN = 96 * MiB, O_KR = 104 * MiB, O_HK = 106 * MiB, O_HV = 108 * MiB,
                 O_KC = 110 * MiB, O_VCT = 110 * MiB + 512 * 1024;
constexpr size_t O_MG = 48 * MiB;
constexpr size_t O_H = 112 * MiB;
constexpr size_t O_Z1 = 112 * MiB, O_QN = 192 * MiB, O_YM = 224 * MiB, O_KM = 256 * MiB;
constexpr size_t O_F = 288 * MiB, O_GM = 288 * MiB;
constexpr size_t O_QM = 416 * MiB, O_VTM = 464 * MiB, O_VTS = 496 * MiB, O_VTW = 504 * MiB, O_END = 512 * MiB;
constexpr int Z1P = 1280;
constexpr int LDS_BYTES = 147456;
constexpr int L_KB = 0, KB_SZ = 13312, L_VB = 2 * KB_SZ, VB_SZ = 8704, L_IMP = L_VB + 2 * VB_SZ, IMP_P = 132, L_SELM = L_IMP + 64 * IMP_P * 4, L_WUN = L_SELM + 1024, L_ATT_END = L_WUN + 128;
static_assert(L_ATT_END <= 131072, "attention LDS");

__device__ __forceinline__ int mk_lane() { int l; asm volatile("v_mbcnt_lo_u32_b32 %0, -1, 0\n\tv_mbcnt_hi_u32_b32 %0, -1, %0" : "=v"(l)); return l; }
__device__ __forceinline__ void grid_barrier(unsigned* ctr, unsigned target, int tid) {
    asm volatile("s_waitcnt vmcnt(0)" ::: "memory");
    __syncthreads();
    if (tid == 0) {
        __builtin_amdgcn_fence(__ATOMIC_RELEASE, "agent");
        asm volatile("s_waitcnt vmcnt(0)" ::: "memory");
        __hip_atomic_fetch_add(ctr, 1u, __ATOMIC_RELAXED, __HIP_MEMORY_SCOPE_AGENT);
        while (__hip_atomic_load(ctr, __ATOMIC_RELAXED, __HIP_MEMORY_SCOPE_AGENT) < target) __builtin_amdgcn_s_sleep(2);
        __builtin_amdgcn_fence(__ATOMIC_ACQUIRE, "agent");
        asm volatile("s_waitcnt vmcnt(0)" ::: "memory");
    }
    __syncthreads();
}
__device__ __forceinline__ unsigned cvtpk(float lo, float hi) { f32x2_t v = {lo, hi}; bf16x2_t b = __builtin_convertvector(v, bf16x2_t); return __builtin_bit_cast(unsigned, b); }
__device__ __forceinline__ float bflo(unsigned w) { return __builtin_bit_cast(float, w << 16); }
__device__ __forceinline__ float bfhi(unsigned w) { return __builtin_bit_cast(float, w & 0xffff0000u); }
__device__ __forceinline__ float bf2f(bf16 b) { return __builtin_bit_cast(float, (unsigned)b << 16); }
__device__ __forceinline__ bf16 f2bf(float f) { return (bf16)(cvtpk(f, 0.f) & 0xffffu); }
__device__ __forceinline__ float wave_sum(float v) {
#pragma unroll
    for (int o = 1; o < 64; o <<= 1) v += __shfl_xor(v, o);
    return v;
}
__device__ __forceinline__ float sigmoidf(float x) { return 1.f / (1.f + __expf(-x)); }
__device__ __forceinline__ float gelu_tanh(float x) { const float u = 0.7978845608028654f * (x + 0.044715f * x * x * x); const float t = 1.f - 2.f / (__expf(2.f * u) + 1.f); return 0.5f * x * (1.f + t); }
__device__ __forceinline__ void rope_cs(int pos, int j, float& c, float& s) {
    const float freq = __builtin_amdgcn_exp2f(-(float)j * 0.8304820237218406f);
    const float ang = (float)pos * freq;
    double rev = (double)ang * 0.15915494309189535; rev -= __builtin_rint(rev);
    const float fr = (float)rev;
    s = __builtin_amdgcn_sinf(fr); c = __builtin_amdgcn_cosf(fr);
}

struct MapPlain { __device__ __forceinline__ int col(int r) const { return r; } __device__ __forceinline__ int drow(int r) const { return r; } };
struct MapGU { int sel; __device__ __forceinline__ int col(int r) const { return r; } __device__ __forceinline__ int drow(int r) const { return (r >> 7) * 256 + sel * 128 + (r & 127); } };
struct MapWin { __device__ __forceinline__ int drow(int r) const { return r; } __device__ __forceinline__ int col(int r) const {
    int col;
    if (r < 1280) col = r; else if (r < 1536) col = 1304 + (r - 1280); else if (r < 1664) col = 1560 + (r - 1536); else if (r < 1696) col = 1688 + (r - 1664);
    else if (r < 1720) col = 1280 + (r - 1696); else if (r < 1792) col = -1; else col = 1720 + (r - 1792);
    return col; } };
struct MapUkv { __device__ __forceinline__ int drow(int r) const { return r; } __device__ __forceinline__ int col(int r) const {
    if (r < 512) return (r >> 6) * 128 + (r & 63); const int rr = r - 512; return (rr >> 6) * 128 + 64 + (rr & 63); } };
template <class Map> __device__ __forceinline__ void transpose_mat(const float* W, int N, const Map mp, int K, int Nvirt, bf16* WT, LAS float* scr, int gw, int NGW, int lane) {
    const int nblk = Nvirt / 32, nitems = (K / 64) * nblk;
    for (int it = gw; it < nitems; it += NGW) {
        const int kb = it / nblk, nb = it % nblk, k0 = 64 * kb, n0 = 32 * nb;
        const int col = mp.col(n0 + (lane & 31));
#pragma unroll 8
        for (int i = 0; i < 32; ++i) { const int kk = 2 * i + (lane >> 5); scr[kk * 33 + (lane & 31)] = (col >= 0) ? W[(size_t)(k0 + kk) * N + col] : 0.f; }
        LDS_WAIT();
        const int c = lane & 7;
#pragma unroll
        for (int j = 0; j < 4; ++j) { const int n = (lane >> 3) + 8 * j; const LAS float* s = scr + (8 * c) * 33 + n;
            u32x4 o; o.x = cvtpk(s[0 * 33], s[1 * 33]); o.y = cvtpk(s[2 * 33], s[3 * 33]); o.z = cvtpk(s[4 * 33], s[5 * 33]); o.w = cvtpk(s[6 * 33], s[7 * 33]);
            *(u32x4*)(WT + (size_t)mp.drow(n0 + n) * K + k0 + 8 * c) = o; }
        LDS_WAIT();
    }
}

__device__ __forceinline__ void rms_row_to_bf16(const f32x4 (&v)[4], const float* gain, bf16* orow, int lane) {
    float ss = 0.f;
#pragma unroll
    for (int j = 0; j < 4; ++j) ss += (v[j].x * v[j].x + v[j].y * v[j].y) + (v[j].z * v[j].z + v[j].w * v[j].w);
    const float r = rsqrtf(wave_sum(ss) * (1.f / DM) + EPS);
#pragma unroll
    for (int j = 0; j < 4; ++j) { const f32x4 g = *(const f32x4*)(gain + 4 * (lane + 64 * j)); const f32x4 o = v[j] * r * g;
        u32x2 w; w.x = cvtpk(o.x, o.y); w.y = cvtpk(o.z, o.w); *(u32x2*)(orow + 4 * (lane + 64 * j)) = w; }
}
template <bool NEXT> __device__ __forceinline__ void rowop(const float* F, const float* base, float coef, const float* gpost, float* xout, const float* gnext, bf16* A1, int gw, int NGW, int lane) {
    for (int m = gw; m < MTOK; m += NGW) {
        const f32x4* fr = (const f32x4*)(F + (size_t)m * DM) + lane; const f32x4* br = (const f32x4*)(base + (size_t)m * DM) + lane;
        f32x4 v[4], bs[4]; float ss = 0.f;
#pragma unroll
        for (int j = 0; j < 4; ++j) { v[j] = fr[64 * j]; bs[j] = br[64 * j]; ss += (v[j].x * v[j].x + v[j].y * v[j].y) + (v[j].z * v[j].z + v[j].w * v[j].w); }
        const float r = rsqrtf(wave_sum(ss) * (1.f / DM) + EPS) * coef;
#pragma unroll
        for (int j = 0; j < 4; ++j) { const f32x4 g = *(const f32x4*)(gpost + 4 * (lane + 64 * j)); v[j] = bs[j] + v[j] * r * g; *((f32x4*)(xout + (size_t)m * DM) + lane + 64 * j) = v[j]; }
        if (NEXT) rms_row_to_bf16(v, gnext, A1 + (size_t)m * DM, lane);
    }
}

#define EPI_ROW(ai, m) ((size_t)u.pm * 256 + (ai) * 128 + wr * 64 + (m) * 16 + fr)
#define EPI_CIN(bj, n) ((bj) * 128 + wc * 32 + (n) * 16 + fq * 4)
struct EpiSwiglu { static constexpr bool PERM = false, AFTER_DRAIN = false; bf16* H;
    __device__ __forceinline__ void operator()(const f32x4 (&acc)[2][2][4][2], const Unit& u, int wr, int wc, int fr, int fq) const {
#pragma unroll
        for (int ai = 0; ai < 2; ++ai)
#pragma unroll
            for (int m = 0; m < 4; ++m) { bf16* rp = H + EPI_ROW(ai, m) * DFF + u.pn * 128 + wc * 32 + fq * 4;
#pragma unroll
                for (int n = 0; n < 2; ++n) { const f32x4 g = acc[ai][0][m][n], up = acc[ai][1][m][n]; float v[4];
#pragma unroll
                    for (int e = 0; e < 4; ++e) v[e] = g[e] / (1.f + __expf(-g[e])) * up[e];
                    u32x2 w; w.x = cvtpk(v[0], v[1]); w.y = cvtpk(v[2], v[3]); *(u32x2*)(rp + n * 16) = w; } }
    }
};
struct EpiF32 { static constexpr bool PERM = false, AFTER_DRAIN = false; float* F; int ldc;
    __device__ __forceinline__ void operator()(const f32x4 (&acc)[2][2][4][2], const Unit& u, int wr, int wc, int fr, int fq) const {
#pragma unroll
        for (int ai = 0; ai < 2; ++ai)
#pragma unroll
            for (int m = 0; m < 4; ++m) { float* rp = F + EPI_ROW(ai, m) * ldc + u.pn * 256;
#pragma unroll
                for (int bj = 0; bj < 2; ++bj)
#pragma unroll
                    for (int n = 0; n < 2; ++n) *(f32x4*)(rp + EPI_CIN(bj, n)) = acc[ai][bj][m][n]; }
    }
};
struct EpiWin { static constexpr bool PERM = false, AFTER_DRAIN = false; bf16* QN; bf16* Z1; bf16* GM; bf16* VTS; bf16* VTW;
    __device__ __forceinline__ void operator()(const f32x4 (&acc)[2][2][4][2], const Unit& u, int wr, int wc, int fr, int fq) const {
        const int pn = u.pn;
#pragma unroll
        for (int ai = 0; ai < 2; ++ai)
#pragma unroll
            for (int m = 0; m < 4; ++m) { const size_t row = EPI_ROW(ai, m);
#pragma unroll
                for (int bj = 0; bj < 2; ++bj)
#pragma unroll
                    for (int n = 0; n < 2; ++n) { const int cin = EPI_CIN(bj, n); f32x4 v = acc[ai][bj][m][n];
                        if ((pn == 3 || pn == 4) && bj == 1) {
                            bf16* vt = (pn == 3) ? VTS : VTW; const int b = (int)(row >> 13), s = (int)(row & 8191), cv = cin - 128;
#pragma unroll
                            for (int e = 0; e < 4; ++e) vt[((size_t)(b * 128 + cv + e)) * SEQ + s] = f2bf(v[e]);
                        } else {
                            bf16* dst;
                            if (pn < 2) { dst = QN + row * 512 + pn * 256 + cin; v = v * 0.125f; }
                            else if (pn < 7) dst = Z1 + row * Z1P + (pn - 2) * 256 + cin;
                            else dst = GM + row * 2048 + (pn - 7) * 256 + cin;
                            u32x2 w; w.x = cvtpk(v[0], v[1]); w.y = cvtpk(v[2], v[3]); *(u32x2*)dst = w;
                        } } }
    }
};
struct EpiGelu { static constexpr bool PERM = false, AFTER_DRAIN = false; bf16* O; int ldc;
    __device__ __forceinline__ void operator()(const f32x4 (&acc)[2][2][4][2], const Unit& u, int wr, int wc, int fr, int fq) const {
#pragma unroll
        for (int ai = 0; ai < 2; ++ai)
#pragma unroll
            for (int m = 0; m < 4; ++m) { bf16* rp = O + EPI_ROW(ai, m) * ldc + u.pn * 256;
#pragma unroll
                for (int bj = 0; bj < 2; ++bj)
#pragma unroll
                    for (int n = 0; n < 2; ++n) { const f32x4 v = acc[ai][bj][m][n];
                        u32x2 w; w.x = cvtpk(gelu_tanh(v[0]), gelu_tanh(v[1])); w.y = cvtpk(gelu_tanh(v[2]), gelu_tanh(v[3])); *(u32x2*)(rp + EPI_CIN(bj, n)) = w; } }
    }
};
struct EpiQup { static constexpr bool PERM = false, AFTER_DRAIN = false; bf16* QM;
    __device__ __forceinline__ void operator()(const f32x4 (&acc)[2][2][4][2], const Unit& u, int wr, int wc, int fr, int fq) const {
        const float sc = 0.10206207261596575f;
#pragma unroll
        for (int ai = 0; ai < 2; ++ai)
#pragma unroll
            for (int m = 0; m < 4; ++m) { bf16* rp = QM + EPI_ROW(ai, m) * 768 + u.pn * 256;
#pragma unroll
                for (int bj = 0; bj < 2; ++bj)
#pragma unroll
                    for (int n = 0; n < 2; ++n) { const f32x4 v = acc[ai][bj][m][n] * sc;
                        u32x2 w; w.x = cvtpk(v[0], v[1]); w.y = cvtpk(v[2], v[3]); *(u32x2*)(rp + EPI_CIN(bj, n)) = w; } }
    }
};
struct EpiKVup { static constexpr bool PERM = false, AFTER_DRAIN = false; bf16* KM; bf16* VTM;
    __device__ __forceinline__ void operator()(const f32x4 (&acc)[2][2][4][2], const Unit& u, int wr, int wc, int fr, int fq) const {
        const int pn = u.pn;
#pragma unroll
        for (int ai = 0; ai < 2; ++ai)
#pragma unroll
            for (int m = 0; m < 4; ++m) { const size_t row = EPI_ROW(ai, m);
#pragma unroll
                for (int bj = 0; bj < 2; ++bj)
#pragma unroll
                    for (int n = 0; n < 2; ++n) { const int cin = EPI_CIN(bj, n); const f32x4 v = acc[ai][bj][m][n];
                        if (pn < 2) { u32x2 w; w.x = cvtpk(v[0], v[1]); w.y = cvtpk(v[2], v[3]); *(u32x2*)(KM + row * 512 + pn * 256 + cin) = w; }
                        else { const int b = (int)(row >> 13), s = (int)(row & 8191), cv = (pn - 2) * 256 + cin;
#pragma unroll
                            for (int e = 0; e < 4; ++e) VTM[((size_t)(b * 512 + cv + e)) * SEQ + s] = f2bf(v[e]); } } }
    }
};
template <bool SECOND> struct EpiProj { static constexpr bool PERM = false, AFTER_DRAIN = false; const bf16* GM; bf16* MG;
    __device__ __forceinline__ void operator()(const f32x4 (&acc)[2][2][4][2], const Unit& u, int wr, int wc, int fr, int fq) const {
#pragma unroll
        for (int ai = 0; ai < 2; ++ai)
#pragma unroll
            for (int m = 0; m < 4; ++m) { const size_t row = EPI_ROW(ai, m);
#pragma unroll
                for (int bj = 0; bj < 2; ++bj)
#pragma unroll
                    for (int n = 0; n < 2; ++n) { const int col = u.pn * 256 + EPI_CIN(bj, n); const f32x4 v = acc[ai][bj][m][n];
                        const u32x2 gw = *(const u32x2*)(GM + row * 2048 + (SECOND ? 1024 : 0) + col);
                        float o0 = sigmoidf(bflo(gw.x)) * v[0], o1 = sigmoidf(bfhi(gw.x)) * v[1], o2 = sigmoidf(bflo(gw.y)) * v[2], o3 = sigmoidf(bfhi(gw.y)) * v[3];
                        bf16* dst = MG + row * DM + col;
                        if (SECOND) { const u32x2 pw = *(const u32x2*)dst; o0 += bflo(pw.x); o1 += bfhi(pw.x); o2 += bflo(pw.y); o3 += bfhi(pw.y); }
                        u32x2 w; w.x = cvtpk(o0, o1); w.y = cvtpk(o2, o3); *(u32x2*)dst = w; } }
    }
};

__device__ __forceinline__ int crow(int r, int hi) { return (r & 3) + 8 * (r >> 2) + 4 * hi; }
template <int ND0> __device__ __forceinline__ f32x16 qk_sub(const LAS char* Kt, int pitch, int sub, const bf16x8* qr, int r32, int hi) {
    f32x16 acc;
#pragma unroll
    for (int r = 0; r < 16; ++r) acc[r] = 0.f;
    const LAS char* kb = Kt + (sub * 32 + r32) * pitch + hi * 16;
#pragma unroll
    for (int d0 = 0; d0 < ND0; ++d0) { const bf16x8 kf = *(const LAS bf16x8*)(kb + d0 * 32); acc = __builtin_amdgcn_mfma_f32_32x32x16_bf16(kf, qr[d0], acc, 0, 0, 0); }
    return acc;
}
__device__ __forceinline__ void pv_sub(f32x16& o0, f32x16& o1, const LAS char* Vt, int sub, const f32x16& p, int r32, int hi) {
#pragma unroll
    for (int j = 0; j < 2; ++j) {
        u32x4 pw; pw.x = cvtpk(p[8 * j + 0], p[8 * j + 1]); pw.y = cvtpk(p[8 * j + 2], p[8 * j + 3]); pw.z = cvtpk(p[8 * j + 4], p[8 * j + 5]); pw.w = cvtpk(p[8 * j + 6], p[8 * j + 7]);
        const bf16x8 pb = __builtin_bit_cast(bf16x8, pw);
#pragma unroll
        for (int dblk = 0; dblk < 2; ++dblk) {
            const LAS char* vp = Vt + (32 * dblk + r32) * 136 + (32 * sub + 16 * j + 4 * hi) * 2;
            const u32x2 lo = *(const LAS u32x2*)vp, h2 = *(const LAS u32x2*)(vp + 16);
            u32x4 vw; vw.x = lo.x; vw.y = lo.y; vw.z = h2.x; vw.w = h2.y;
            const bf16x8 vf = __builtin_bit_cast(bf16x8, vw);
            if (dblk == 0) o0 = __builtin_amdgcn_mfma_f32_32x32x16_bf16(vf, pb, o0, 0, 0, 0); else o1 = __builtin_amdgcn_mfma_f32_32x32x16_bf16(vf, pb, o1, 0, 0, 0);
        }
    }
}
__device__ __forceinline__ void softmax_step(f32x16& s0, f32x16& s1, float& m, float& l, f32x16& o0, f32x16& o1) {
    float mx = fmaxf(s0[0], s1[0]);
#pragma unroll
    for (int r = 1; r < 16; ++r) mx = fmaxf(mx, fmaxf(s0[r], s1[r]));
    mx = fmaxf(mx, __shfl_xor(mx, 32));
    const float mn = fmaxf(m, mx), alpha = __expf(m - mn); m = mn;
    float sum = 0.f;
#pragma unroll
    for (int r = 0; r < 16; ++r) { const float p0 = s0[r] > -1e29f ? __expf(s0[r] - mn) : 0.f; const float p1 = s1[r] > -1e29f ? __expf(s1[r] - mn) : 0.f; s0[r] = p0; s1[r] = p1; sum += p0 + p1; }
    l = l * alpha + sum;
#pragma unroll
    for (int r = 0; r < 16; ++r) { o0[r] *= alpha; o1[r] *= alpha; }
}
__device__ __forceinline__ void zero16(f32x16& a) {
#pragma unroll
    for (int r = 0; r < 16; ++r) a[r] = 0.f;
}

__device__ __forceinline__ void mla_unit(int b, int h, int qb, const bf16* QM, const bf16* KM, const bf16* KR, const bf16* VTM, bf16* YM, LAS char* lds, const int wid, const int lane) {
    const int tid = wid * 64 + lane, r32 = lane & 31, hi = lane >> 5;
    const int q0 = qb * 256 + wid * 32, t = q0 + r32;
    const size_t rowq = (size_t)b * SEQ + t;
    bf16x8 qr[6];
#pragma unroll
    for (int d0 = 0; d0 < 6; ++d0) qr[d0] = *(const bf16x8*)(QM + rowq * 768 + h * 96 + d0 * 16 + hi * 8);
    {
        u32x4 a = __builtin_bit_cast(u32x4, qr[4]), bb = __builtin_bit_cast(u32x4, qr[5]);
        float x1[8] = {bflo(a.x), bfhi(a.x), bflo(a.y), bfhi(a.y), bflo(a.z), bfhi(a.z), bflo(a.w), bfhi(a.w)};
        float x2[8] = {bflo(bb.x), bfhi(bb.x), bflo(bb.y), bfhi(bb.y), bflo(bb.z), bfhi(bb.z), bflo(bb.w), bfhi(bb.w)};
#pragma unroll
        for (int e = 0; e < 8; ++e) { float cs, sn; rope_cs(t, 8 * hi + e, cs, sn); const float y1 = x1[e] * cs - x2[e] * sn, y2 = x1[e] * sn + x2[e] * cs; x1[e] = y1; x2[e] = y2; }
        a.x = cvtpk(x1[0], x1[1]); a.y = cvtpk(x1[2], x1[3]); a.z = cvtpk(x1[4], x1[5]); a.w = cvtpk(x1[6], x1[7]);
        bb.x = cvtpk(x2[0], x2[1]); bb.y = cvtpk(x2[2], x2[3]); bb.z = cvtpk(x2[4], x2[5]); bb.w = cvtpk(x2[6], x2[7]);
        qr[4] = __builtin_bit_cast(bf16x8, a); qr[5] = __builtin_bit_cast(bf16x8, bb);
    }
    float m = NEGF, l = 0.f; f32x16 o0, o1; zero16(o0); zero16(o1);
    const int NT = (qb + 1) * 4;
    const bf16* ksrc = KM + ((size_t)b * SEQ + (tid >> 3)) * 512 + h * 64 + (tid & 7) * 8;
    const bf16* rsrc = KR + ((size_t)b * SEQ + ((tid & 255) >> 2)) * 32 + (tid & 3) * 8;
    const bf16* vsrc = VTM + ((size_t)(b * 8 + h) * 64 + (tid >> 3)) * SEQ + (tid & 7) * 8;
    const int kdst = (tid >> 3) * 208 + (tid & 7) * 16, rdst = ((tid & 255) >> 2) * 208 + 128 + (tid & 3) * 16, vdst = (tid >> 3) * 136 + (tid & 7) * 16;
    u32x4 sk, sr, sv;
#define MLA_LOAD(it) do { sk = *(const u32x4*)(ksrc + (size_t)(it) * 64 * 512); if (tid < 256) sr = *(const u32x4*)(rsrc + (size_t)(it) * 64 * 32); sv = *(const u32x4*)(vsrc + (it) * 64); } while (0)
#define MLA_STORE(buf) do { *(LAS u32x4*)(lds + L_KB + (buf) * KB_SZ + kdst) = sk; if (tid < 256) *(LAS u32x4*)(lds + L_KB + (buf) * KB_SZ + rdst) = sr; \
        LAS char* vp_ = lds + L_VB + (buf) * VB_SZ + vdst; u32x2 a_; a_.x = sv.x; a_.y = sv.y; *(LAS u32x2*)vp_ = a_; a_.x = sv.z; a_.y = sv.w; *(LAS u32x2*)(vp_ + 8) = a_; } while (0)
    sr = (u32x4){0u, 0u, 0u, 0u};
    MLA_LOAD(0); MLA_STORE(0); __syncthreads();
    for (int it = 0; it < NT; ++it) {
        const bool more = it + 1 < NT;
        if (more) MLA_LOAD(it + 1);
        const int kv0 = it * 64;
        if (kv0 <= q0 + 31) {
            const LAS char* Kb = lds + L_KB + (it & 1) * KB_SZ; const LAS char* Vb = lds + L_VB + (it & 1) * VB_SZ;
            f32x16 s0 = qk_sub<6>(Kb, 208, 0, qr, r32, hi), s1 = qk_sub<6>(Kb, 208, 1, qr, r32, hi);
            if (kv0 + 63 > q0) {
#pragma unroll
                for (int r = 0; r < 16; ++r) { const int kp = kv0 + crow(r, hi); if (kp > t) s0[r] = NEGF; if (kp + 32 > t) s1[r] = NEGF; }
            }
            softmax_step(s0, s1, m, l, o0, o1);
            pv_sub(o0, o1, Vb, 0, s0, r32, hi); pv_sub(o0, o1, Vb, 1, s1, r32, hi);
        }
        if (more) MLA_STORE((it + 1) & 1);
        __syncthreads();
    }
#undef MLA_LOAD
#undef MLA_STORE
    l += __shfl_xor(l, 32);
    const float inv = 1.f / l;
    bf16* orow = YM + rowq * 512 + h * 64 + 4 * hi;
#pragma unroll
    for (int a = 0; a < 4; ++a) {
        u32x2 w; w.x = cvtpk(o0[4 * a] * inv, o0[4 * a + 1] * inv); w.y = cvtpk(o0[4 * a + 2] * inv, o0[4 * a + 3] * inv); *(u32x2*)(orow + 8 * a) = w;
        w.x = cvtpk(o1[4 * a] * inv, o1[4 * a + 1] * inv); w.y = cvtpk(o1[4 * a + 2] * inv, o1[4 * a + 3] * inv); *(u32x2*)(orow + 32 + 8 * a) = w;
    }
}

__device__ __forceinline__ int next_set(unsigned long long u0, unsigned long long u1, int from) {
    if (from < 64) { const unsigned long long x = u0 >> from; if (x) return from + __builtin_ctzll(x); from = 64; }
    if (from < 128) { const unsigned long long x = u1 >> (from - 64); if (x) return from + __builtin_ctzll(x); }
    return 128;
}
__device__ __forceinline__ void nsa_unit(int b, int g, int tile, bf16* QN  , const bf16* Z1, const bf16* KC, const bf16* VCT, const bf16* VTS, const bf16* VTW, LAS char* lds, const int wid, const int lane) {
    const int tid = wid * 64 + lane, r32 = lane & 31, hi = lane >> 5;
    const int t0 = tile * 64, cur = tile, tl = r32 >> 2, hh = r32 & 3, head = 4 * g + hh, tok = 8 * wid + tl, t = t0 + tok, bg = b * 2 + g;
    const size_t rowq = (size_t)b * SEQ + t;
    bf16x8 qr[4];
#pragma unroll
    for (int d0 = 0; d0 < 4; ++d0) qr[d0] = *(const bf16x8*)(QN + rowq * 512 + head * 64 + d0 * 16 + hi * 8);
    const float slope = __builtin_amdgcn_exp2f(-(float)(head + 1));
    const bf16* gz = Z1 + rowq * Z1P + 1184 + head * 3;
    const float g0 = sigmoidf(bf2f(gz[0])), g1 = sigmoidf(bf2f(gz[1])), g2 = sigmoidf(bf2f(gz[2]));
    LAS float* imp = (LAS float*)(lds + L_IMP);
    LAS unsigned* selm = (LAS unsigned*)(lds + L_SELM);
    LAS unsigned* wun = (LAS unsigned*)(lds + L_WUN);
    for (int i = lane; i < 8 * IMP_P; i += 64) imp[8 * wid * IMP_P + i] = 0.f;
    f32x16 out0, out1; zero16(out0); zero16(out1);
    const int krow = tid >> 3, kch = tid & 7;
    const int kdst = krow * 144 + kch * 16, vdst = krow * 136 + kch * 16;
    u32x4 sk, sv;
#define NSA_STORE(buf, withv) do { *(LAS u32x4*)(lds + L_KB + (buf) * KB_SZ + kdst) = sk; if (withv) { LAS char* vp_ = lds + L_VB + (buf) * VB_SZ + vdst; u32x2 a_; a_.x = sv.x; a_.y = sv.y; *(LAS u32x2*)vp_ = a_; a_.x = sv.z; a_.y = sv.w; *(LAS u32x2*)(vp_ + 8) = a_; } } while (0)

    const int ncmp = t0 / 16 + 3, nct = (ncmp + 63) / 64;
    const bf16* kcsrc = KC + ((size_t)bg * 512 + krow) * 64 + kch * 8;
    const bf16* vcsrc = VCT + ((size_t)bg * 64 + krow) * 512 + kch * 8;
    float mc = NEGF, lc = 0.f;
    {
        sk = *(const u32x4*)kcsrc; NSA_STORE(0, false); __syncthreads();
        for (int it = 0; it < nct; ++it) {
            const bool more = it + 1 < nct;
            if (more) sk = *(const u32x4*)(kcsrc + (size_t)(it + 1) * 64 * 64);
            const LAS char* Kb = lds + L_KB + (it & 1) * KB_SZ;
            f32x16 s0 = qk_sub<4>(Kb, 144, 0, qr, r32, hi), s1 = qk_sub<4>(Kb, 144, 1, qr, r32, hi);
            float mx = NEGF;
#pragma unroll
            for (int r = 0; r < 16; ++r) { const int i0 = it * 64 + crow(r, hi); const int d0_ = t - (16 * i0 + 31), d1_ = d0_ - 512;
                s0[r] = d0_ >= 0 ? s0[r] - slope * (float)d0_ : NEGF; s1[r] = d1_ >= 0 ? s1[r] - slope * (float)d1_ : NEGF; mx = fmaxf(mx, fmaxf(s0[r], s1[r])); }
            mx = fmaxf(mx, __shfl_xor(mx, 32));
            const float mn = fmaxf(mc, mx), alpha = __expf(mc - mn); mc = mn;
            float sum = 0.f;
#pragma unroll
            for (int r = 0; r < 16; ++r) { sum += (s0[r] > -1e29f ? __expf(s0[r] - mn) : 0.f) + (s1[r] > -1e29f ? __expf(s1[r] - mn) : 0.f); }
            lc = lc * alpha + sum;
            if (more) NSA_STORE((it + 1) & 1, false);
            __syncthreads();
        }
        lc += __shfl_xor(lc, 32);
    }
    {
        const float invl = 1.f / fmaxf(lc, 1e-30f);
        f32x16 o0, o1; zero16(o0); zero16(o1);
        sk = *(const u32x4*)kcsrc; sv = *(const u32x4*)vcsrc; NSA_STORE(0, true); __syncthreads();
        for (int it = 0; it < nct; ++it) {
            const bool more = it + 1 < nct;
            if (more) { sk = *(const u32x4*)(kcsrc + (size_t)(it + 1) * 64 * 64); sv = *(const u32x4*)(vcsrc + (it + 1) * 64); }
            const LAS char* Kb = lds + L_KB + (it & 1) * KB_SZ; const LAS char* Vb = lds + L_VB + (it & 1) * VB_SZ;
            f32x16 s0 = qk_sub<4>(Kb, 144, 0, qr, r32, hi), s1 = qk_sub<4>(Kb, 144, 1, qr, r32, hi);
#pragma unroll
            for (int r = 0; r < 16; ++r) { const int i0 = it * 64 + crow(r, hi); const int d0_ = t - (16 * i0 + 31), d1_ = d0_ - 512;
                s0[r] = d0_ >= 0 ? __expf(s0[r] - slope * (float)d0_ - mc) * invl : 0.f; s1[r] = d1_ >= 0 ? __expf(s1[r] - slope * (float)d1_ - mc) * invl : 0.f; }
            pv_sub(o0, o1, Vb, 0, s0, r32, hi); pv_sub(o0, o1, Vb, 1, s1, r32, hi);
#pragma unroll
            for (int sub = 0; sub < 2; ++sub) {
                f32x16 ps = sub ? s1 : s0;
#pragma unroll
                for (int r = 0; r < 16; ++r) { ps[r] += __shfl_xor(ps[r], 1); ps[r] += __shfl_xor(ps[r], 2); }
                LAS float* row = imp + tok * IMP_P + (it * 64 + sub * 32) / 4 + hi;
                if (hh == 0) {
#pragma unroll
                    for (int a = 0; a < 4; ++a) row[2 * a] += (ps[4 * a] + ps[4 * a + 1]) + (ps[4 * a + 2] + 0.5f * ps[4 * a + 3]);
                }
                LDS_WAIT();
                if (hh == 0) {
#pragma unroll
                    for (int a = 0; a < 4; ++a) row[2 * a + 1] += 0.5f * ps[4 * a + 3];
                }
                LDS_WAIT();
            }
            if (more) NSA_STORE((it + 1) & 1, true);
            __syncthreads();
        }
#pragma unroll
        for (int r = 0; r < 16; ++r) { out0[r] += g0 * o0[r]; out1[r] += g0 * o1[r]; }
    }
    {
        const int nlast = cur - 2;
        for (int tk = 0; tk < 8; ++tk) {
            const LAS float* row = imp + (8 * wid + tk) * IMP_P;
            const int j0 = lane, j1 = lane + 64; const float v0 = row[j0], v1 = row[j1];
            int c0 = 0, c1 = 0;
            for (int jj = 1; jj <= nlast; ++jj) { const float x = row[jj]; c0 += (x > v0 || (x == v0 && jj < j0)) ? 1 : 0; c1 += (x > v1 || (x == v1 && jj < j1)) ? 1 : 0; }
            const bool s0 = j0 >= 1 && j0 <= nlast && c0 < 13, s1 = j1 <= nlast && c1 < 13;
            unsigned long long m0 = __ballot(s0), m1 = __ballot(s1);
            m0 |= 1ull;
            if (cur < 64) m0 |= 1ull << cur; else m1 |= 1ull << (cur - 64);
            if (cur >= 1) { if (cur - 1 < 64) m0 |= 1ull << (cur - 1); else m1 |= 1ull << (cur - 65); }
            if (lane == 0) { selm[(8 * wid + tk) * 4 + 0] = (unsigned)m0; selm[(8 * wid + tk) * 4 + 1] = (unsigned)(m0 >> 32); selm[(8 * wid + tk) * 4 + 2] = (unsigned)m1; selm[(8 * wid + tk) * 4 + 3] = (unsigned)(m1 >> 32); }
        }
        LDS_WAIT();
        if (lane < 4) { unsigned x = 0; for (int tk = 0; tk < 8; ++tk) x |= selm[(8 * wid + tk) * 4 + lane]; wun[wid * 4 + lane] = x; }
        __syncthreads();
    }
    const unsigned long long tm0 = (unsigned long long)selm[tok * 4 + 0] | ((unsigned long long)selm[tok * 4 + 1] << 32), tm1 = (unsigned long long)selm[tok * 4 + 2] | ((unsigned long long)selm[tok * 4 + 3] << 32);
    unsigned long long wu0, wu1, gu0 = 0, gu1 = 0;
    {
        const unsigned a0 = __builtin_amdgcn_readfirstlane(wun[wid * 4 + 0]), a1 = __builtin_amdgcn_readfirstlane(wun[wid * 4 + 1]), a2 = __builtin_amdgcn_readfirstlane(wun[wid * 4 + 2]), a3 = __builtin_amdgcn_readfirstlane(wun[wid * 4 + 3]);
        wu0 = (unsigned long long)a0 | ((unsigned long long)a1 << 32); wu1 = (unsigned long long)a2 | ((unsigned long long)a3 << 32);
        for (int w = 0; w < 8; ++w) {
            const unsigned b0 = __builtin_amdgcn_readfirstlane(wun[w * 4 + 0]), b1 = __builtin_amdgcn_readfirstlane(wun[w * 4 + 1]), b2 = __builtin_amdgcn_readfirstlane(wun[w * 4 + 2]), b3 = __builtin_amdgcn_readfirstlane(wun[w * 4 + 3]);
            gu0 |= (unsigned long long)b0 | ((unsigned long long)b1 << 32); gu1 |= (unsigned long long)b2 | ((unsigned long long)b3 << 32);
        }
    }
    {
        const bf16* ksrc = Z1 + ((size_t)b * SEQ + krow) * Z1P + 256 + g * 64 + kch * 8;
        const bf16* vsrc = VTS + ((size_t)(b * 128 + g * 64 + krow)) * SEQ + kch * 8;
        float m = NEGF, l = 0.f; f32x16 o0, o1; zero16(o0); zero16(o1);
        int j = next_set(gu0, gu1, 0);
        sk = *(const u32x4*)(ksrc + (size_t)j * 64 * Z1P); sv = *(const u32x4*)(vsrc + j * 64); NSA_STORE(0, true); __syncthreads();
        int par = 0;
        while (j < 128) {
            const int nj = next_set(gu0, gu1, j + 1);
            const bool more = nj < 128;
            if (more) { sk = *(const u32x4*)(ksrc + (size_t)nj * 64 * Z1P); sv = *(const u32x4*)(vsrc + nj * 64); }
            const bool wsel = ((j < 64 ? (wu0 >> j) : (wu1 >> (j - 64))) & 1ull) != 0;
            if (wsel) {
                const LAS char* Kb = lds + L_KB + par * KB_SZ; const LAS char* Vb = lds + L_VB + par * VB_SZ;
                f32x16 s0 = qk_sub<4>(Kb, 144, 0, qr, r32, hi), s1 = qk_sub<4>(Kb, 144, 1, qr, r32, hi);
                const bool tsel = ((j < 64 ? (tm0 >> j) : (tm1 >> (j - 64))) & 1ull) != 0;
#pragma unroll
                for (int r = 0; r < 16; ++r) { const int d0_ = t - (j * 64 + crow(r, hi)), d1_ = d0_ - 32;
                    s0[r] = (tsel && d0_ >= 0) ? s0[r] - slope * (float)d0_ : NEGF; s1[r] = (tsel && d1_ >= 0) ? s1[r] - slope * (float)d1_ : NEGF; }
                softmax_step(s0, s1, m, l, o0, o1);
                pv_sub(o0, o1, Vb, 0, s0, r32, hi); pv_sub(o0, o1, Vb, 1, s1, r32, hi);
            }
            if (more) NSA_STORE(par ^ 1, true);
            __syncthreads();
            par ^= 1; j = nj;
        }
        l += __shfl_xor(l, 32);
        const float sc = g1 / fmaxf(l, 1e-30f);
#pragma unroll
        for (int r = 0; r < 16; ++r) { out0[r] += sc * o0[r]; out1[r] += sc * o1[r]; }
    }
    {
        const bf16* ksrc = Z1 + ((size_t)b * SEQ + krow) * Z1P + 512 + g * 64 + kch * 8;
        const bf16* vsrc = VTW + ((size_t)(b * 128 + g * 64 + krow)) * SEQ + kch * 8;
        float m = NEGF, l = 0.f; f32x16 o0, o1; zero16(o0); zero16(o1);
        const int kt_first = (t0 >= 512) ? (t0 - 512) / 64 : 0, kt_last = t0 / 64;
        sk = *(const u32x4*)(ksrc + (size_t)kt_first * 64 * Z1P); sv = *(const u32x4*)(vsrc + kt_first * 64); NSA_STORE(0, true); __syncthreads();
        int par = 0;
        for (int kt = kt_first; kt <= kt_last; ++kt) {
            const bool more = kt < kt_last;
            if (more) { sk = *(const u32x4*)(ksrc + (size_t)(kt + 1) * 64 * Z1P); sv = *(const u32x4*)(vsrc + (kt + 1) * 64); }
            const LAS char* Kb = lds + L_KB + par * KB_SZ; const LAS char* Vb = lds + L_VB + par * VB_SZ;
            f32x16 s0 = qk_sub<4>(Kb, 144, 0, qr, r32, hi), s1 = qk_sub<4>(Kb, 144, 1, qr, r32, hi);
#pragma unroll
            for (int r = 0; r < 16; ++r) { const int d0_ = t - (kt * 64 + crow(r, hi)), d1_ = d0_ - 32;
                s0[r] = (d0_ >= 0 && d0_ < 512) ? s0[r] - slope * (float)d0_ : NEGF; s1[r] = (d1_ >= 0 && d1_ < 512) ? s1[r] - slope * (float)d1_ : NEGF; }
            softmax_step(s0, s1, m, l, o0, o1);
            pv_sub(o0, o1, Vb, 0, s0, r32, hi); pv_sub(o0, o1, Vb, 1, s1, r32, hi);
            if (more) NSA_STORE(par ^ 1, true);
            __syncthreads();
            par ^= 1;
        }
        l += __shfl_xor(l, 32);
        const float sc = g2 / fmaxf(l, 1e-30f);
#pragma unroll
        for (int r = 0; r < 16; ++r) { out0[r] += sc * o0[r]; out1[r] += sc * o1[r]; }
    }
#undef NSA_STORE
    bf16* orow = QN + rowq * 512 + head * 64 + 4 * hi;
#pragma unroll
    for (int a = 0; a < 4; ++a) {
        u32x2 w; w.x = cvtpk(out0[4 * a], out0[4 * a + 1]); w.y = cvtpk(out0[4 * a + 2], out0[4 * a + 3]); *(u32x2*)(orow + 8 * a) = w;
        w.x = cvtpk(out1[4 * a], out1[4 * a + 1]); w.y = cvtpk(out1[4 * a + 2], out1[4 * a + 3]); *(u32x2*)(orow + 32 + 8 * a) = w;
    }
}

struct Args { const float* in[27]; float* out; unsigned char* ws; int ph_lo, ph_hi; };
enum { I_X = 0, I_F1PRE, I_F1POST, I_F1G, I_F1U, I_F1D, I_MPRE, I_MPOST, I_WIN, I_CPK, I_CW1K, I_CW2K, I_CPV, I_CW1V, I_CW2V, I_QNG, I_WUQ, I_KVNG, I_WUKV, I_WPN, I_WPM, I_WOUT, I_F2PRE, I_F2POST, I_F2G, I_F2U, I_F2D };

__global__ void __launch_bounds__(NWAVES * 64, 2) fwd_kernel(Args args) {
    extern __shared__ __attribute__((aligned(16))) unsigned char lds_raw[];
    LAS unsigned char* lds = (LAS unsigned char*)lds_raw;
    const int wave = __builtin_amdgcn_readfirstlane((int)threadIdx.x >> 6);
    const int G = gridDim.x, c = blockIdx.x;
    const int NGW = G * NWAVES, NGT = G * NWAVES * 64;
#define IDS() const int lane = mk_lane(); const int tid = wave * 64 + lane; const int gw = c * NWAVES + wave; const int gt = c * (NWAVES * 64) + tid; (void)tid; (void)gw; (void)gt
#define WGU1 ((bf16*)(args.ws + O_WGU1))
#define WD1 ((bf16*)(args.ws + O_WD1))
#define WGU2 ((bf16*)(args.ws + O_WGU2))
#define WD2 ((bf16*)(args.ws + O_WD2))
#define WIN ((bf16*)(args.ws + O_WIN))
#define WPN ((bf16*)(args.ws + O_WPN))
#define WPM ((bf16*)(args.ws + O_WPM))
#define WOUT ((bf16*)(args.ws + O_WOUT))
#define WUQ ((bf16*)(args.ws + O_WUQ))
#define WUKV ((bf16*)(args.ws + O_WUKV))
#define CW1K ((bf16*)(args.ws + O_CW1K))
#define CW1V ((bf16*)(args.ws + O_CW1V))
#define A1 ((bf16*)(args.ws + O_A1))
#define IM2K ((bf16*)(args.ws + O_IM2K))
#define IM2V ((bf16*)(args.ws + O_IM2V))
#define CQN ((bf16*)(args.ws + O_CQN))
#define CKVN ((bf16*)(args.ws + O_CKVN))
#define KR ((bf16*)(args.ws + O_KR))
#define HK ((bf16*)(args.ws + O_HK))
#define HV ((bf16*)(args.ws + O_HV))
#define KC ((bf16*)(args.ws + O_KC))
#define VCT ((bf16*)(args.ws + O_VCT))
#define MG ((bf16*)(args.ws + O_MG))
#define H ((bf16*)(args.ws + O_H))
#define Z1 ((bf16*)(args.ws + O_Z1))
#define QN ((bf16*)(args.ws + O_QN))
#define YM ((bf16*)(args.ws + O_YM))
#define KM ((bf16*)(args.ws + O_KM))
#define GM ((bf16*)(args.ws + O_GM))
#define QM ((bf16*)(args.ws + O_QM))
#define VTM ((bf16*)(args.ws + O_VTM))
#define VTS ((bf16*)(args.ws + O_VTS))
#define VTW ((bf16*)(args.ws + O_VTW))
#define F ((float*)(args.ws + O_F))
#define X (args.out)
    typedef const float* cfp_t;
    const __attribute__((address_space(4))) cfp_t* in = (const __attribute__((address_space(4))) cfp_t*)__builtin_amdgcn_kernarg_segment_ptr();
    asm volatile("" : "+s"(in));
    const int lo = args.ph_lo, hi_ph = args.ph_hi;
#define IN(k) (lo <= (k) && (k) < hi_ph)
    unsigned* const barctr = (unsigned*)(args.ws + O_CTL);
#if MK_PER_PHASE
#define SEAM(k) do { } while (0)
#else
    if (lo == 0 && hi_ph == NPHASE) { cg::grid_group grid = cg::this_grid(); grid.sync(); }
#define SEAM(k) do { if (IN(k) && IN((k) + 1)) { const int l_ = mk_lane(); grid_barrier(barctr, (unsigned)((k) + 1) * (unsigned)G, wave * 64 + l_); } } while (0)
#endif
#define GEMM_CALL(EPI, A_, B_, M_, N_, K_, cc, E_) do { Gemm g_{(const pg8::bf16_t*)(A_), (const pg8::bf16_t*)(B_), (M_), (N_), (K_)}; StaticOrder S_; S_.init((M_), (N_), G, (cc)); \
        const int l_ = mk_lane(); pg8::gemm_phase<EPI, StaticOrder, false, PG8_SP2>(lds, g_, S_, (E_), wave, l_); } while (0)

    if (IN(0)) {
        IDS();
        LAS float* scr = (LAS float*)(lds + wave * 16384);
        transpose_mat(in[I_F1G], DFF, MapGU{0}, 1024, DFF, WGU1, scr, gw, NGW, lane);
        transpose_mat(in[I_F1U], DFF, MapGU{1}, 1024, DFF, WGU1, scr, gw, NGW, lane);
        transpose_mat(in[I_F1D], 1024, MapPlain{}, 2816, 1024, WD1, scr, gw, NGW, lane);
        transpose_mat(in[I_WIN], 3768, MapWin{}, 1024, 3840, WIN, scr, gw, NGW, lane);
        transpose_mat(in[I_F2G], DFF, MapGU{0}, 1024, DFF, WGU2, scr, gw, NGW, lane);
        transpose_mat(in[I_F2U], DFF, MapGU{1}, 1024, DFF, WGU2, scr, gw, NGW, lane);
        transpose_mat(in[I_F2D], 1024, MapPlain{}, 2816, 1024, WD2, scr, gw, NGW, lane);
        transpose_mat(in[I_WPN], 1024, MapPlain{}, 512, 1024, WPN, scr, gw, NGW, lane);
        transpose_mat(in[I_WPM], 1024, MapPlain{}, 512, 1024, WPM, scr, gw, NGW, lane);
        transpose_mat(in[I_WOUT], 1024, MapPlain{}, 1024, 1024, WOUT, scr, gw, NGW, lane);
        transpose_mat(in[I_WUQ], 768, MapPlain{}, 256, 768, WUQ, scr, gw, NGW, lane);
        transpose_mat(in[I_WUKV], 1024, MapUkv{}, 128, 1024, WUKV, scr, gw, NGW, lane);
        transpose_mat(in[I_CW1K], 256, MapPlain{}, 2048, 256, CW1K, scr, gw, NGW, lane);
        transpose_mat(in[I_CW1V], 256, MapPlain{}, 2048, 256, CW1V, scr, gw, NGW, lane);
        for (int m = gw; m < MTOK; m += NGW) { const f32x4* xr = (const f32x4*)(in[I_X] + (size_t)m * DM) + lane; f32x4 v[4];
#pragma unroll
            for (int j = 0; j < 4; ++j) v[j] = xr[64 * j];
            rms_row_to_bf16(v, in[I_F1PRE], A1 + (size_t)m * DM, lane); }
        __syncthreads();
    }
    SEAM(0);
    if (IN(1)) GEMM_CALL(EpiSwiglu, A1, WGU1, MTOK, 5632, 1024, c, (EpiSwiglu{H}));
    SEAM(1);
    if (IN(2)) GEMM_CALL(EpiF32, H, WD1, MTOK, 1024, 2816, c, (EpiF32{F, DM}));
    SEAM(2);
    if (IN(3)) { IDS(); rowop<true>(F, in[I_X], 0.5f, in[I_F1POST], X, in[I_MPRE], A1, gw, NGW, lane); }
    SEAM(3);
    if (IN(4)) GEMM_CALL(EpiWin, A1, WIN, MTOK, 3840, 1024, c, (EpiWin{QN, Z1, GM, VTS, VTW}));
    SEAM(4);
    if (IN(5)) {
        IDS();
        for (int ch = gt; ch < 2 * 4096 * 256; ch += NGT) {
            const int kv = ch >> 20, r = (ch >> 8) & 4095, c8 = ch & 255, l = c8 >> 3, d0 = (c8 & 7) * 8, bgi = r >> 9, i = r & 511, b = bgi >> 1, g = bgi & 1;
            u32x4 o = (u32x4){0u, 0u, 0u, 0u};
            if (i < 511) {
                const u32x4 z = *(const u32x4*)(Z1 + ((size_t)b * SEQ + 16 * i + l) * Z1P + kv * 128 + g * 64 + d0);
                const float* pe = (kv ? in[I_CPV] : in[I_CPK]) + l * 64 + d0; const f32x4 p0 = *(const f32x4*)pe, p1 = *(const f32x4*)(pe + 4);
                o.x = cvtpk(bflo(z.x) + p0.x, bfhi(z.x) + p0.y); o.y = cvtpk(bflo(z.y) + p0.z, bfhi(z.y) + p0.w); o.z = cvtpk(bflo(z.z) + p1.x, bfhi(z.z) + p1.y); o.w = cvtpk(bflo(z.w) + p1.z, bfhi(z.w) + p1.w);
            }
            *(u32x4*)((kv ? IM2V : IM2K) + (size_t)r * 2048 + c8 * 8) = o;
        }
        for (int m = gw; m < MTOK; m += NGW) {
            const bf16* zr = Z1 + (size_t)m * Z1P;
            { const u32x2 w = *(const u32x2*)(zr + 768 + 4 * lane); const float a0 = bflo(w.x), a1 = bfhi(w.x), a2 = bflo(w.y), a3 = bfhi(w.y);
              const float r = rsqrtf(wave_sum((a0 * a0 + a1 * a1) + (a2 * a2 + a3 * a3)) * (1.f / 256.f) + EPS); const f32x4 gq = *(const f32x4*)(in[I_QNG] + 4 * lane);
              u32x2 o; o.x = cvtpk(a0 * r * gq.x, a1 * r * gq.y); o.y = cvtpk(a2 * r * gq.z, a3 * r * gq.w); *(u32x2*)(CQN + (size_t)m * 256 + 4 * lane) = o; }
            { const unsigned w = *(const unsigned*)(zr + 1024 + 2 * lane); const float a0 = bflo(w), a1 = bfhi(w);
              const float r = rsqrtf(wave_sum(a0 * a0 + a1 * a1) * (1.f / 128.f) + EPS); const float gk0 = in[I_KVNG][2 * lane], gk1 = in[I_KVNG][2 * lane + 1];
              *(unsigned*)(CKVN + (size_t)m * 128 + 2 * lane) = cvtpk(a0 * r * gk0, a1 * r * gk1); }
            if (lane < 16) { const float x1 = bf2f(zr[1152 + lane]), x2 = bf2f(zr[1152 + 16 + lane]); float cs, sn; rope_cs(m & 8191, lane, cs, sn);
              KR[(size_t)m * 32 + lane] = f2bf(x1 * cs - x2 * sn); KR[(size_t)m * 32 + 16 + lane] = f2bf(x1 * sn + x2 * cs); }
        }
    }
    SEAM(5);
    if (IN(6)) {
        GEMM_CALL(EpiGelu, IM2K, CW1K, 4096, 256, 2048, c, (EpiGelu{HK, 256}));
        GEMM_CALL(EpiGelu, IM2V, CW1V, 4096, 256, 2048, (c + G / 2) % G, (EpiGelu{HV, 256}));
        GEMM_CALL(EpiQup, CQN, WUQ, MTOK, 768, 256, c, (EpiQup{QM}));
        GEMM_CALL(EpiKVup, CKVN, WUKV, MTOK, 1024, 128, c, (EpiKVup{KM, VTM}));
    }
    SEAM(6);
    if (IN(7)) {
        IDS();
        for (int idx = gt; idx < 2 * 4096 * 64; idx += NGT) {
            const int kv = idx >> 18, r = (idx >> 6) & 4095, d = idx & 63;
            const bf16* hrow = (kv ? HV : HK) + (size_t)r * 256; const float* w2 = (kv ? in[I_CW2V] : in[I_CW2K]) + d;
            float acc = 0.f;
            for (int j8 = 0; j8 < 32; ++j8) { const u32x4 hw = *(const u32x4*)(hrow + j8 * 8); const float* wp = w2 + (size_t)j8 * 8 * 64;
                acc += bflo(hw.x) * wp[0] + bfhi(hw.x) * wp[64] + bflo(hw.y) * wp[128] + bfhi(hw.y) * wp[192] + bflo(hw.z) * wp[256] + bfhi(hw.z) * wp[320] + bflo(hw.w) * wp[384] + bfhi(hw.w) * wp[448]; }
            if (kv == 0) KC[(size_t)r * 64 + d] = f2bf(acc); else VCT[((size_t)(r >> 9) * 64 + d) * 512 + (r & 511)] = f2bf(acc);
        }
    }
    SEAM(7);
    if (IN(8)) {
        IDS();
        LAS char* al = (LAS char*)lds;
        for (int i = 0; i * G < 1024; ++i) { const int p = (i & 1) ? (G - 1 - c) : c, uu = i * G + p;
            if (uu < 1024) { const int qb = 31 - (uu >> 5), bh = uu & 31;
#ifndef NO_MLA
 mla_unit(bh >> 3, bh & 7, qb, QM, KM, KR, VTM, YM, al, wave, lane);
#endif
 } }
        for (int i = 0; i * G < 1024; ++i) { const int p = (i & 1) ? (G - 1 - c) : c, uu = i * G + p;
            if (uu < 1024) { const int tile = 127 - (uu >> 3), bgi = uu & 7;
#ifndef NO_NSA
 nsa_unit(bgi >> 1, bgi & 1, tile, QN, Z1, KC, VCT, VTS, VTW, al, wave, lane);
#endif
 } }
    }
    SEAM(8);
    if (IN(9)) {
        GEMM_CALL(EpiProj<false>, QN, WPN, MTOK, 1024, 512, c, (EpiProj<false>{GM, MG}));
        GEMM_CALL(EpiProj<true>, YM, WPM, MTOK, 1024, 512, c, (EpiProj<true>{GM, MG}));
    }
    SEAM(9);
    if (IN(10)) GEMM_CALL(EpiF32, MG, WOUT, MTOK, 1024, 1024, c, (EpiF32{F, DM}));
    SEAM(10);
    if (IN(11)) { IDS(); rowop<true>(F, X, 1.0f, in[I_MPOST], X, in[I_F2PRE], A1, gw, NGW, lane); }
    SEAM(11);
    if (IN(12)) GEMM_CALL(EpiSwiglu, A1, WGU2, MTOK, 5632, 1024, c, (EpiSwiglu{H}));
    SEAM(12);
    if (IN(13)) GEMM_CALL(EpiF32, H, WD2, MTOK, 1024, 2816, c, (EpiF32{F, DM}));
    SEAM(13);
    if (IN(14)) { IDS(); rowop<false>(F, X, 0.5f, in[I_F2POST], X, nullptr, nullptr, gw, NGW, lane); }
#undef IN
#undef IDS
#undef SEAM
#undef GEMM_CALL
#undef WGU1
#undef WD1
#undef WGU2
#undef WD2
#undef WIN
#undef WPN
#undef WPM
#undef WOUT
#undef WUQ
#undef WUKV
#undef CW1K
#undef CW1V
#undef A1
#undef IM2K
#undef IM2V
#undef CQN
#undef CKVN
#undef KR
#undef HK
#undef HV
#undef KC
#undef VCT
#undef MG
#undef H
#undef Z1
#undef QN
#undef YM
#undef KM
#undef GM
#undef QM
#undef VTM
#undef VTS
#undef VTW
#undef F
#undef X
}
}

extern "C" void kernel_launch(void* const* d_in, const int* in_sizes, int n_in, void* d_out, int out_size, void* d_ws, size_t ws_size, hipStream_t stream) {
    using namespace mk;
    static int grid = 0;
    if (grid == 0) {
        if (n_in != 27 || out_size != MTOK * DM || ws_size < O_END) { fprintf(stderr, "kernel_launch: unexpected problem (n_in %d out %d ws %zu)\n", n_in, out_size, ws_size); grid = -1; return; }
        int dev = 0, cus = 0, per_cu = 0;
        hipGetDevice(&dev); hipDeviceGetAttribute(&cus, hipDeviceAttributeMultiprocessorCount, dev);
        if (hipFuncSetAttribute((const void*)fwd_kernel, hipFuncAttributeMaxDynamicSharedMemorySize, LDS_BYTES) != hipSuccess) { fprintf(stderr, "kernel_launch: hipFuncSetAttribute failed\n"); grid = -1; return; }
        if (hipOccupancyMaxActiveBlocksPerMultiprocessor(&per_cu, (const void*)fwd_kernel, NWAVES * 64, LDS_BYTES) != hipSuccess || per_cu < 1) { fprintf(stderr, "kernel_launch: occupancy query says %d\n", per_cu); per_cu = 1; }
        (void)hipGetLastError();
        grid = cus * per_cu;
    }
    if (grid < 0) return;
    if (hipMemsetAsync((char*)d_ws + O_CTL, 0, 4096, stream) != hipSuccess) { fprintf(stderr, "kernel_launch: memset failed\n"); return; }
    Args a{};
    for (int i = 0; i < 27; ++i) a.in[i] = (const float*)d_in[i];
    a.out = (float*)d_out; a.ws = (unsigned char*)d_ws;
#if MK_PER_PHASE
    for (int ph = 0; ph < NPHASE; ++ph) { a.ph_lo = ph; a.ph_hi = ph + 1; hipLaunchKernelGGL(fwd_kernel, dim3(grid), dim3(NWAVES * 64), LDS_BYTES, stream, a); }
#else
    a.ph_lo = 0; a.ph_hi = NPHASE;
    void* kargs[] = {&a};
    hipError_t e = hipLaunchCooperativeKernel((const void*)fwd_kernel, dim3(grid), dim3(NWAVES * 64), kargs, LDS_BYTES, stream);
    if (e != hipSuccess) fprintf(stderr, "cooperative launch failed: %s (grid %d)\n", hipGetErrorString(e), grid);
#endif
}
```

```cpp
#include <hip/hip_runtime.h>
#include <hip/hip_cooperative_groups.h>
#include <cstdio>
#include <cstdint>
namespace cg = cooperative_groups;
namespace pg8 {
#define PG8_LAS __attribute__((address_space(3)))
typedef unsigned short bf16_t;
typedef short bf16x8 __attribute__((ext_vector_type(8)));
typedef float f32x4 __attribute__((ext_vector_type(4)));
typedef unsigned u32x4 __attribute__((ext_vector_type(4)));
constexpr int BM = 256, BK = 64, HALF = 128, HTB = HALF * BK * 2  , STAGE_BYTES = 8 * HTB, NXCD = 8, WGM = 8;

__host__ __device__ __forceinline__ int lds_byte(int r, int c) { const int st = (r >> 4) * 2 + (c >> 5), rr = r & 15, cc = c & 31, ob = rr * 64 + cc * 2; return st * 1024 + (ob ^ (((ob >> 9) & 1) << 5)); }
__host__ __device__ __forceinline__ void stage_rc(int b, int& R, int& C) { const int st = b / 1024, sb = b % 1024, swz = sb ^ (((sb >> 9) & 1) << 5); R = (st >> 1) * 16 + swz / 64; C = (st & 1) * 32 + (swz % 64) / 2; }
__host__ __device__ __forceinline__ int perm32(int rho) { const int n = rho >> 4, i = rho & 15; return 8 * (i >> 2) + 4 * n + (i & 3); }

struct Unit { int pm, pn; };
struct Gemm { const bf16_t* A; const bf16_t* Bt; int M, N, K; };

struct StaticOrder {
    int nM, nN, nwg, G, c;
    __host__ __device__ void init(int M, int N, int G_, int c_) { nM = M / BM; nN = N / BM; nwg = nM * nN; G = G_; c = c_; }
    __host__ __device__ bool next(int i, Unit& u) const {
        const long L = (long)i * G + c; if (L >= nwg) return false;
        int wgid = (int)L; { const int q = nwg / NXCD, r = nwg % NXCD, xcd = wgid % NXCD, off = wgid / NXCD; wgid = (xcd < r ? xcd * (q + 1) : r * (q + 1) + (xcd - r) * q) + off; }
        const int nig = WGM * nN, gid = wgid / nig, fm = gid * WGM, gsz = (nM - fm) < WGM ? (nM - fm) : WGM;
        u.pm = fm + ((wgid % nig) % gsz); u.pn = (wgid % nig) / gsz; return true;
    }
    __device__ __forceinline__ void a_ready(const Unit&) const {}
    __device__ __forceinline__ void done(const Unit&) const {}
};

__device__ __forceinline__ unsigned cvt_pk_bf16(float lo, float hi) { unsigned r; asm volatile("v_cvt_pk_bf16_f32 %0, %1, %2" : "=v"(r) : "v"(lo), "v"(hi)); return r; }
typedef float f32x2 __attribute__((ext_vector_type(2)));
template <class Epi, class Sched, bool ALIGN_EPI = false, bool SP2 = false>
__device__ __forceinline__ void gemm_phase(PG8_LAS unsigned char* lds, const Gemm g, const Sched& S, const Epi& E, const int wid, const int lane) {
    const int tid = wid * 64 + lane, wr = wid >> 2, wc = wid & 3, fr = lane & 15, fq = lane >> 4;
    const int K = g.K, nt = K / BK;
    unsigned voffA[2], voffB[2];
#pragma unroll
    for (int i = 0; i < 2; ++i) { int R, C; stage_rc(tid * 16 + i * 8192, R, C); const int Rb = Epi::PERM ? ((R & ~31) + perm32(R & 31)) : R;
        voffA[i] = (unsigned)(R * K + C) * 2u; voffB[i] = (unsigned)(Rb * K + C) * 2u; }
    const size_t kstep = (size_t)(BK * 2);
    const size_t hstep = (size_t)HALF * K * 2;
    const size_t tstep = 2 * hstep;
    const unsigned ldsw = (unsigned)wid * 1024u;
    const int aoff = lds_byte(wr * 64 + fr, fq * 8), boff = lds_byte(wc * 32 + fr, fq * 8);
#define PG8_SA(b, h) (((b) * 2 + (h)) * HTB)
#define PG8_SB(b, h) ((4 + (b) * 2 + (h)) * HTB)
#define PG8_STAGE(bufoff, gbase, voff) do { _Pragma("unroll") for (int _i = 0; _i < 2; ++_i) \
        __builtin_amdgcn_global_load_lds((const unsigned*)((const char*)(gbase) + (voff)[_i]), (PG8_LAS unsigned*)(lds + (bufoff) + ldsw + _i * 8192), 16, 0, 0); } while (0)
#define PG8_LDA(dst, b, h) do { _Pragma("unroll") for (int m = 0; m < 4; ++m) _Pragma("unroll") for (int k = 0; k < 2; ++k) dst[m][k] = *(const PG8_LAS bf16x8*)(lds + PG8_SA(b, h) + aoff + m * 2048 + k * 1024); } while (0)
#define PG8_LDB(dst, b, h) do { _Pragma("unroll") for (int n = 0; n < 2; ++n) _Pragma("unroll") for (int k = 0; k < 2; ++k) dst[n][k] = *(const PG8_LAS bf16x8*)(lds + PG8_SB(b, h) + boff + n * 2048 + k * 1024); } while (0)
#define PG8_MMA(ai, bj, At, Bt) do { __builtin_amdgcn_s_setprio(1); _Pragma("unroll") for (int m = 0; m < 4; ++m) _Pragma("unroll") for (int n = 0; n < 2; ++n) _Pragma("unroll") for (int k = 0; k < 2; ++k) \
        acc[ai][bj][m][n] = __builtin_amdgcn_mfma_f32_16x16x32_bf16(Bt[n][k], At[m][k], acc[ai][bj][m][n], 0, 0, 0); __builtin_amdgcn_s_setprio(0); } while (0)
#define PG8_WAIT_V(n) asm volatile("s_waitcnt vmcnt(" #n ")" ::: "memory")
#define PG8_WAIT_L(n) asm volatile("s_waitcnt lgkmcnt(" #n ")" ::: "memory")
#define PG8_BAR __builtin_amdgcn_s_barrier()
#define PG8_SCHED __builtin_amdgcn_sched_barrier(0)
    Unit cur, nxt; int ui = 0;
    if (!S.next(0, cur)) return;
    f32x4 acc[2][2][4][2];
#pragma unroll
    for (int a = 0; a < 2; ++a)
#pragma unroll
        for (int b = 0; b < 2; ++b)
#pragma unroll
            for (int m = 0; m < 4; ++m)
#pragma unroll
                for (int n = 0; n < 2; ++n) acc[a][b][m][n] = (f32x4){0.f, 0.f, 0.f, 0.f};
    bf16x8 At[4][2], B0[2][2], B1[2][2];
    const char* cA = (const char*)g.A + (size_t)cur.pm * tstep; const char* cB = (const char*)g.Bt + (size_t)cur.pn * tstep;
    S.a_ready(cur);
    if constexpr (SP2) {
        PG8_STAGE(PG8_SB(0, 0), cB, voffB); PG8_STAGE(PG8_SB(0, 1), cB + hstep, voffB); PG8_STAGE(PG8_SA(0, 0), cA, voffA); PG8_STAGE(PG8_SA(0, 1), cA + hstep, voffA);
        if (wr == 1) PG8_BAR;
        PG8_WAIT_V(2); PG8_BAR;
        PG8_STAGE(PG8_SB(1, 0), cB + kstep, voffB); PG8_STAGE(PG8_SA(1, 0), cA + kstep, voffA); PG8_STAGE(PG8_SB(1, 1), cB + hstep + kstep, voffB);
        PG8_WAIT_V(6); PG8_BAR;
    } else {
        PG8_STAGE(PG8_SB(0, 0), cB, voffB); PG8_STAGE(PG8_SA(0, 0), cA, voffA); PG8_STAGE(PG8_SB(0, 1), cB + hstep, voffB); PG8_STAGE(PG8_SA(0, 1), cA + hstep, voffA);
        if (wr == 1) PG8_BAR;
        PG8_WAIT_V(4); PG8_BAR;
        PG8_STAGE(PG8_SB(1, 0), cB + kstep, voffB); PG8_STAGE(PG8_SA(1, 0), cA + kstep, voffA); PG8_STAGE(PG8_SB(1, 1), cB + hstep + kstep, voffB);
        PG8_WAIT_V(6); PG8_BAR;
    }
    for (;;) {
        const bool has_next = S.next(ui + 1, nxt);
        const char* nA = has_next ? (const char*)g.A + (size_t)nxt.pm * tstep : cA; const char* nB = has_next ? (const char*)g.Bt + (size_t)nxt.pn * tstep : cB;
        for (int t = 0; t < nt; t += 2) {
            const bool last = (t == nt - 2);
            const char* a1 = cA + (size_t)(t + 1) * kstep;
            const char* a2 = last ? nA : cA + (size_t)(t + 2) * kstep; const char* b2 = last ? nB : cB + (size_t)(t + 2) * kstep;
            const char* a3 = a2 + kstep; const char* b3 = b2 + kstep;
            if (last && has_next) S.a_ready(nxt);
            if constexpr (SP2) {
            PG8_LDB(B0, 0, 0); PG8_LDB(B1, 0, 1); PG8_SCHED; PG8_LDA(At, 0, 0); PG8_STAGE(PG8_SA(1, 1), a1 + hstep, voffA);
            PG8_WAIT_V(8); PG8_WAIT_L(0); PG8_BAR; PG8_MMA(0, 0, At, B0); PG8_MMA(0, 1, At, B1); PG8_BAR; PG8_SCHED;
            PG8_LDA(At, 0, 1); PG8_STAGE(PG8_SB(0, 0), b2, voffB); PG8_STAGE(PG8_SB(0, 1), b2 + hstep, voffB); PG8_STAGE(PG8_SA(0, 0), a2, voffA);
            PG8_WAIT_V(8); PG8_WAIT_L(0); PG8_BAR; PG8_MMA(1, 0, At, B0); PG8_MMA(1, 1, At, B1); PG8_BAR; PG8_SCHED;
            PG8_LDB(B0, 1, 0); PG8_LDB(B1, 1, 1); PG8_SCHED; PG8_LDA(At, 1, 0); PG8_STAGE(PG8_SA(0, 1), a2 + hstep, voffA);
            PG8_WAIT_V(8); PG8_WAIT_L(0); PG8_BAR; PG8_MMA(0, 0, At, B0); PG8_MMA(0, 1, At, B1); PG8_BAR; PG8_SCHED;
            PG8_LDA(At, 1, 1); PG8_STAGE(PG8_SB(1, 0), b3, voffB); PG8_STAGE(PG8_SB(1, 1), b3 + hstep, voffB); PG8_STAGE(PG8_SA(1, 0), a3, voffA);
            PG8_WAIT_V(8); PG8_WAIT_L(0); PG8_BAR; PG8_MMA(1, 0, At, B0); PG8_MMA(1, 1, At, B1); PG8_BAR; PG8_SCHED;
            } else {
            PG8_LDB(B0, 0, 0); PG8_SCHED; PG8_LDA(At, 0, 0); PG8_STAGE(PG8_SA(1, 1), a1 + hstep, voffA);
            PG8_WAIT_L(8); PG8_BAR; PG8_WAIT_L(0); PG8_MMA(0, 0, At, B0); PG8_BAR; PG8_SCHED;
            PG8_LDB(B1, 0, 1); PG8_STAGE(PG8_SB(0, 0), b2, voffB);
            PG8_BAR; PG8_WAIT_L(0); PG8_MMA(0, 1, At, B1); PG8_BAR;
            PG8_LDA(At, 0, 1); PG8_STAGE(PG8_SA(0, 0), a2, voffA);
            PG8_BAR; PG8_WAIT_L(0); PG8_MMA(1, 0, At, B0); PG8_BAR; PG8_SCHED;
            PG8_STAGE(PG8_SB(0, 1), b2 + hstep, voffB);
            PG8_WAIT_V(6); PG8_BAR; PG8_MMA(1, 1, At, B1); PG8_BAR;
            PG8_LDB(B0, 1, 0); PG8_SCHED; PG8_LDA(At, 1, 0); PG8_STAGE(PG8_SA(0, 1), a2 + hstep, voffA);
            PG8_WAIT_L(8); PG8_BAR; PG8_WAIT_L(0); PG8_MMA(0, 0, At, B0); PG8_BAR; PG8_SCHED;
            PG8_LDB(B1, 1, 1); PG8_STAGE(PG8_SB(1, 0), b3, voffB);
            PG8_BAR; PG8_WAIT_L(0); PG8_MMA(0, 1, At, B1); PG8_BAR;
            PG8_LDA(At, 1, 1); PG8_STAGE(PG8_SA(1, 0), a3, voffA);
            PG8_BAR; PG8_WAIT_L(0); PG8_MMA(1, 0, At, B0); PG8_BAR; PG8_SCHED;
            PG8_STAGE(PG8_SB(1, 1), b3 + hstep, voffB);
            PG8_WAIT_V(6); PG8_BAR; PG8_MMA(1, 1, At, B1); PG8_BAR;
            }
        }
        if constexpr (ALIGN_EPI) { if (wr == 0) PG8_BAR; }
        if constexpr (!Epi::AFTER_DRAIN) { E(acc, cur, wr, wc, fr, fq); S.done(cur); }
        if (!has_next) break;
#pragma unroll
        for (int a = 0; a < 2; ++a)
#pragma unroll
            for (int b = 0; b < 2; ++b)
#pragma unroll
                for (int m = 0; m < 4; ++m)
#pragma unroll
                    for (int n = 0; n < 2; ++n) acc[a][b][m][n] = (f32x4){0.f, 0.f, 0.f, 0.f};
        cur = nxt; cA = nA; cB = nB; ++ui;
        if constexpr (ALIGN_EPI) { if (wr == 1) PG8_BAR; }
    }
    PG8_WAIT_V(0);
    if constexpr (!ALIGN_EPI) { if (wr == 0) PG8_BAR; }
    PG8_BAR;
    if constexpr (Epi::AFTER_DRAIN) { E.fused(acc, cur, wr, wc, fr, fq, lds, wid, lane); S.done(cur); }
#undef PG8_SA
#undef PG8_SB
#undef PG8_STAGE
#undef PG8_LDA
#undef PG8_LDB
#undef PG8_MMA
#undef PG8_WAIT_V
#undef PG8_WAIT_L
#undef PG8_BAR
#undef PG8_SCHED
}
}

#ifndef PG8_SP2
#define PG8_SP2 true
#endif
#ifndef MK_PER_PHASE
#define MK_PER_PHASE 0
#endif

namespace mk {
using pg8::bf16x8; using pg8::f32x4; using pg8::u32x4; using pg8::Unit; using pg8::Gemm; using pg8::StaticOrder;
typedef unsigned short bf16;
typedef float f32x16 __attribute__((ext_vector_type(16)));
typedef unsigned u32x2 __attribute__((ext_vector_type(2)));
typedef float f32x2_t __attribute__((ext_vector_type(2)));
typedef __bf16 bf16x2_t __attribute__((ext_vector_type(2)));
#define LAS __attribute__((address_space(3)))
#define LDS_WAIT() asm volatile("s_waitcnt lgkmcnt(0)" ::: "memory")

constexpr int NB = 4, SEQ = 8192, DM = 1024, MTOK = NB * SEQ, DFF = 2816;
constexpr float EPS = 1e-6f, NEGF = -1e30f;
constexpr int NPHASE = 15;
constexpr int NWAVES = 8;
constexpr size_t MiB = 1u << 20;
constexpr size_t SZ_WGU = (size_t)5632 * 1024 * 2, SZ_WD = (size_t)1024 * 2816 * 2, SZ_WIN = (size_t)3840 * 1024 * 2;
constexpr size_t O_WGU1 = 0, O_WD1 = O_WGU1 + SZ_WGU, O_WGU2 = O_WD1 + SZ_WD, O_WD2 = O_WGU2 + SZ_WGU, O_WIN = O_WD2 + SZ_WD,
                 O_WPN = O_WIN + SZ_WIN, O_WPM = O_WPN + MiB, O_WOUT = O_WPM + MiB, O_WUQ = O_WOUT + 2 * MiB, O_WUKV = O_WUQ + 768 * 256 * 2,
                 O_CW1K = O_WUKV + 1024 * 128 * 2, O_CW1V = O_CW1K + MiB, O_WEND = O_CW1V + MiB;
static_assert(O_WEND <= 48 * MiB - 4096, "weights");
constexpr size_t O_CTL = 48 * MiB - 4096;
constexpr size_t O_A1 = 48 * MiB;
constexpr size_t O_IM2K = 48 * MiB, O_IM2V = 64 * MiB, O_CQN = 80 * MiB, O_CKVN = 96 * MiB, O_KR = 104 * MiB, O_HK = 106 * MiB, O_HV = 108 * MiB,
                 O_KC = 110 * MiB, O_VCT = 110 * MiB + 512 * 1024;
constexpr size_t O_MG = 48 * MiB;
constexpr size_t O_H = 112 * MiB;
constexpr size_t O_Z1 = 112 * MiB, O_QN = 192 * MiB, O_YM = 224 * MiB, O_KM = 256 * MiB;
constexpr size_t O_F = 288 * MiB, O_GM = 288 * MiB;
constexpr size_t O_QM = 416 * MiB, O_VTM = 464 * MiB, O_VTS = 496 * MiB, O_VTW = 504 * MiB, O_END = 512 * MiB;
constexpr int Z1P = 1280;
constexpr int LDS_BYTES = 147456;
constexpr int L_KB = 0, KB_SZ = 13312, L_VB = 2 * KB_SZ, VB_SZ = 8704, L_IMP = L_VB + 2 * VB_SZ, IMP_P = 132, L_SELM = L_IMP + 64 * IMP_P * 4, L_WUN = L_SELM + 1024, L_ATT_END = L_WUN + 128;
static_assert(L_ATT_END <= 131072, "attention LDS");

__device__ __forceinline__ int mk_lane() { int l; asm volatile("v_mbcnt_lo_u32_b32 %0, -1, 0\n\tv_mbcnt_hi_u32_b32 %0, -1, %0" : "=v"(l)); return l; }
__device__ __forceinline__ void grid_barrier(unsigned* ctr, unsigned target, int tid) {
    asm volatile("s_waitcnt vmcnt(0)" ::: "memory");
    __syncthreads();
    if (tid == 0) {
        __builtin_amdgcn_fence(__ATOMIC_RELEASE, "agent");
        asm volatile("s_waitcnt vmcnt(0)" ::: "memory");
        __hip_atomic_fetch_add(ctr, 1u, __ATOMIC_RELAXED, __HIP_MEMORY_SCOPE_AGENT);
        while (__hip_atomic_load(ctr, __ATOMIC_RELAXED, __HIP_MEMORY_SCOPE_AGENT) < target) __builtin_amdgcn_s_sleep(2);
        __builtin_amdgcn_fence(__ATOMIC_ACQUIRE, "agent");
        asm volatile("s_waitcnt vmcnt(0)" ::: "memory");
    }
    __syncthreads();
}
__device__ __forceinline__ unsigned cvtpk(float lo, float hi) { f32x2_t v = {lo, hi}; bf16x2_t b = __builtin_convertvector(v, bf16x2_t); return __builtin_bit_cast(unsigned, b); }
__device__ __forceinline__ float bflo(unsigned w) { return __builtin_bit_cast(float, w << 16); }
__device__ __forceinline__ float bfhi(unsigned w) { return __builtin_bit_cast(float, w & 0xffff0000u); }
__device__ __forceinline__ float bf2f(bf16 b) { return __builtin_bit_cast(float, (unsigned)b << 16); }
__device__ __forceinline__ bf16 f2bf(float f) { return (bf16)(cvtpk(f, 0.f) & 0xffffu); }
__device__ __forceinline__ float wave_sum(float v) {
#pragma unroll
    for (int o = 1; o < 64; o <<= 1) v += __shfl_xor(v, o);
    return v;
}
__device__ __forceinline__ float sigmoidf(float x) { return 1.f / (1.f + __expf(-x)); }
__device__ __forceinline__ float gelu_tanh(float x) { const float u = 0.7978845608028654f * (x + 0.044715f * x * x * x); const float t = 1.f - 2.f / (__expf(2.f * u) + 1.f); return 0.5f * x * (1.f + t); }
__device__ __forceinline__ void rope_cs(int pos, int j, float& c, float& s) {
    const float freq = __builtin_amdgcn_exp2f(-(float)j * 0.8304820237218406f);
    const float ang = (float)pos * freq;
    double rev = (double)ang * 0.15915494309189535; rev -= __builtin_rint(rev);
    const float fr = (float)rev;
    s = __builtin_amdgcn_sinf(fr); c = __builtin_amdgcn_cosf(fr);
}

struct MapPlain { __device__ __forceinline__ int col(int r) const { return r; } __device__ __forceinline__ int drow(int r) const { return r; } };
struct MapGU { int sel; __device__ __forceinline__ int col(int r) const { return r; } __device__ __forceinline__ int drow(int r) const { return (r >> 7) * 256 + sel * 128 + (r & 127); } };
struct MapWin { __device__ __forceinline__ int drow(int r) const { return r; } __device__ __forceinline__ int col(int r) const {
    int col;
    if (r < 1280) col = r; else if (r < 1536) col = 1304 + (r - 1280); else if (r < 1664) col = 1560 + (r - 1536); else if (r < 1696) col = 1688 + (r - 1664);
    else if (r < 1720) col = 1280 + (r - 1696); else if (r < 1792) col = -1; else col = 1720 + (r - 1792);
    return col; } };
struct MapUkv { __device__ __forceinline__ int drow(int r) const { return r; } __device__ __forceinline__ int col(int r) const {
    if (r < 512) return (r >> 6) * 128 + (r & 63); const int rr = r - 512; return (rr >> 6) * 128 + 64 + (rr & 63); } };
template <class Map> __device__ __forceinline__ void transpose_mat(const float* W, int N, const Map mp, int K, int Nvirt, bf16* WT, LAS float* scr, int gw, int NGW, int lane) {
    const int nblk = Nvirt / 32, nitems = (K / 64) * nblk;
    for (int it = gw; it < nitems; it += NGW) {
        const int kb = it / nblk, nb = it % nblk, k0 = 64 * kb, n0 = 32 * nb;
        const int col = mp.col(n0 + (lane & 31));
#pragma unroll 8
        for (int i = 0; i < 32; ++i) { const int kk = 2 * i + (lane >> 5); scr[kk * 33 + (lane & 31)] = (col >= 0) ? W[(size_t)(k0 + kk) * N + col] : 0.f; }
        LDS_WAIT();
        const int c = lane & 7;
#pragma unroll
        for (int j = 0; j < 4; ++j) { const int n = (lane >> 3) + 8 * j; const LAS float* s = scr + (8 * c) * 33 + n;
            u32x4 o; o.x = cvtpk(s[0 * 33], s[1 * 33]); o.y = cvtpk(s[2 * 33], s[3 * 33]); o.z = cvtpk(s[4 * 33], s[5 * 33]); o.w = cvtpk(s[6 * 33], s[7 * 33]);
            *(u32x4*)(WT + (size_t)mp.drow(n0 + n) * K + k0 + 8 * c) = o; }
        LDS_WAIT();
    }
}

__device__ __forceinline__ void rms_row_to_bf16(const f32x4 (&v)[4], const float* gain, bf16* orow, int lane) {
    float ss = 0.f;
#pragma unroll
    for (int j = 0; j < 4; ++j) ss += (v[j].x * v[j].x + v[j].y * v[j].y) + (v[j].z * v[j].z + v[j].w * v[j].w);
    const float r = rsqrtf(wave_sum(ss) * (1.f / DM) + EPS);
#pragma unroll
    for (int j = 0; j < 4; ++j) { const f32x4 g = *(const f32x4*)(gain + 4 * (lane + 64 * j)); const f32x4 o = v[j] * r * g;
        u32x2 w; w.x = cvtpk(o.x, o.y); w.y = cvtpk(o.z, o.w); *(u32x2*)(orow + 4 * (lane + 64 * j)) = w; }
}
template <bool NEXT> __device__ __forceinline__ void rowop(const float* F, const float* base, float coef, const float* gpost, float* xout, const float* gnext, bf16* A1, int gw, int NGW, int lane) {
    for (int m = gw; m < MTOK; m += NGW) {
        const f32x4* fr = (const f32x4*)(F + (size_t)m * DM) + lane; const f32x4* br = (const f32x4*)(base + (size_t)m * DM) + lane;
        f32x4 v[4], bs[4]; float ss = 0.f;
#pragma unroll
        for (int j = 0; j < 4; ++j) { v[j] = fr[64 * j]; bs[j] = br[64 * j]; ss += (v[j].x * v[j].x + v[j].y * v[j].y) + (v[j].z * v[j].z + v[j].w * v[j].w); }
        const float r = rsqrtf(wave_sum(ss) * (1.f / DM) + EPS) * coef;
#pragma unroll
        for (int j = 0; j < 4; ++j) { const f32x4 g = *(const f32x4*)(gpost + 4 * (lane + 64 * j)); v[j] = bs[j] + v[j] * r * g; *((f32x4*)(xout + (size_t)m * DM) + lane + 64 * j) = v[j]; }
        if (NEXT) rms_row_to_bf16(v, gnext, A1 + (size_t)m * DM, lane);
    }
}

#define EPI_ROW(ai, m) ((size_t)u.pm * 256 + (ai) * 128 + wr * 64 + (m) * 16 + fr)
#define EPI_CIN(bj, n) ((bj) * 128 + wc * 32 + (n) * 16 + fq * 4)
struct EpiSwiglu { static constexpr bool PERM = false, AFTER_DRAIN = false; bf16* H;
    __device__ __forceinline__ void operator()(const f32x4 (&acc)[2][2][4][2], const Unit& u, int wr, int wc, int fr, int fq) const {
#pragma unroll
        for (int ai = 0; ai < 2; ++ai)
#pragma unroll
            for (int m = 0; m < 4; ++m) { bf16* rp = H + EPI_ROW(ai, m) * DFF + u.pn * 128 + wc * 32 + fq * 4;
#pragma unroll
                for (int n = 0; n < 2; ++n) { const f32x4 g = acc[ai][0][m][n], up = acc[ai][1][m][n]; float v[4];
#pragma unroll
                    for (int e = 0; e < 4; ++e) v[e] = g[e] / (1.f + __expf(-g[e])) * up[e];
                    u32x2 w; w.x = cvtpk(v[0], v[1]); w.y = cvtpk(v[2], v[3]); *(u32x2*)(rp + n * 16) = w; } }
    }
};
struct EpiF32 { static constexpr bool PERM = false, AFTER_DRAIN = false; float* F; int ldc;
    __device__ __forceinline__ void operator()(const f32x4 (&acc)[2][2][4][2], const Unit& u, int wr, int wc, int fr, int fq) const {
#pragma unroll
        for (int ai = 0; ai < 2; ++ai)
#pragma unroll
            for (int m = 0; m < 4; ++m) { float* rp = F + EPI_ROW(ai, m) * ldc + u.pn * 256;
#pragma unroll
                for (int bj = 0; bj < 2; ++bj)
#pragma unroll
                    for (int n = 0; n < 2; ++n) *(f32x4*)(rp + EPI_CIN(bj, n)) = acc[ai][bj][m][n]; }
    }
};
struct EpiWin { static constexpr bool PERM = false, AFTER_DRAIN = false; bf16* QN; bf16* Z1; bf16* GM; bf16* VTS; bf16* VTW;
    __device__ __forceinline__ void operator()(const f32x4 (&acc)[2][2][4][2], const Unit& u, int wr, int wc, int fr, int fq) const {
        const int pn = u.pn;
#pragma unroll
        for (int ai = 0; ai < 2; ++ai)
#pragma unroll
            for (int m = 0; m < 4; ++m) { const size_t row = EPI_ROW(ai, m);
#pragma unroll
                for (int bj = 0; bj < 2; ++bj)
#pragma unroll
                    for (int n = 0; n < 2; ++n) { const int cin = EPI_CIN(bj, n); f32x4 v = acc[ai][bj][m][n];
                        if ((pn == 3 || pn == 4) && bj == 1) {
                            bf16* vt = (pn == 3) ? VTS : VTW; const int b = (int)(row >> 13), s = (int)(row & 8191), cv = cin - 128;
#pragma unroll
                            for (int e = 0; e < 4; ++e) vt[((size_t)(b * 128 + cv + e)) * SEQ + s] = f2bf(v[e]);
                        } else {
                            bf16* dst;
                            if (pn < 2) { dst = QN + row * 512 + pn * 256 + cin; v = v * 0.18033688011112042f; }
                            else if (pn < 7) dst = Z1 + row * Z1P + (pn - 2) * 256 + cin;
                            else dst = GM + row * 2048 + (pn - 7) * 256 + cin;
                            u32x2 w; w.x = cvtpk(v[0], v[1]); w.y = cvtpk(v[2], v[3]); *(u32x2*)dst = w;
                        } } }
    }
};
struct EpiGelu { static constexpr bool PERM = false, AFTER_DRAIN = false; bf16* O; int ldc;
    __device__ __forceinline__ void operator()(const f32x4 (&acc)[2][2][4][2], const Unit& u, int wr, int wc, int fr, int fq) const {
#pragma unroll
        for (int ai = 0; ai < 2; ++ai)
#pragma unroll
            for (int m = 0; m < 4; ++m) { bf16* rp = O + EPI_ROW(ai, m) * ldc + u.pn * 256;
#pragma unroll
                for (int bj = 0; bj < 2; ++bj)
#pragma unroll
                    for (int n = 0; n < 2; ++n) { const f32x4 v = acc[ai][bj][m][n];
                        u32x2 w; w.x = cvtpk(gelu_tanh(v[0]), gelu_tanh(v[1])); w.y = cvtpk(gelu_tanh(v[2]), gelu_tanh(v[3])); *(u32x2*)(rp + EPI_CIN(bj, n)) = w; } }
    }
};
struct EpiQup { static constexpr bool PERM = false, AFTER_DRAIN = false; bf16* QM;
    __device__ __forceinline__ void operator()(const f32x4 (&acc)[2][2][4][2], const Unit& u, int wr, int wc, int fr, int fq) const {
        const float sc = 0.14724445614104196f;
#pragma unroll
        for (int ai = 0; ai < 2; ++ai)
#pragma unroll
            for (int m = 0; m < 4; ++m) { bf16* rp = QM + EPI_ROW(ai, m) * 768 + u.pn * 256;
#pragma unroll
                for (int bj = 0; bj < 2; ++bj)
#pragma unroll
                    for (int n = 0; n < 2; ++n) { const f32x4 v = acc[ai][bj][m][n] * sc;
                        u32x2 w; w.x = cvtpk(v[0], v[1]); w.y = cvtpk(v[2], v[3]); *(u32x2*)(rp + EPI_CIN(bj, n)) = w; } }
    }
};
struct EpiKVup { static constexpr bool PERM = false, AFTER_DRAIN = false; bf16* KM; bf16* VTM;
    __device__ __forceinline__ void operator()(const f32x4 (&acc)[2][2][4][2], const Unit& u, int wr, int wc, int fr, int fq) const {
        const int pn = u.pn;
#pragma unroll
        for (int ai = 0; ai < 2; ++ai)
#pragma unroll
            for (int m = 0; m < 4; ++m) { const size_t row = EPI_ROW(ai, m);
#pragma unroll
                for (int bj = 0; bj < 2; ++bj)
#pragma unroll
                    for (int n = 0; n < 2; ++n) { const int cin = EPI_CIN(bj, n); const f32x4 v = acc[ai][bj][m][n];
                        if (pn < 2) { u32x2 w; w.x = cvtpk(v[0], v[1]); w.y = cvtpk(v[2], v[3]); *(u32x2*)(KM + row * 512 + pn * 256 + cin) = w; }
                        else { const int b = (int)(row >> 13), s = (int)(row & 8191), cv = (pn - 2) * 256 + cin;
#pragma unroll
                            for (int e = 0; e < 4; ++e) VTM[((size_t)(b * 512 + cv + e)) * SEQ + s] = f2bf(v[e]); } } }
    }
};
template <bool SECOND> struct EpiProj { static constexpr bool PERM = false, AFTER_DRAIN = false; const bf16* GM; bf16* MG;
    __device__ __forceinline__ void operator()(const f32x4 (&acc)[2][2][4][2], const Unit& u, int wr, int wc, int fr, int fq) const {
#pragma unroll
        for (int ai = 0; ai < 2; ++ai)
#pragma unroll
            for (int m = 0; m < 4; ++m) { const size_t row = EPI_ROW(ai, m);
#pragma unroll
                for (int bj = 0; bj < 2; ++bj)
#pragma unroll
                    for (int n = 0; n < 2; ++n) { const int col = u.pn * 256 + EPI_CIN(bj, n); const f32x4 v = acc[ai][bj][m][n];
                        const u32x2 gw = *(const u32x2*)(GM + row * 2048 + (SECOND ? 1024 : 0) + col);
                        float o0 = sigmoidf(bflo(gw.x)) * v[0], o1 = sigmoidf(bfhi(gw.x)) * v[1], o2 = sigmoidf(bflo(gw.y)) * v[2], o3 = sigmoidf(bfhi(gw.y)) * v[3];
                        bf16* dst = MG + row * DM + col;
                        if (SECOND) { const u32x2 pw = *(const u32x2*)dst; o0 += bflo(pw.x); o1 += bfhi(pw.x); o2 += bflo(pw.y); o3 += bfhi(pw.y); }
                        u32x2 w; w.x = cvtpk(o0, o1); w.y = cvtpk(o2, o3); *(u32x2*)dst = w; } }
    }
};

__device__ __forceinline__ int crow(int r, int hi) { return (r & 3) + 8 * (r >> 2) + 4 * hi; }
template <int ND0> __device__ __forceinline__ f32x16 qk_sub(const LAS char* Kt, int pitch, int sub, const bf16x8* qr, const f32x16& cin, int r32, int hi) {
    f32x16 acc = cin;
    const LAS char* kb = Kt + (sub * 32 + r32) * pitch + hi * 16;
#pragma unroll
    for (int d0 = 0; d0 < ND0; ++d0) { const bf16x8 kf = *(const LAS bf16x8*)(kb + d0 * 32); acc = __builtin_amdgcn_mfma_f32_32x32x16_bf16(kf, qr[d0], acc, 0, 0, 0); }
    return acc;
}
__device__ __forceinline__ void fill16(f32x16& a, float v) {
#pragma unroll
    for (int r = 0; r < 16; ++r) a[r] = v;
}
__device__ __forceinline__ void pv_sub(f32x16& o0, f32x16& o1, const LAS char* Vt, int sub, const f32x16& p, int r32, int hi) {
#pragma unroll
    for (int j = 0; j < 2; ++j) {
        u32x4 pw; pw.x = cvtpk(p[8 * j + 0], p[8 * j + 1]); pw.y = cvtpk(p[8 * j + 2], p[8 * j + 3]); pw.z = cvtpk(p[8 * j + 4], p[8 * j + 5]); pw.w = cvtpk(p[8 * j + 6], p[8 * j + 7]);
        const bf16x8 pb = __builtin_bit_cast(bf16x8, pw);
#pragma unroll
        for (int dblk = 0; dblk < 2; ++dblk) {
            const LAS char* vp = Vt + (32 * dblk + r32) * 136 + (32 * sub + 16 * j + 4 * hi) * 2;
            const u32x2 lo = *(const LAS u32x2*)vp, h2 = *(const LAS u32x2*)(vp + 16);
            u32x4 vw; vw.x = lo.x; vw.y = lo.y; vw.z = h2.x; vw.w = h2.y;
            const bf16x8 vf = __builtin_bit_cast(bf16x8, vw);
            if (dblk == 0) o0 = __builtin_amdgcn_mfma_f32_32x32x16_bf16(vf, pb, o0, 0, 0, 0); else o1 = __builtin_amdgcn_mfma_f32_32x32x16_bf16(vf, pb, o1, 0, 0, 0);
        }
    }
}
__device__ __forceinline__ bool sm_tile(f32x16& s0, f32x16& s1, float& mref, float& thr, float& l, f32x16& o0, f32x16& o1) {
    float mx = fmaxf(s0[0], s1[0]);
#pragma unroll
    for (int r = 1; r < 16; ++r) mx = fmaxf(mx, fmaxf(s0[r], s1[r]));
    mx = fmaxf(mx, __shfl_xor(mx, 32));
    bool ch = false;
    if (__any(mx > thr)) {
        const bool up = mx > thr; const float d = up ? mx : 0.f; const float alpha = (thr > 0.f) ? __builtin_amdgcn_exp2f(-d) : 1.f;
        mref += d; thr = up ? 8.f : thr; l *= alpha;
#pragma unroll
        for (int r = 0; r < 16; ++r) { o0[r] *= alpha; o1[r] *= alpha; s0[r] -= d; s1[r] -= d; }
        ch = true;
    }
    float sum = 0.f;
#pragma unroll
    for (int r = 0; r < 16; ++r) { s0[r] = __builtin_amdgcn_exp2f(s0[r]); s1[r] = __builtin_amdgcn_exp2f(s1[r]); sum += s0[r] + s1[r]; }
    l += sum;
    return ch;
}
__device__ __forceinline__ void zero16(f32x16& a) {
#pragma unroll
    for (int r = 0; r < 16; ++r) a[r] = 0.f;
}

__device__ __forceinline__ void mla_unit(int b, int h, int qb, const bf16* QM, const bf16* KM, const bf16* KR, const bf16* VTM, bf16* YM, LAS char* lds, const int wid, const int lane) {
    const int tid = wid * 64 + lane, r32 = lane & 31, hi = lane >> 5;
    const int q0 = qb * 256 + wid * 32, t = q0 + r32;
    const size_t rowq = (size_t)b * SEQ + t;
    bf16x8 qr[6];
#pragma unroll
    for (int d0 = 0; d0 < 6; ++d0) qr[d0] = *(const bf16x8*)(QM + rowq * 768 + h * 96 + d0 * 16 + hi * 8);
    {
        u32x4 a = __builtin_bit_cast(u32x4, qr[4]), bb = __builtin_bit_cast(u32x4, qr[5]);
        float x1[8] = {bflo(a.x), bfhi(a.x), bflo(a.y), bfhi(a.y), bflo(a.z), bfhi(a.z), bflo(a.w), bfhi(a.w)};
        float x2[8] = {bflo(bb.x), bfhi(bb.x), bflo(bb.y), bfhi(bb.y), bflo(bb.z), bfhi(bb.z), bflo(bb.w), bfhi(bb.w)};
#pragma unroll
        for (int e = 0; e < 8; ++e) { float cs, sn; rope_cs(t, 8 * hi + e, cs, sn); const float y1 = x1[e] * cs - x2[e] * sn, y2 = x1[e] * sn + x2[e] * cs; x1[e] = y1; x2[e] = y2; }
        a.x = cvtpk(x1[0], x1[1]); a.y = cvtpk(x1[2], x1[3]); a.z = cvtpk(x1[4], x1[5]); a.w = cvtpk(x1[6], x1[7]);
        bb.x = cvtpk(x2[0], x2[1]); bb.y = cvtpk(x2[2], x2[3]); bb.z = cvtpk(x2[4], x2[5]); bb.w = cvtpk(x2[6], x2[7]);
        qr[4] = __builtin_bit_cast(bf16x8, a); qr[5] = __builtin_bit_cast(bf16x8, bb);
    }
    float mref = 0.f, thr = -1e29f, l = 0.f; f32x16 o0, o1, cinit; zero16(o0); zero16(o1); zero16(cinit);
    const int NT = (qb + 1) * 4;
    const bf16* ksrc = KM + ((size_t)b * SEQ + (tid >> 3)) * 512 + h * 64 + (tid & 7) * 8;
    const bf16* rsrc = KR + ((size_t)b * SEQ + ((tid & 255) >> 2)) * 32 + (tid & 3) * 8;
    const bf16* vsrc = VTM + ((size_t)(b * 8 + h) * 64 + (tid >> 3)) * SEQ + (tid & 7) * 8;
    const int kdst = (tid >> 3) * 208 + (tid & 7) * 16, rdst = ((tid & 255) >> 2) * 208 + 128 + (tid & 3) * 16, vdst = (tid >> 3) * 136 + (tid & 7) * 16;
    u32x4 sk, sr, sv;
#define MLA_LOAD(it) do { sk = *(const u32x4*)(ksrc + (size_t)(it) * 64 * 512); if (tid < 256) sr = *(const u32x4*)(rsrc + (size_t)(it) * 64 * 32); sv = *(const u32x4*)(vsrc + (it) * 64); } while (0)
#define MLA_STORE(buf) do { *(LAS u32x4*)(lds + L_KB + (buf) * KB_SZ + kdst) = sk; if (tid < 256) *(LAS u32x4*)(lds + L_KB + (buf) * KB_SZ + rdst) = sr; \
        LAS char* vp_ = lds + L_VB + (buf) * VB_SZ + vdst; u32x2 a_; a_.x = sv.x; a_.y = sv.y; *(LAS u32x2*)vp_ = a_; a_.x = sv.z; a_.y = sv.w; *(LAS u32x2*)(vp_ + 8) = a_; } while (0)
    sr = (u32x4){0u, 0u, 0u, 0u};
    MLA_LOAD(0); MLA_STORE(0); __syncthreads();
    for (int it = 0; it < NT; ++it) {
        const bool more = it + 1 < NT;
        if (more) MLA_LOAD(it + 1);
        const int kv0 = it * 64;
        if (kv0 <= q0 + 31) {
            const LAS char* Kb = lds + L_KB + (it & 1) * KB_SZ; const LAS char* Vb = lds + L_VB + (it & 1) * VB_SZ;
            f32x16 s0 = qk_sub<6>(Kb, 208, 0, qr, cinit, r32, hi), s1 = qk_sub<6>(Kb, 208, 1, qr, cinit, r32, hi);
            if (kv0 + 63 > q0) {
#pragma unroll
                for (int r = 0; r < 16; ++r) { const int kp = kv0 + crow(r, hi); if (kp > t) s0[r] = NEGF; if (kp + 32 > t) s1[r] = NEGF; }
            }
            if (sm_tile(s0, s1, mref, thr, l, o0, o1)) fill16(cinit, -mref);
            pv_sub(o0, o1, Vb, 0, s0, r32, hi); pv_sub(o0, o1, Vb, 1, s1, r32, hi);
        }
        if (more) MLA_STORE((it + 1) & 1);
        __syncthreads();
    }
#undef MLA_LOAD
#undef MLA_STORE
    l += __shfl_xor(l, 32);
    const float inv = 1.f / l;
    bf16* orow = YM + rowq * 512 + h * 64 + 4 * hi;
#pragma unroll
    for (int a = 0; a < 4; ++a) {
        u32x2 w; w.x = cvtpk(o0[4 * a] * inv, o0[4 * a + 1] * inv); w.y = cvtpk(o0[4 * a + 2] * inv, o0[4 * a + 3] * inv); *(u32x2*)(orow + 8 * a) = w;
        w.x = cvtpk(o1[4 * a] * inv, o1[4 * a + 1] * inv); w.y = cvtpk(o1[4 * a + 2] * inv, o1[4 * a + 3] * inv); *(u32x2*)(orow + 32 + 8 * a) = w;
    }
}

__device__ __forceinline__ int next_set(unsigned long long u0, unsigned long long u1, int from) {
    if (from < 64) { const unsigned long long x = u0 >> from; if (x) return from + __builtin_ctzll(x); from = 64; }
    if (from < 128) { const unsigned long long x = u1 >> (from - 64); if (x) return from + __builtin_ctzll(x); }
    return 128;
}
__device__ __forceinline__ void nsa_unit(int b, int g, int tile, bf16* QN  , const bf16* Z1, const bf16* KC, const bf16* VCT, const bf16* VTS, const bf16* VTW, LAS char* lds, const int wid, const int lane) {
    const int tid = wid * 64 + lane, r32 = lane & 31, hi = lane >> 5;
    const int t0 = tile * 64, cur = tile, tl = r32 >> 2, hh = r32 & 3, head = 4 * g + hh, tok = 8 * wid + tl, t = t0 + tok, bg = b * 2 + g;
    const size_t rowq = (size_t)b * SEQ + t;
    bf16x8 qr[4];
#pragma unroll
    for (int d0 = 0; d0 < 4; ++d0) qr[d0] = *(const bf16x8*)(QN + rowq * 512 + head * 64 + d0 * 16 + hi * 8);
    const float slope = __builtin_amdgcn_exp2f(-(float)(head + 1)) * 1.4426950408889634f;
    f32x16 czero; zero16(czero);
    const bf16* gz = Z1 + rowq * Z1P + 1184 + head * 3;
    const float g0 = sigmoidf(bf2f(gz[0])), g1 = sigmoidf(bf2f(gz[1])), g2 = sigmoidf(bf2f(gz[2]));
    LAS float* imp = (LAS float*)(lds + L_IMP);
    LAS unsigned* selm = (LAS unsigned*)(lds + L_SELM);
    LAS unsigned* wun = (LAS unsigned*)(lds + L_WUN);
    for (int i = lane; i < 8 * IMP_P; i += 64) imp[8 * wid * IMP_P + i] = 0.f;
    f32x16 out0, out1; zero16(out0); zero16(out1);
    const int krow = tid >> 3, kch = tid & 7;
    const int kdst = krow * 144 + kch * 16, vdst = krow * 136 + kch * 16;
    u32x4 sk, sv;
#define NSA_STORE(buf, withv) do { *(LAS u32x4*)(lds + L_KB + (buf) * KB_SZ + kdst) = sk; if (withv) { LAS char* vp_ = lds + L_VB + (buf) * VB_SZ + vdst; u32x2 a_; a_.x = sv.x; a_.y = sv.y; *(LAS u32x2*)vp_ = a_; a_.x = sv.z; a_.y = sv.w; *(LAS u32x2*)(vp_ + 8) = a_; } } while (0)

    const int ncmp = t0 / 16 + 3, nct = (ncmp + 63) / 64;
    const bf16* kcsrc = KC + ((size_t)bg * 512 + krow) * 64 + kch * 8;
    const bf16* vcsrc = VCT + ((size_t)bg * 64 + krow) * 512 + kch * 8;
    float mc = NEGF, lc = 0.f;
    {
        sk = *(const u32x4*)kcsrc; NSA_STORE(0, false); __syncthreads();
        for (int it = 0; it < nct; ++it) {
            const bool more = it + 1 < nct;
            if (more) sk = *(const u32x4*)(kcsrc + (size_t)(it + 1) * 64 * 64);
            const LAS char* Kb = lds + L_KB + (it & 1) * KB_SZ;
            f32x16 s0 = qk_sub<4>(Kb, 144, 0, qr, czero, r32, hi), s1 = qk_sub<4>(Kb, 144, 1, qr, czero, r32, hi);
            float mx = NEGF;
#pragma unroll
            for (int r = 0; r < 16; ++r) { const int i0 = it * 64 + crow(r, hi); const int d0_ = t - (16 * i0 + 31), d1_ = d0_ - 512;
                s0[r] = d0_ >= 0 ? s0[r] - slope * (float)d0_ : NEGF; s1[r] = d1_ >= 0 ? s1[r] - slope * (float)d1_ : NEGF; mx = fmaxf(mx, fmaxf(s0[r], s1[r])); }
            mx = fmaxf(mx, __shfl_xor(mx, 32));
            const float mn = fmaxf(mc, mx), alpha = __builtin_amdgcn_exp2f(mc - mn); mc = mn;
            float sum = 0.f;
#pragma unroll
            for (int r = 0; r < 16; ++r) { sum += (s0[r] > -1e29f ? __builtin_amdgcn_exp2f(s0[r] - mn) : 0.f) + (s1[r] > -1e29f ? __builtin_amdgcn_exp2f(s1[r] - mn) : 0.f); }
            lc = lc * alpha + sum;
            if (more) NSA_STORE((it + 1) & 1, false);
            __syncthreads();
        }
        lc += __shfl_xor(lc, 32);
    }
    {
        const float invl = 1.f / fmaxf(lc, 1e-30f);
        f32x16 o0, o1; zero16(o0); zero16(o1);
        sk = *(const u32x4*)kcsrc; sv = *(const u32x4*)vcsrc; NSA_STORE(0, true); __syncthreads();
        for (int it = 0; it < nct; ++it) {
            const bool more = it + 1 < nct;
            if (more) { sk = *(const u32x4*)(kcsrc + (size_t)(it + 1) * 64 * 64); sv = *(const u32x4*)(vcsrc + (it + 1) * 64); }
            const LAS char* Kb = lds + L_KB + (it & 1) * KB_SZ; const LAS char* Vb = lds + L_VB + (it & 1) * VB_SZ;
            f32x16 s0 = qk_sub<4>(Kb, 144, 0, qr, czero, r32, hi), s1 = qk_sub<4>(Kb, 144, 1, qr, czero, r32, hi);
#pragma unroll
            for (int r = 0; r < 16; ++r) { const int i0 = it * 64 + crow(r, hi); const int d0_ = t - (16 * i0 + 31), d1_ = d0_ - 512;
                s0[r] = d0_ >= 0 ? __builtin_amdgcn_exp2f(s0[r] - slope * (float)d0_ - mc) * invl : 0.f; s1[r] = d1_ >= 0 ? __builtin_amdgcn_exp2f(s1[r] - slope * (float)d1_ - mc) * invl : 0.f; }
            pv_sub(o0, o1, Vb, 0, s0, r32, hi); pv_sub(o0, o1, Vb, 1, s1, r32, hi);
#pragma unroll
            for (int sub = 0; sub < 2; ++sub) {
                f32x16 ps = sub ? s1 : s0;
#pragma unroll
                for (int r = 0; r < 16; ++r) { ps[r] += __shfl_xor(ps[r], 1); ps[r] += __shfl_xor(ps[r], 2); }
                LAS float* row = imp + tok * IMP_P + (it * 64 + sub * 32) / 4 + hi;
                if (hh == 0) {
#pragma unroll
                    for (int a = 0; a < 4; ++a) row[2 * a] += (ps[4 * a] + ps[4 * a + 1]) + (ps[4 * a + 2] + 0.5f * ps[4 * a + 3]);
                }
                LDS_WAIT();
                if (hh == 0) {
#pragma unroll
                    for (int a = 0; a < 4; ++a) row[2 * a + 1] += 0.5f * ps[4 * a + 3];
                }
                LDS_WAIT();
            }
            if (more) NSA_STORE((it + 1) & 1, true);
            __syncthreads();
        }
#pragma unroll
        for (int r = 0; r < 16; ++r) { out0[r] += g0 * o0[r]; out1[r] += g0 * o1[r]; }
    }
    {
        const int nlast = cur - 2;
#pragma unroll 1
        for (int tk = 0; tk < 8; ++tk) {
            const LAS float* row = imp + (8 * wid + tk) * IMP_P;
            const int j0 = lane, j1 = lane + 64; const float v0 = row[j0], v1 = row[j1];
            int c0 = 0, c1 = 0;
#pragma unroll 2
            for (int jj = 1; jj <= nlast; ++jj) { const float x = row[jj]; c0 += (x > v0 || (x == v0 && jj < j0)) ? 1 : 0; c1 += (x > v1 || (x == v1 && jj < j1)) ? 1 : 0; }
            const bool s0 = j0 >= 1 && j0 <= nlast && c0 < 13, s1 = j1 <= nlast && c1 < 13;
            unsigned long long m0 = __ballot(s0), m1 = __ballot(s1);
            m0 |= 1ull;
            if (cur < 64) m0 |= 1ull << cur; else m1 |= 1ull << (cur - 64);
            if (cur >= 1) { if (cur - 1 < 64) m0 |= 1ull << (cur - 1); else m1 |= 1ull << (cur - 65); }
            if (lane == 0) { selm[(8 * wid + tk) * 4 + 0] = (unsigned)m0; selm[(8 * wid + tk) * 4 + 1] = (unsigned)(m0 >> 32); selm[(8 * wid + tk) * 4 + 2] = (unsigned)m1; selm[(8 * wid + tk) * 4 + 3] = (unsigned)(m1 >> 32); }
        }
        LDS_WAIT();
        if (lane < 4) { unsigned x = 0; for (int tk = 0; tk < 8; ++tk) x |= selm[(8 * wid + tk) * 4 + lane]; wun[wid * 4 + lane] = x; }
        __syncthreads();
    }
    const unsigned long long tm0 = (unsigned long long)selm[tok * 4 + 0] | ((unsigned long long)selm[tok * 4 + 1] << 32), tm1 = (unsigned long long)selm[tok * 4 + 2] | ((unsigned long long)selm[tok * 4 + 3] << 32);
    unsigned long long wu0, wu1, gu0 = 0, gu1 = 0;
    {
        const unsigned a0 = __builtin_amdgcn_readfirstlane(wun[wid * 4 + 0]), a1 = __builtin_amdgcn_readfirstlane(wun[wid * 4 + 1]), a2 = __builtin_amdgcn_readfirstlane(wun[wid * 4 + 2]), a3 = __builtin_amdgcn_readfirstlane(wun[wid * 4 + 3]);
        wu0 = (unsigned long long)a0 | ((unsigned long long)a1 << 32); wu1 = (unsigned long long)a2 | ((unsigned long long)a3 << 32);
        for (int w = 0; w < 8; ++w) {
            const unsigned b0 = __builtin_amdgcn_readfirstlane(wun[w * 4 + 0]), b1 = __builtin_amdgcn_readfirstlane(wun[w * 4 + 1]), b2 = __builtin_amdgcn_readfirstlane(wun[w * 4 + 2]), b3 = __builtin_amdgcn_readfirstlane(wun[w * 4 + 3]);
            gu0 |= (unsigned long long)b0 | ((unsigned long long)b1 << 32); gu1 |= (unsigned long long)b2 | ((unsigned long long)b3 << 32);
        }
    }
    {
        const bf16* ksrc = Z1 + ((size_t)b * SEQ + krow) * Z1P + 256 + g * 64 + kch * 8;
        const bf16* vsrc = VTS + ((size_t)(b * 128 + g * 64 + krow)) * SEQ + kch * 8;
        float mref = 0.f, thr = -1e29f, l = 0.f; f32x16 o0, o1; zero16(o0); zero16(o1);
        const float sl4 = slope * (float)(4 * hi);
        int j = next_set(gu0, gu1, 0);
        sk = *(const u32x4*)(ksrc + (size_t)j * 64 * Z1P); sv = *(const u32x4*)(vsrc + j * 64); NSA_STORE(0, true); __syncthreads();
        int par = 0;
        while (j < 128) {
            const int nj = next_set(gu0, gu1, j + 1);
            const bool more = nj < 128;
            if (more) { sk = *(const u32x4*)(ksrc + (size_t)nj * 64 * Z1P); sv = *(const u32x4*)(vsrc + nj * 64); }
            const bool wsel = ((j < 64 ? (wu0 >> j) : (wu1 >> (j - 64))) & 1ull) != 0;
            if (wsel) {
                const LAS char* Kb = lds + L_KB + par * KB_SZ; const LAS char* Vb = lds + L_VB + par * VB_SZ;
                const bool tsel = ((j < 64 ? (tm0 >> j) : (tm1 >> (j - 64))) & 1ull) != 0;
                f32x16 cin; fill16(cin, tsel ? (sl4 - mref - slope * (float)(t - j * 64)) : NEGF);
                f32x16 s0 = qk_sub<4>(Kb, 144, 0, qr, cin, r32, hi), s1 = qk_sub<4>(Kb, 144, 1, qr, cin, r32, hi);
#pragma unroll
                for (int r = 0; r < 16; ++r) { s0[r] = __builtin_fmaf(slope, (float)((r & 3) + 8 * (r >> 2)), s0[r]); s1[r] = __builtin_fmaf(slope, (float)((r & 3) + 8 * (r >> 2) + 32), s1[r]); }
                if (j == cur) {
#pragma unroll
                    for (int r = 0; r < 16; ++r) { const int d0_ = t - (j * 64 + crow(r, hi)); if (d0_ < 0) s0[r] = NEGF; if (d0_ < 32) s1[r] = NEGF; }
                }
                sm_tile(s0, s1, mref, thr, l, o0, o1);
                pv_sub(o0, o1, Vb, 0, s0, r32, hi); pv_sub(o0, o1, Vb, 1, s1, r32, hi);
            }
            if (more) NSA_STORE(par ^ 1, true);
            __syncthreads();
            par ^= 1; j = nj;
        }
        l += __shfl_xor(l, 32);
        const float sc = g1 / fmaxf(l, 1e-30f);
#pragma unroll
        for (int r = 0; r < 16; ++r) { out0[r] += sc * o0[r]; out1[r] += sc * o1[r]; }
    }
    {
        const bf16* ksrc = Z1 + ((size_t)b * SEQ + krow) * Z1P + 512 + g * 64 + kch * 8;
        const bf16* vsrc = VTW + ((size_t)(b * 128 + g * 64 + krow)) * SEQ + kch * 8;
        float mref = 0.f, thr = -1e29f, l = 0.f; f32x16 o0, o1; zero16(o0); zero16(o1);
        const float sl4 = slope * (float)(4 * hi);
        const int tw0 = t0 + 8 * wid;
        const int kt_first = (t0 >= 512) ? (t0 - 512) / 64 : 0, kt_last = t0 / 64;
        sk = *(const u32x4*)(ksrc + (size_t)kt_first * 64 * Z1P); sv = *(const u32x4*)(vsrc + kt_first * 64); NSA_STORE(0, true); __syncthreads();
        int par = 0;
        for (int kt = kt_first; kt <= kt_last; ++kt) {
            const bool more = kt < kt_last;
            if (more) { sk = *(const u32x4*)(ksrc + (size_t)(kt + 1) * 64 * Z1P); sv = *(const u32x4*)(vsrc + (kt + 1) * 64); }
            const LAS char* Kb = lds + L_KB + par * KB_SZ; const LAS char* Vb = lds + L_VB + par * VB_SZ;
            f32x16 cin; fill16(cin, sl4 - mref - slope * (float)(t - kt * 64));
            f32x16 s0 = qk_sub<4>(Kb, 144, 0, qr, cin, r32, hi), s1 = qk_sub<4>(Kb, 144, 1, qr, cin, r32, hi);
#pragma unroll
            for (int r = 0; r < 16; ++r) { s0[r] = __builtin_fmaf(slope, (float)((r & 3) + 8 * (r >> 2)), s0[r]); s1[r] = __builtin_fmaf(slope, (float)((r & 3) + 8 * (r >> 2) + 32), s1[r]); }
            if (kt * 64 + 63 > tw0 || kt * 64 < tw0 + 7 - 511) {
#pragma unroll
                for (int r = 0; r < 16; ++r) { const int d0_ = t - (kt * 64 + crow(r, hi)), d1_ = d0_ - 32;
                    if (!(d0_ >= 0 && d0_ < 512)) s0[r] = NEGF; if (!(d1_ >= 0 && d1_ < 512)) s1[r] = NEGF; }
            }
            sm_tile(s0, s1, mref, thr, l, o0, o1);
            pv_sub(o0, o1, Vb, 0, s0, r32, hi); pv_sub(o0, o1, Vb, 1, s1, r32, hi);
            if (more) NSA_STORE(par ^ 1, true);
            __syncthreads();
            par ^= 1;
        }
        l += __shfl_xor(l, 32);
        const float sc = g2 / fmaxf(l, 1e-30f);
#pragma unroll
        for (int r = 0; r < 16; ++r) { out0[r] += sc * o0[r]; out1[r] += sc * o1[r]; }
    }
#undef NSA_STORE
    bf16* orow = QN + rowq * 512 + head * 64 + 4 * hi;
#pragma unroll
    for (int a = 0; a < 4; ++a) {
        u32x2 w; w.x = cvtpk(out0[4 * a], out0[4 * a + 1]); w.y = cvtpk(out0[4 * a + 2], out0[4 * a + 3]); *(u32x2*)(orow + 8 * a) = w;
        w.x = cvtpk(out1[4 * a], out1[4 * a + 1]); w.y = cvtpk(out1[4 * a + 2], out1[4 * a + 3]); *(u32x2*)(orow + 32 + 8 * a) = w;
    }
}

struct Args { const float* in[27]; float* out; unsigned char* ws; int ph_lo, ph_hi; };
enum { I_X = 0, I_F1PRE, I_F1POST, I_F1G, I_F1U, I_F1D, I_MPRE, I_MPOST, I_WIN, I_CPK, I_CW1K, I_CW2K, I_CPV, I_CW1V, I_CW2V, I_QNG, I_WUQ, I_KVNG, I_WUKV, I_WPN, I_WPM, I_WOUT, I_F2PRE, I_F2POST, I_F2G, I_F2U, I_F2D };

__global__ void __launch_bounds__(NWAVES * 64, 2) fwd_kernel(Args args) {
    extern __shared__ __attribute__((aligned(16))) unsigned char lds_raw[];
    LAS unsigned char* lds = (LAS unsigned char*)lds_raw;
    const int wave = __builtin_amdgcn_readfirstlane((int)threadIdx.x >> 6);
    const int G = gridDim.x, c = blockIdx.x;
    const int NGW = G * NWAVES, NGT = G * NWAVES * 64;
#define IDS() const int lane = mk_lane(); const int tid = wave * 64 + lane; const int gw = c * NWAVES + wave; const int gt = c * (NWAVES * 64) + tid; (void)tid; (void)gw; (void)gt
#define WGU1 ((bf16*)(args.ws + O_WGU1))
#define WD1 ((bf16*)(args.ws + O_WD1))
#define WGU2 ((bf16*)(args.ws + O_WGU2))
#define WD2 ((bf16*)(args.ws + O_WD2))
#define WIN ((bf16*)(args.ws + O_WIN))
#define WPN ((bf16*)(args.ws + O_WPN))
#define WPM ((bf16*)(args.ws + O_WPM))
#define WOUT ((bf16*)(args.ws + O_WOUT))
#define WUQ ((bf16*)(args.ws + O_WUQ))
#define WUKV ((bf16*)(args.ws + O_WUKV))
#define CW1K ((bf16*)(args.ws + O_CW1K))
#define CW1V ((bf16*)(args.ws + O_CW1V))
#define A1 ((bf16*)(args.ws + O_A1))
#define IM2K ((bf16*)(args.ws + O_IM2K))
#define IM2V ((bf16*)(args.ws + O_IM2V))
#define CQN ((bf16*)(args.ws + O_CQN))
#define CKVN ((bf16*)(args.ws + O_CKVN))
#define KR ((bf16*)(args.ws + O_KR))
#define HK ((bf16*)(args.ws + O_HK))
#define HV ((bf16*)(args.ws + O_HV))
#define KC ((bf16*)(args.ws + O_KC))
#define VCT ((bf16*)(args.ws + O_VCT))
#define MG ((bf16*)(args.ws + O_MG))
#define H ((bf16*)(args.ws + O_H))
#define Z1 ((bf16*)(args.ws + O_Z1))
#define QN ((bf16*)(args.ws + O_QN))
#define YM ((bf16*)(args.ws + O_YM))
#define KM ((bf16*)(args.ws + O_KM))
#define GM ((bf16*)(args.ws + O_GM))
#define QM ((bf16*)(args.ws + O_QM))
#define VTM ((bf16*)(args.ws + O_VTM))
#define VTS ((bf16*)(args.ws + O_VTS))
#define VTW ((bf16*)(args.ws + O_VTW))
#define F ((float*)(args.ws + O_F))
#define X (args.out)
    typedef const float* cfp_t;
    const __attribute__((address_space(4))) cfp_t* in = (const __attribute__((address_space(4))) cfp_t*)__builtin_amdgcn_kernarg_segment_ptr();
    asm volatile("" : "+s"(in));
    const int lo = args.ph_lo, hi_ph = args.ph_hi;
#define IN(k) (lo <= (k) && (k) < hi_ph)
    unsigned* const barctr = (unsigned*)(args.ws + O_CTL);
#if MK_PER_PHASE
#define SEAM(k) do { } while (0)
#else
    if (lo == 0 && hi_ph == NPHASE) { cg::grid_group grid = cg::this_grid(); grid.sync(); }
#define SEAM(k) do { if (IN(k) && IN((k) + 1)) { const int l_ = mk_lane(); grid_barrier(barctr, (unsigned)((k) + 1) * (unsigned)G, wave * 64 + l_); } } while (0)
#endif
#define GEMM_CALL(EPI, A_, B_, M_, N_, K_, cc, E_) do { Gemm g_{(const pg8::bf16_t*)(A_), (const pg8::bf16_t*)(B_), (M_), (N_), (K_)}; StaticOrder S_; S_.init((M_), (N_), G, (cc)); \
        const int l_ = mk_lane(); pg8::gemm_phase<EPI, StaticOrder, false, PG8_SP2>(lds, g_, S_, (E_), wave, l_); } while (0)

    if (IN(0)) {
        IDS();
        LAS float* scr = (LAS float*)(lds + wave * 16384);
        transpose_mat(in[I_F1G], DFF, MapGU{0}, 1024, DFF, WGU1, scr, gw, NGW, lane);
        transpose_mat(in[I_F1U], DFF, MapGU{1}, 1024, DFF, WGU1, scr, gw, NGW, lane);
        transpose_mat(in[I_F1D], 1024, MapPlain{}, 2816, 1024, WD1, scr, gw, NGW, lane);
        transpose_mat(in[I_WIN], 3768, MapWin{}, 1024, 3840, WIN, scr, gw, NGW, lane);
        transpose_mat(in[I_F2G], DFF, MapGU{0}, 1024, DFF, WGU2, scr, gw, NGW, lane);
        transpose_mat(in[I_F2U], DFF, MapGU{1}, 1024, DFF, WGU2, scr, gw, NGW, lane);
        transpose_mat(in[I_F2D], 1024, MapPlain{}, 2816, 1024, WD2, scr, gw, NGW, lane);
        transpose_mat(in[I_WPN], 1024, MapPlain{}, 512, 1024, WPN, scr, gw, NGW, lane);
        transpose_mat(in[I_WPM], 1024, MapPlain{}, 512, 1024, WPM, scr, gw, NGW, lane);
        transpose_mat(in[I_WOUT], 1024, MapPlain{}, 1024, 1024, WOUT, scr, gw, NGW, lane);
        transpose_mat(in[I_WUQ], 768, MapPlain{}, 256, 768, WUQ, scr, gw, NGW, lane);
        transpose_mat(in[I_WUKV], 1024, MapUkv{}, 128, 1024, WUKV, scr, gw, NGW, lane);
        transpose_mat(in[I_CW1K], 256, MapPlain{}, 2048, 256, CW1K, scr, gw, NGW, lane);
        transpose_mat(in[I_CW1V], 256, MapPlain{}, 2048, 256, CW1V, scr, gw, NGW, lane);
        for (int m = gw; m < MTOK; m += NGW) { const f32x4* xr = (const f32x4*)(in[I_X] + (size_t)m * DM) + lane; f32x4 v[4];
#pragma unroll
            for (int j = 0; j < 4; ++j) v[j] = xr[64 * j];
            rms_row_to_bf16(v, in[I_F1PRE], A1 + (size_t)m * DM, lane); }
        __syncthreads();
    }
    SEAM(0);
    if (IN(1)) GEMM_CALL(EpiSwiglu, A1, WGU1, MTOK, 5632, 1024, c, (EpiSwiglu{H}));
    SEAM(1);
#ifdef PROBE_FFN2
    if (IN(2)) GEMM_CALL(EpiF32, H, WD1, MTOK, 1024, 2816, c, (EpiF32{F, DM}));
    if (IN(1)) GEMM_CALL(EpiSwiglu, A1, WGU1, MTOK, 5632, 1024, c, (EpiSwiglu{H}));
#endif
    if (IN(2)) GEMM_CALL(EpiF32, H, WD1, MTOK, 1024, 2816, c, (EpiF32{F, DM}));
    SEAM(2);
    if (IN(3)) { IDS(); rowop<true>(F, in[I_X], 0.5f, in[I_F1POST], X, in[I_MPRE], A1, gw, NGW, lane); }
    SEAM(3);
    if (IN(4)) GEMM_CALL(EpiWin, A1, WIN, MTOK, 3840, 1024, c, (EpiWin{QN, Z1, GM, VTS, VTW}));
    SEAM(4);
    if (IN(5)) {
        IDS();
        for (int ch = gt; ch < 2 * 4096 * 256; ch += NGT) {
            const int kv = ch >> 20, r = (ch >> 8) & 4095, c8 = ch & 255, l = c8 >> 3, d0 = (c8 & 7) * 8, bgi = r >> 9, i = r & 511, b = bgi >> 1, g = bgi & 1;
            u32x4 o = (u32x4){0u, 0u, 0u, 0u};
            if (i < 511) {
                const u32x4 z = *(const u32x4*)(Z1 + ((size_t)b * SEQ + 16 * i + l) * Z1P + kv * 128 + g * 64 + d0);
                const float* pe = (kv ? in[I_CPV] : in[I_CPK]) + l * 64 + d0; const f32x4 p0 = *(const f32x4*)pe, p1 = *(const f32x4*)(pe + 4);
                o.x = cvtpk(bflo(z.x) + p0.x, bfhi(z.x) + p0.y); o.y = cvtpk(bflo(z.y) + p0.z, bfhi(z.y) + p0.w); o.z = cvtpk(bflo(z.z) + p1.x, bfhi(z.z) + p1.y); o.w = cvtpk(bflo(z.w) + p1.z, bfhi(z.w) + p1.w);
            }
            *(u32x4*)((kv ? IM2V : IM2K) + (size_t)r * 2048 + c8 * 8) = o;
        }
        for (int m = gw; m < MTOK; m += NGW) {
            const bf16* zr = Z1 + (size_t)m * Z1P;
            { const u32x2 w = *(const u32x2*)(zr + 768 + 4 * lane); const float a0 = bflo(w.x), a1 = bfhi(w.x), a2 = bflo(w.y), a3 = bfhi(w.y);
              const float r = rsqrtf(wave_sum((a0 * a0 + a1 * a1) + (a2 * a2 + a3 * a3)) * (1.f / 256.f) + EPS); const f32x4 gq = *(const f32x4*)(in[I_QNG] + 4 * lane);
              u32x2 o; o.x = cvtpk(a0 * r * gq.x, a1 * r * gq.y); o.y = cvtpk(a2 * r * gq.z, a3 * r * gq.w); *(u32x2*)(CQN + (size_t)m * 256 + 4 * lane) = o; }
            { const unsigned w = *(const unsigned*)(zr + 1024 + 2 * lane); const float a0 = bflo(w), a1 = bfhi(w);
              const float r = rsqrtf(wave_sum(a0 * a0 + a1 * a1) * (1.f / 128.f) + EPS); const float gk0 = in[I_KVNG][2 * lane], gk1 = in[I_KVNG][2 * lane + 1];
              *(unsigned*)(CKVN + (size_t)m * 128 + 2 * lane) = cvtpk(a0 * r * gk0, a1 * r * gk1); }
            if (lane < 16) { const float x1 = bf2f(zr[1152 + lane]), x2 = bf2f(zr[1152 + 16 + lane]); float cs, sn; rope_cs(m & 8191, lane, cs, sn);
              KR[(size_t)m * 32 + lane] = f2bf(x1 * cs - x2 * sn); KR[(size_t)m * 32 + 16 + lane] = f2bf(x1 * sn + x2 * cs); }
        }
    }
    SEAM(5);
    if (IN(6)) {
        GEMM_CALL(EpiGelu, IM2K, CW1K, 4096, 256, 2048, c, (EpiGelu{HK, 256}));
        GEMM_CALL(EpiGelu, IM2V, CW1V, 4096, 256, 2048, (c + G / 2) % G, (EpiGelu{HV, 256}));
        GEMM_CALL(EpiQup, CQN, WUQ, MTOK, 768, 256, c, (EpiQup{QM}));
        GEMM_CALL(EpiKVup, CKVN, WUKV, MTOK, 1024, 128, c, (EpiKVup{KM, VTM}));
    }
    SEAM(6);
    if (IN(7)) {
        IDS();
        for (int idx = gt; idx < 2 * 4096 * 64; idx += NGT) {
            const int kv = idx >> 18, r = (idx >> 6) & 4095, d = idx & 63;
            const bf16* hrow = (kv ? HV : HK) + (size_t)r * 256; const float* w2 = (kv ? in[I_CW2V] : in[I_CW2K]) + d;
            float acc = 0.f;
            for (int j8 = 0; j8 < 32; ++j8) { const u32x4 hw = *(const u32x4*)(hrow + j8 * 8); const float* wp = w2 + (size_t)j8 * 8 * 64;
                acc += bflo(hw.x) * wp[0] + bfhi(hw.x) * wp[64] + bflo(hw.y) * wp[128] + bfhi(hw.y) * wp[192] + bflo(hw.z) * wp[256] + bfhi(hw.z) * wp[320] + bflo(hw.w) * wp[384] + bfhi(hw.w) * wp[448]; }
            if (kv == 0) KC[(size_t)r * 64 + d] = f2bf(acc); else VCT[((size_t)(r >> 9) * 64 + d) * 512 + (r & 511)] = f2bf(acc);
        }
    }
    SEAM(7);
    if (IN(8)) {
        IDS();
        LAS char* al = (LAS char*)lds;
#ifdef PROBE_MLA2
        for (int rep_ = 0; rep_ < 2; ++rep_)
#endif
        for (int i = 0; i * G < 1024; ++i) { const int p = (i & 1) ? (G - 1 - c) : c, uu = i * G + p;
            if (uu < 1024) { const int qb = 31 - (uu >> 5), bh = uu & 31;
#ifndef NO_MLA
 mla_unit(bh >> 3, bh & 7, qb, QM, KM, KR, VTM, YM, al, wave, lane);
#endif
 } }
        for (int i = 0; i * G < 1024; ++i) { const int p = (i & 1) ? (G - 1 - c) : c, uu = i * G + p;
            if (uu < 1024) { const int tile = 127 - (uu >> 3), bgi = uu & 7;
#ifndef NO_NSA
 nsa_unit(bgi >> 1, bgi & 1, tile, QN, Z1, KC, VCT, VTS, VTW, al, wave, lane);
#endif
 } }
    }
    SEAM(8);
    if (IN(9)) {
        GEMM_CALL(EpiProj<false>, QN, WPN, MTOK, 1024, 512, c, (EpiProj<false>{GM, MG}));
        GEMM_CALL(EpiProj<true>, YM, WPM, MTOK, 1024, 512, c, (EpiProj<true>{GM, MG}));
    }
    SEAM(9);
    if (IN(10)) GEMM_CALL(EpiF32, MG, WOUT, MTOK, 1024, 1024, c, (EpiF32{F, DM}));
    SEAM(10);
    if (IN(11)) { IDS(); rowop<true>(F, X, 1.0f, in[I_MPOST], X, in[I_F2PRE], A1, gw, NGW, lane); }
    SEAM(11);
    if (IN(12)) GEMM_CALL(EpiSwiglu, A1, WGU2, MTOK, 5632, 1024, c, (EpiSwiglu{H}));
    SEAM(12);
    if (IN(13)) GEMM_CALL(EpiF32, H, WD2, MTOK, 1024, 2816, c, (EpiF32{F, DM}));
    SEAM(13);
    if (IN(14)) { IDS(); rowop<false>(F, X, 0.5f, in[I_F2POST], X, nullptr, nullptr, gw, NGW, lane); }
#undef IN
#undef IDS
#undef SEAM
#undef GEMM_CALL
#undef WGU1
#undef WD1
#undef WGU2
#undef WD2
#undef WIN
#undef WPN
#undef WPM
#undef WOUT
#undef WUQ
#undef WUKV
#undef CW1K
#undef CW1V
#undef A1
#undef IM2K
#undef IM2V
#undef CQN
#undef CKVN
#undef KR
#undef HK
#undef HV
#undef KC
#undef VCT
#undef MG
#undef H
#undef Z1
#undef QN
#undef YM
#undef KM
#undef GM
#undef QM
#undef VTM
#undef VTS
#undef VTW
#undef F
#undef X
}
}

extern "C" void kernel_launch(void* const* d_in, const int* in_sizes, int n_in, void* d_out, int out_size, void* d_ws, size_t ws_size, hipStream_t stream) {
    using namespace mk;
    static int grid = 0;
    if (grid == 0) {
        if (n_in != 27 || out_size != MTOK * DM || ws_size < O_END) { fprintf(stderr, "kernel_launch: unexpected problem (n_in %d out %d ws %zu)\n", n_in, out_size, ws_size); grid = -1; return; }
        int dev = 0, cus = 0, per_cu = 0;
        hipGetDevice(&dev); hipDeviceGetAttribute(&cus, hipDeviceAttributeMultiprocessorCount, dev);
        if (hipFuncSetAttribute((const void*)fwd_kernel, hipFuncAttributeMaxDynamicSharedMemorySize, LDS_BYTES) != hipSuccess) { fprintf(stderr, "kernel_launch: hipFuncSetAttribute failed\n"); grid = -1; return; }
        if (hipOccupancyMaxActiveBlocksPerMultiprocessor(&per_cu, (const void*)fwd_kernel, NWAVES * 64, LDS_BYTES) != hipSuccess || per_cu < 1) { fprintf(stderr, "kernel_launch: occupancy query says %d\n", per_cu); per_cu = 1; }
        (void)hipGetLastError();
        grid = cus * per_cu;
    }
    if (grid < 0) return;
    if (hipMemsetAsync((char*)d_ws + O_CTL, 0, 4096, stream) != hipSuccess) { fprintf(stderr, "kernel_launch: memset failed\n"); return; }
    Args a{};
    for (int i = 0; i < 27; ++i) a.in[i] = (const float*)d_in[i];
    a.out = (float*)d_out; a.ws = (unsigned char*)d_ws;
#if MK_PER_PHASE
    for (int ph = 0; ph < NPHASE; ++ph) { a.ph_lo = ph; a.ph_hi = ph + 1; hipLaunchKernelGGL(fwd_kernel, dim3(grid), dim3(NWAVES * 64), LDS_BYTES, stream, a); }
#else
    a.ph_lo = 0; a.ph_hi = NPHASE;
    void* kargs[] = {&a};
    hipError_t e = hipLaunchCooperativeKernel((const void*)fwd_kernel, dim3(grid), dim3(NWAVES * 64), kargs, LDS_BYTES, stream);
    if (e != hipSuccess) fprintf(stderr, "cooperative launch failed: %s (grid %d)\n", hipGetErrorString(e), grid);
#endif
}
```

```cpp
#include <hip/hip_runtime.h>
#include <hip/hip_cooperative_groups.h>
#include <cstdio>
#include <cstdint>
namespace cg = cooperative_groups;
namespace pg8 {
#define PG8_LAS __attribute__((address_space(3)))
typedef unsigned short bf16_t;
typedef short bf16x8 __attribute__((ext_vector_type(8)));
typedef float f32x4 __attribute__((ext_vector_type(4)));
typedef unsigned u32x4 __attribute__((ext_vector_type(4)));
constexpr int BM = 256, BK = 64, HALF = 128, HTB = HALF * BK * 2  , STAGE_BYTES = 8 * HTB, NXCD = 8, WGM = 8;

__host__ __device__ __forceinline__ int lds_byte(int r, int c) { const int st = (r >> 4) * 2 + (c >> 5), rr = r & 15, cc = c & 31, ob = rr * 64 + cc * 2; return st * 1024 + (ob ^ (((ob >> 9) & 1) << 5)); }
__host__ __device__ __forceinline__ void stage_rc(int b, int& R, int& C) { const int st = b / 1024, sb = b % 1024, swz = sb ^ (((sb >> 9) & 1) << 5); R = (st >> 1) * 16 + swz / 64; C = (st & 1) * 32 + (swz % 64) / 2; }
__host__ __device__ __forceinline__ int perm32(int rho) { const int n = rho >> 4, i = rho & 15; return 8 * (i >> 2) + 4 * n + (i & 3); }

struct Unit { int pm, pn; };
struct Gemm { const bf16_t* A; const bf16_t* Bt; int M, N, K; };

struct StaticOrder {
    int nM, nN, nwg, G, c;
    __host__ __device__ void init(int M, int N, int G_, int c_) { nM = M / BM; nN = N / BM; nwg = nM * nN; G = G_; c = c_; }
    __host__ __device__ bool next(int i, Unit& u) const {
        const long L = (long)i * G + c; if (L >= nwg) return false;
        int wgid = (int)L; { const int q = nwg / NXCD, r = nwg % NXCD, xcd = wgid % NXCD, off = wgid / NXCD; wgid = (xcd < r ? xcd * (q + 1) : r * (q + 1) + (xcd - r) * q) + off; }
        const int nig = WGM * nN, gid = wgid / nig, fm = gid * WGM, gsz = (nM - fm) < WGM ? (nM - fm) : WGM;
        u.pm = fm + ((wgid % nig) % gsz); u.pn = (wgid % nig) / gsz; return true;
    }
    __device__ __forceinline__ void a_ready(const Unit&) const {}
    __device__ __forceinline__ void done(const Unit&) const {}
};

__device__ __forceinline__ unsigned cvt_pk_bf16(float lo, float hi) { unsigned r; asm volatile("v_cvt_pk_bf16_f32 %0, %1, %2" : "=v"(r) : "v"(lo), "v"(hi)); return r; }
typedef float f32x2 __attribute__((ext_vector_type(2)));
template <class Epi, class Sched, bool ALIGN_EPI = false, bool SP2 = false>
__device__ __forceinline__ void gemm_phase(PG8_LAS unsigned char* lds, const Gemm g, const Sched& S, const Epi& E, const int wid, const int lane) {
    const int tid = wid * 64 + lane, wr = wid >> 2, wc = wid & 3, fr = lane & 15, fq = lane >> 4;
    const int K = g.K, nt = K / BK;
    unsigned voffA[2], voffB[2];
#pragma unroll
    for (int i = 0; i < 2; ++i) { int R, C; stage_rc(tid * 16 + i * 8192, R, C); const int Rb = Epi::PERM ? ((R & ~31) + perm32(R & 31)) : R;
        voffA[i] = (unsigned)(R * K + C) * 2u; voffB[i] = (unsigned)(Rb * K + C) * 2u; }
    const size_t kstep = (size_t)(BK * 2);
    const size_t hstep = (size_t)HALF * K * 2;
    const size_t tstep = 2 * hstep;
    const unsigned ldsw = (unsigned)wid * 1024u;
    const int aoff = lds_byte(wr * 64 + fr, fq * 8), boff = lds_byte(wc * 32 + fr, fq * 8);
#define PG8_SA(b, h) (((b) * 2 + (h)) * HTB)
#define PG8_SB(b, h) ((4 + (b) * 2 + (h)) * HTB)
#define PG8_STAGE(bufoff, gbase, voff) do { _Pragma("unroll") for (int _i = 0; _i < 2; ++_i) \
        __builtin_amdgcn_global_load_lds((const unsigned*)((const char*)(gbase) + (voff)[_i]), (PG8_LAS unsigned*)(lds + (bufoff) + ldsw + _i * 8192), 16, 0, 0); } while (0)
#define PG8_LDA(dst, b, h) do { _Pragma("unroll") for (int m = 0; m < 4; ++m) _Pragma("unroll") for (int k = 0; k < 2; ++k) dst[m][k] = *(const PG8_LAS bf16x8*)(lds + PG8_SA(b, h) + aoff + m * 2048 + k * 1024); } while (0)
#define PG8_LDB(dst, b, h) do { _Pragma("unroll") for (int n = 0; n < 2; ++n) _Pragma("unroll") for (int k = 0; k < 2; ++k) dst[n][k] = *(const PG8_LAS bf16x8*)(lds + PG8_SB(b, h) + boff + n * 2048 + k * 1024); } while (0)
#define PG8_MMA(ai, bj, At, Bt) do { __builtin_amdgcn_s_setprio(1); _Pragma("unroll") for (int m = 0; m < 4; ++m) _Pragma("unroll") for (int n = 0; n < 2; ++n) _Pragma("unroll") for (int k = 0; k < 2; ++k) \
        acc[ai][bj][m][n] = __builtin_amdgcn_mfma_f32_16x16x32_bf16(Bt[n][k], At[m][k], acc[ai][bj][m][n], 0, 0, 0); __builtin_amdgcn_s_setprio(0); } while (0)
#define PG8_WAIT_V(n) asm volatile("s_waitcnt vmcnt(" #n ")" ::: "memory")
#define PG8_WAIT_L(n) asm volatile("s_waitcnt lgkmcnt(" #n ")" ::: "memory")
#define PG8_BAR __builtin_amdgcn_s_barrier()
#define PG8_SCHED __builtin_amdgcn_sched_barrier(0)
    Unit cur, nxt; int ui = 0;
    if (!S.next(0, cur)) return;
    f32x4 acc[2][2][4][2];
#pragma unroll
    for (int a = 0; a < 2; ++a)
#pragma unroll
        for (int b = 0; b < 2; ++b)
#pragma unroll
            for (int m = 0; m < 4; ++m)
#pragma unroll
                for (int n = 0; n < 2; ++n) acc[a][b][m][n] = (f32x4){0.f, 0.f, 0.f, 0.f};
    bf16x8 At[4][2], B0[2][2], B1[2][2];
    const char* cA = (const char*)g.A + (size_t)cur.pm * tstep; const char* cB = (const char*)g.Bt + (size_t)cur.pn * tstep;
    S.a_ready(cur);
    if constexpr (SP2) {
        PG8_STAGE(PG8_SB(0, 0), cB, voffB); PG8_STAGE(PG8_SB(0, 1), cB + hstep, voffB); PG8_STAGE(PG8_SA(0, 0), cA, voffA); PG8_STAGE(PG8_SA(0, 1), cA + hstep, voffA);
        if (wr == 1) PG8_BAR;
        PG8_WAIT_V(2); PG8_BAR;
        PG8_STAGE(PG8_SB(1, 0), cB + kstep, voffB); PG8_STAGE(PG8_SA(1, 0), cA + kstep, voffA); PG8_STAGE(PG8_SB(1, 1), cB + hstep + kstep, voffB);
        PG8_WAIT_V(6); PG8_BAR;
    } else {
        PG8_STAGE(PG8_SB(0, 0), cB, voffB); PG8_STAGE(PG8_SA(0, 0), cA, voffA); PG8_STAGE(PG8_SB(0, 1), cB + hstep, voffB); PG8_STAGE(PG8_SA(0, 1), cA + hstep, voffA);
        if (wr == 1) PG8_BAR;
        PG8_WAIT_V(4); PG8_BAR;
        PG8_STAGE(PG8_SB(1, 0), cB + kstep, voffB); PG8_STAGE(PG8_SA(1, 0), cA + kstep, voffA); PG8_STAGE(PG8_SB(1, 1), cB + hstep + kstep, voffB);
        PG8_WAIT_V(6); PG8_BAR;
    }
    for (;;) {
        const bool has_next = S.next(ui + 1, nxt);
        const char* nA = has_next ? (const char*)g.A + (size_t)nxt.pm * tstep : cA; const char* nB = has_next ? (const char*)g.Bt + (size_t)nxt.pn * tstep : cB;
        for (int t = 0; t < nt; t += 2) {
            const bool last = (t == nt - 2);
            const char* a1 = cA + (size_t)(t + 1) * kstep;
            const char* a2 = last ? nA : cA + (size_t)(t + 2) * kstep; const char* b2 = last ? nB : cB + (size_t)(t + 2) * kstep;
            const char* a3 = a2 + kstep; const char* b3 = b2 + kstep;
            if (last && has_next) S.a_ready(nxt);
            if constexpr (SP2) {
            PG8_LDB(B0, 0, 0); PG8_LDB(B1, 0, 1); PG8_SCHED; PG8_LDA(At, 0, 0); PG8_STAGE(PG8_SA(1, 1), a1 + hstep, voffA);
            PG8_WAIT_V(8); PG8_WAIT_L(0); PG8_BAR; PG8_MMA(0, 0, At, B0); PG8_MMA(0, 1, At, B1); PG8_BAR; PG8_SCHED;
            PG8_LDA(At, 0, 1); PG8_STAGE(PG8_SB(0, 0), b2, voffB); PG8_STAGE(PG8_SB(0, 1), b2 + hstep, voffB); PG8_STAGE(PG8_SA(0, 0), a2, voffA);
            PG8_WAIT_V(8); PG8_WAIT_L(0); PG8_BAR; PG8_MMA(1, 0, At, B0); PG8_MMA(1, 1, At, B1); PG8_BAR; PG8_SCHED;
            PG8_LDB(B0, 1, 0); PG8_LDB(B1, 1, 1); PG8_SCHED; PG8_LDA(At, 1, 0); PG8_STAGE(PG8_SA(0, 1), a2 + hstep, voffA);
            PG8_WAIT_V(8); PG8_WAIT_L(0); PG8_BAR; PG8_MMA(0, 0, At, B0); PG8_MMA(0, 1, At, B1); PG8_BAR; PG8_SCHED;
            PG8_LDA(At, 1, 1); PG8_STAGE(PG8_SB(1, 0), b3, voffB); PG8_STAGE(PG8_SB(1, 1), b3 + hstep, voffB); PG8_STAGE(PG8_SA(1, 0), a3, voffA);
            PG8_WAIT_V(8); PG8_WAIT_L(0); PG8_BAR; PG8_MMA(1, 0, At, B0); PG8_MMA(1, 1, At, B1); PG8_BAR; PG8_SCHED;
            } else {
            PG8_LDB(B0, 0, 0); PG8_SCHED; PG8_LDA(At, 0, 0); PG8_STAGE(PG8_SA(1, 1), a1 + hstep, voffA);
            PG8_WAIT_L(8); PG8_BAR; PG8_WAIT_L(0); PG8_MMA(0, 0, At, B0); PG8_BAR; PG8_SCHED;
            PG8_LDB(B1, 0, 1); PG8_STAGE(PG8_SB(0, 0), b2, voffB);
            PG8_BAR; PG8_WAIT_L(0); PG8_MMA(0, 1, At, B1); PG8_BAR;
            PG8_LDA(At, 0, 1); PG8_STAGE(PG8_SA(0, 0), a2, voffA);
            PG8_BAR; PG8_WAIT_L(0); PG8_MMA(1, 0, At, B0); PG8_BAR; PG8_SCHED;
            PG8_STAGE(PG8_SB(0, 1), b2 + hstep, voffB);
            PG8_WAIT_V(6); PG8_BAR; PG8_MMA(1, 1, At, B1); PG8_BAR;
            PG8_LDB(B0, 1, 0); PG8_SCHED; PG8_LDA(At, 1, 0); PG8_STAGE(PG8_SA(0, 1), a2 + hstep, voffA);
            PG8_WAIT_L(8); PG8_BAR; PG8_WAIT_L(0); PG8_MMA(0, 0, At, B0); PG8_BAR; PG8_SCHED;
            PG8_LDB(B1, 1, 1); PG8_STAGE(PG8_SB(1, 0), b3, voffB);
            PG8_BAR; PG8_WAIT_L(0); PG8_MMA(0, 1, At, B1); PG8_BAR;
            PG8_LDA(At, 1, 1); PG8_STAGE(PG8_SA(1, 0), a3, voffA);
            PG8_BAR; PG8_WAIT_L(0); PG8_MMA(1, 0, At, B0); PG8_BAR; PG8_SCHED;
            PG8_STAGE(PG8_SB(1, 1), b3 + hstep, voffB);
            PG8_WAIT_V(6); PG8_BAR; PG8_MMA(1, 1, At, B1); PG8_BAR;
            }
        }
        if constexpr (ALIGN_EPI) { if (wr == 0) PG8_BAR; }
        if constexpr (!Epi::AFTER_DRAIN) { E(acc, cur, wr, wc, fr, fq); S.done(cur); }
        if (!has_next) break;
#pragma unroll
        for (int a = 0; a < 2; ++a)
#pragma unroll
            for (int b = 0; b < 2; ++b)
#pragma unroll
                for (int m = 0; m < 4; ++m)
#pragma unroll
                    for (int n = 0; n < 2; ++n) acc[a][b][m][n] = (f32x4){0.f, 0.f, 0.f, 0.f};
        cur = nxt; cA = nA; cB = nB; ++ui;
        if constexpr (ALIGN_EPI) { if (wr == 1) PG8_BAR; }
    }
    PG8_WAIT_V(0);
    if constexpr (!ALIGN_EPI) { if (wr == 0) PG8_BAR; }
    PG8_BAR;
    if constexpr (Epi::AFTER_DRAIN) { E.fused(acc, cur, wr, wc, fr, fq, lds, wid, lane); S.done(cur); }
#undef PG8_SA
#undef PG8_SB
#undef PG8_STAGE
#undef PG8_LDA
#undef PG8_LDB
#undef PG8_MMA
#undef PG8_WAIT_V
#undef PG8_WAIT_L
#undef PG8_BAR
#undef PG8_SCHED
}
}

#ifndef PG8_SP2
#define PG8_SP2 true
#endif
#ifndef MK_PER_PHASE
#define MK_PER_PHASE 0
#endif

namespace mk {
using pg8::bf16x8; using pg8::f32x4; using pg8::u32x4; using pg8::Unit; using pg8::Gemm; using pg8::StaticOrder;
typedef unsigned short bf16;
typedef float f32x16 __attribute__((ext_vector_type(16)));
typedef unsigned u32x2 __attribute__((ext_vector_type(2)));
typedef float f32x2_t __attribute__((ext_vector_type(2)));
typedef __bf16 bf16x2_t __attribute__((ext_vector_type(2)));
#define LAS __attribute__((address_space(3)))
#define LDS_WAIT() asm volatile("s_waitcnt lgkmcnt(0)" ::: "memory")

#define XB_TMO      128
#define XB_XCNT(j)  (256  + 64 * (j))
#define XB_XSUB(j)  (1280 + 64 * (j))
#define XB_XGEN(j)  (2304 + 64 * (j))
#define XB_TOP      3328
#define XB_TOPGEN   3392
#define XCD_BAR_WORDS 3456
#define XB_SPIN_CAP (1u << 18)

__device__ __forceinline__ unsigned xb_ld(unsigned* p)              { return __hip_atomic_load(p, __ATOMIC_RELAXED, __HIP_MEMORY_SCOPE_AGENT); }
__device__ __forceinline__ unsigned xb_add(unsigned* p, unsigned v) { return __hip_atomic_fetch_add(p, v, __ATOMIC_RELAXED, __HIP_MEMORY_SCOPE_AGENT); }
__device__ __forceinline__ unsigned xb_xcc_id() { return (unsigned)__builtin_amdgcn_s_getreg((3 << 11) | 20) & 0xFu; }
#define XB_SPIN(cond, bar) do { unsigned _sp = 0; while (cond) { __builtin_amdgcn_s_sleep(1); \
    if ((++_sp & 255u) == 0u) { if (xb_ld(&(bar)[XB_TMO])) break; if (_sp > XB_SPIN_CAP) { atomicAdd(&(bar)[XB_TMO], 1u); break; } } } } while (0)

struct XcdBarrier {
    unsigned* bar; unsigned x;
    volatile LAS unsigned* st;
};

__device__ __forceinline__ XcdBarrier xcd_barrier_post(unsigned* bar, volatile LAS unsigned* st, const int tid) {
    XcdBarrier b; b.bar = bar; b.x = xb_xcc_id(); b.st = st;
    if (tid == 0) (void)xb_add(&bar[XB_XCNT(b.x)], 1u);
    return b;
}
__device__ __forceinline__ void xcd_barrier_complete(unsigned* bar, unsigned x, unsigned& nloc, unsigned& nx) {
    const unsigned G = gridDim.x * gridDim.y * gridDim.z;
    unsigned sum, cnt, mine, sp = 0u;
    for (;;) {
        sum = 0u; cnt = 0u; mine = 0u;
#pragma unroll
        for (unsigned j = 0; j < 16; ++j) { const unsigned c = xb_ld(&bar[XB_XCNT(j)]); sum += c; cnt += (c > 0u) ? 1u : 0u; mine = (j == x) ? c : mine; }
        if (sum == G) break;
        __builtin_amdgcn_s_sleep(1);
        if ((++sp & 255u) == 0u) { if (xb_ld(&bar[XB_TMO])) break; if (sp > XB_SPIN_CAP) { atomicAdd(&bar[XB_TMO], 1u); break; } }
    }
    nloc = mine > 0u ? mine : 1u; nx = cnt > 0u ? cnt : 1u;
}

__device__ __forceinline__ void xcd_barrier(const XcdBarrier& b, const int tid) {
    asm volatile("s_waitcnt vmcnt(0)" ::: "memory");
    __syncthreads();
    if (tid == 0) {
        unsigned* bar = b.bar;
        __builtin_amdgcn_s_waitcnt(0);
        unsigned nloc = b.st[0], nx = b.st[1];
        if (nloc == 0u) { xcd_barrier_complete(bar, b.x, nloc, nx); b.st[0] = nloc; b.st[1] = nx; }
        const unsigned old = xb_add(&bar[XB_XSUB(b.x)], 1u);
        const unsigned gen = old / nloc;
        if (old + 1u == (gen + 1u) * nloc) {
            __builtin_amdgcn_fence(__ATOMIC_RELEASE, "agent");
            asm volatile("s_waitcnt vmcnt(0)" ::: "memory");
            const unsigned og = xb_add(&bar[XB_TOP], 1u);
            const unsigned tg = og / nx;
            if (og + 1u == (tg + 1u) * nx) xb_add(&bar[XB_TOPGEN], 1u);
            else XB_SPIN(xb_ld(&bar[XB_TOPGEN]) == tg, bar);
            __builtin_amdgcn_fence(__ATOMIC_ACQUIRE, "agent");
            xb_add(&bar[XB_XGEN(b.x)], 1u);
            asm volatile("s_waitcnt vmcnt(0)" ::: "memory");
        } else {
            XB_SPIN(xb_ld(&bar[XB_XGEN(b.x)]) == gen, bar);
            __builtin_amdgcn_fence(__ATOMIC_ACQUIRE, "agent");
            asm volatile("s_waitcnt vmcnt(0)" ::: "memory");
        }
    }
    __syncthreads();
}

constexpr int NB = 4, SEQ = 8192, DM = 1024, MTOK = NB * SEQ, DFF = 2816;
constexpr float EPS = 1e-6f, NEGF = -1e30f;
constexpr int NPHASE = 15;
constexpr int NWAVES = 8;
constexpr size_t MiB = 1u << 20;
constexpr size_t SZ_WGU = (size_t)5632 * 1024 * 2, SZ_WD = (size_t)1024 * 2816 * 2, SZ_WIN = (size_t)3840 * 1024 * 2;
constexpr size_t O_WGU1 = 0, O_WD1 = O_WGU1 + SZ_WGU, O_WGU2 = O_WD1 + SZ_WD, O_WD2 = O_WGU2 + SZ_WGU, O_WIN = O_WD2 + SZ_WD,
                 O_WPN = O_WIN + SZ_WIN, O_WPM = O_WPN + MiB, O_WOUT = O_WPM + MiB, O_WUQ = O_WOUT + 2 * MiB, O_WUKV = O_WUQ + 768 * 256 * 2,
                 O_CW1K = O_WUKV + 1024 * 128 * 2, O_CW1V = O_CW1K + MiB, O_WEND = O_CW1V + MiB;
static_assert(O_WEND <= 48 * MiB - 16384, "weights");
constexpr size_t O_CTL = 48 * MiB - 16384;
constexpr size_t O_A1 = 48 * MiB;
constexpr size_t O_IM2K = 48 * MiB, O_IM2V = 64 * MiB, O_CQN = 80 * MiB, O_CKVN = 96 * MiB, O_KR = 104 * MiB, O_HK = 106 * MiB, O_HV = 108 * MiB,
                 O_KC = 110 * MiB, O_VCT = 110 * MiB + 512 * 1024;
constexpr size_t O_MG = 48 * MiB;
constexpr size_t O_H = 112 * MiB;
constexpr size_t O_Z1 = 112 * MiB, O_QN = 192 * MiB, O_YM = 224 * MiB, O_KM = 256 * MiB;
constexpr size_t O_F = 288 * MiB, O_GM = 288 * MiB;
constexpr size_t O_QM = 416 * MiB, O_VTM = 464 * MiB, O_VTS = 496 * MiB, O_VTW = 504 * MiB, O_END = 512 * MiB;
constexpr int Z1P = 1280;
constexpr int LDS_BYTES = 147456;
constexpr int L_KB = 0, KB_SZ = 13312, L_VB = 2 * KB_SZ, VB_SZ = 8704, L_IMP = L_VB + 2 * VB_SZ, IMP_P = 132, L_SELM = L_IMP + 64 * IMP_P * 4, L_WUN = L_SELM + 1024, L_ATT_END = L_WUN + 128;
static_assert(L_ATT_END <= 131072, "attention LDS");

__device__ __forceinline__ int mk_lane() { int l; asm volatile("v_mbcnt_lo_u32_b32 %0, -1, 0\n\tv_mbcnt_hi_u32_b32 %0, -1, %0" : "=v"(l)); return l; }
__device__ __forceinline__ void grid_barrier(unsigned* ctr, unsigned target, int tid) {
    asm volatile("s_waitcnt vmcnt(0)" ::: "memory");
    __syncthreads();
    if (tid == 0) {
        __builtin_amdgcn_fence(__ATOMIC_RELEASE, "agent");
        asm volatile("s_waitcnt vmcnt(0)" ::: "memory");
        __hip_atomic_fetch_add(ctr, 1u, __ATOMIC_RELAXED, __HIP_MEMORY_SCOPE_AGENT);
        while (__hip_atomic_load(ctr, __ATOMIC_RELAXED, __HIP_MEMORY_SCOPE_AGENT) < target) __builtin_amdgcn_s_sleep(2);
        __builtin_amdgcn_fence(__ATOMIC_ACQUIRE, "agent");
        asm volatile("s_waitcnt vmcnt(0)" ::: "memory");
    }
    __syncthreads();
}
__device__ __forceinline__ unsigned cvtpk(float lo, float hi) { f32x2_t v = {lo, hi}; bf16x2_t b = __builtin_convertvector(v, bf16x2_t); return __builtin_bit_cast(unsigned, b); }
__device__ __forceinline__ float bflo(unsigned w) { return __builtin_bit_cast(float, w << 16); }
__device__ __forceinline__ float bfhi(unsigned w) { return __builtin_bit_cast(float, w & 0xffff0000u); }
__device__ __forceinline__ float bf2f(bf16 b) { return __builtin_bit_cast(float, (unsigned)b << 16); }
__device__ __forceinline__ bf16 f2bf(float f) { return (bf16)(cvtpk(f, 0.f) & 0xffffu); }
__device__ __forceinline__ float wave_sum(float v) {
#pragma unroll
    for (int o = 1; o < 64; o <<= 1) v += __shfl_xor(v, o);
    return v;
}
__device__ __forceinline__ float sigmoidf(float x) { return 1.f / (1.f + __expf(-x)); }
__device__ __forceinline__ float gelu_tanh(float x) { const float u = 0.7978845608028654f * (x + 0.044715f * x * x * x); const float t = 1.f - 2.f / (__expf(2.f * u) + 1.f); return 0.5f * x * (1.f + t); }
__device__ __forceinline__ void rope_cs(int pos, int j, float& c, float& s) {
    const float freq = __builtin_amdgcn_exp2f(-(float)j * 0.8304820237218406f);
    const float ang = (float)pos * freq;
    double rev = (double)ang * 0.15915494309189535; rev -= __builtin_rint(rev);
    const float fr = (float)rev;
    s = __builtin_amdgcn_sinf(fr); c = __builtin_amdgcn_cosf(fr);
}

struct MapPlain { __device__ __forceinline__ int col(int r) const { return r; } __device__ __forceinline__ int drow(int r) const { return r; } };
struct MapGU { int sel; __device__ __forceinline__ int col(int r) const { return r; } __device__ __forceinline__ int drow(int r) const { return (r >> 7) * 256 + sel * 128 + (r & 127); } };
struct MapWin { __device__ __forceinline__ int drow(int r) const { return r; } __device__ __forceinline__ int col(int r) const {
    int col;
    if (r < 1280) col = r; else if (r < 1536) col = 1304 + (r - 1280); else if (r < 1664) col = 1560 + (r - 1536); else if (r < 1696) col = 1688 + (r - 1664);
    else if (r < 1720) col = 1280 + (r - 1696); else if (r < 1792) col = -1; else col = 1720 + (r - 1792);
    return col; } };
struct MapUkv { __device__ __forceinline__ int drow(int r) const { return r; } __device__ __forceinline__ int col(int r) const {
    if (r < 512) return (r >> 6) * 128 + (r & 63); const int rr = r - 512; return (rr >> 6) * 128 + 64 + (rr & 63); } };
template <class Map> __device__ __forceinline__ void transpose_mat(const float* W, int N, const Map mp, int K, int Nvirt, bf16* WT, LAS float* scr, int gw, int NGW, int lane) {
    const int nblk = Nvirt / 32, nitems = (K / 64) * nblk;
    for (int it = gw; it < nitems; it += NGW) {
        const int kb = it / nblk, nb = it % nblk, k0 = 64 * kb, n0 = 32 * nb;
        const int col = mp.col(n0 + (lane & 31));
#pragma unroll 8
        for (int i = 0; i < 32; ++i) { const int kk = 2 * i + (lane >> 5); scr[kk * 33 + (lane & 31)] = (col >= 0) ? W[(size_t)(k0 + kk) * N + col] : 0.f; }
        LDS_WAIT();
        const int c = lane & 7;
#pragma unroll
        for (int j = 0; j < 4; ++j) { const int n = (lane >> 3) + 8 * j; const LAS float* s = scr + (8 * c) * 33 + n;
            u32x4 o; o.x = cvtpk(s[0 * 33], s[1 * 33]); o.y = cvtpk(s[2 * 33], s[3 * 33]); o.z = cvtpk(s[4 * 33], s[5 * 33]); o.w = cvtpk(s[6 * 33], s[7 * 33]);
            *(u32x4*)(WT + (size_t)mp.drow(n0 + n) * K + k0 + 8 * c) = o; }
        LDS_WAIT();
    }
}

__device__ __forceinline__ void rms_row_to_bf16(const f32x4 (&v)[4], const float* gain, bf16* orow, int lane) {
    float ss = 0.f;
#pragma unroll
    for (int j = 0; j < 4; ++j) ss += (v[j].x * v[j].x + v[j].y * v[j].y) + (v[j].z * v[j].z + v[j].w * v[j].w);
    const float r = rsqrtf(wave_sum(ss) * (1.f / DM) + EPS);
#pragma unroll
    for (int j = 0; j < 4; ++j) { const f32x4 g = *(const f32x4*)(gain + 4 * (lane + 64 * j)); const f32x4 o = v[j] * r * g;
        u32x2 w; w.x = cvtpk(o.x, o.y); w.y = cvtpk(o.z, o.w); *(u32x2*)(orow + 4 * (lane + 64 * j)) = w; }
}
template <bool NEXT> __device__ __forceinline__ void rowop(const float* F, const float* base, float coef, const float* gpost, float* xout, const float* gnext, bf16* A1, int gw, int NGW, int lane) {
    for (int m = gw; m < MTOK; m += NGW) {
        const f32x4* fr = (const f32x4*)(F + (size_t)m * DM) + lane; const f32x4* br = (const f32x4*)(base + (size_t)m * DM) + lane;
        f32x4 v[4], bs[4]; float ss = 0.f;
#pragma unroll
        for (int j = 0; j < 4; ++j) { v[j] = fr[64 * j]; bs[j] = br[64 * j]; ss += (v[j].x * v[j].x + v[j].y * v[j].y) + (v[j].z * v[j].z + v[j].w * v[j].w); }
        const float r = rsqrtf(wave_sum(ss) * (1.f / DM) + EPS) * coef;
#pragma unroll
        for (int j = 0; j < 4; ++j) { const f32x4 g = *(const f32x4*)(gpost + 4 * (lane + 64 * j)); v[j] = bs[j] + v[j] * r * g; *((f32x4*)(xout + (size_t)m * DM) + lane + 64 * j) = v[j]; }
        if (NEXT) rms_row_to_bf16(v, gnext, A1 + (size_t)m * DM, lane);
    }
}

#define EPI_ROW(ai, m) ((size_t)u.pm * 256 + (ai) * 128 + wr * 64 + (m) * 16 + fr)
#define EPI_CIN(bj, n) ((bj) * 128 + wc * 32 + (n) * 16 + fq * 4)
struct EpiSwiglu { static constexpr bool PERM = false, AFTER_DRAIN = false; bf16* H;
    __device__ __forceinline__ void operator()(const f32x4 (&acc)[2][2][4][2], const Unit& u, int wr, int wc, int fr, int fq) const {
#pragma unroll
        for (int ai = 0; ai < 2; ++ai)
#pragma unroll
            for (int m = 0; m < 4; ++m) { bf16* rp = H + EPI_ROW(ai, m) * DFF + u.pn * 128 + wc * 32 + fq * 4;
#pragma unroll
                for (int n = 0; n < 2; ++n) { const f32x4 g = acc[ai][0][m][n], up = acc[ai][1][m][n]; float v[4];
#pragma unroll
                    for (int e = 0; e < 4; ++e) v[e] = g[e] / (1.f + __expf(-g[e])) * up[e];
                    u32x2 w; w.x = cvtpk(v[0], v[1]); w.y = cvtpk(v[2], v[3]); *(u32x2*)(rp + n * 16) = w; } }
    }
};
struct EpiF32 { static constexpr bool PERM = false, AFTER_DRAIN = false; float* F; int ldc;
    __device__ __forceinline__ void operator()(const f32x4 (&acc)[2][2][4][2], const Unit& u, int wr, int wc, int fr, int fq) const {
#pragma unroll
        for (int ai = 0; ai < 2; ++ai)
#pragma unroll
            for (int m = 0; m < 4; ++m) { float* rp = F + EPI_ROW(ai, m) * ldc + u.pn * 256;
#pragma unroll
                for (int bj = 0; bj < 2; ++bj)
#pragma unroll
                    for (int n = 0; n < 2; ++n) *(f32x4*)(rp + EPI_CIN(bj, n)) = acc[ai][bj][m][n]; }
    }
};
struct EpiWin { static constexpr bool PERM = false, AFTER_DRAIN = false; bf16* QN; bf16* Z1; bf16* GM; bf16* VTS; bf16* VTW;
    __device__ __forceinline__ void operator()(const f32x4 (&acc)[2][2][4][2], const Unit& u, int wr, int wc, int fr, int fq) const {
        const int pn = u.pn;
#pragma unroll
        for (int ai = 0; ai < 2; ++ai)
#pragma unroll
            for (int m = 0; m < 4; ++m) { const size_t row = EPI_ROW(ai, m);
#pragma unroll
                for (int bj = 0; bj < 2; ++bj)
#pragma unroll
                    for (int n = 0; n < 2; ++n) { const int cin = EPI_CIN(bj, n); f32x4 v = acc[ai][bj][m][n];
                        if ((pn == 3 || pn == 4) && bj == 1) {
                            bf16* vt = (pn == 3) ? VTS : VTW; const int b = (int)(row >> 13), s = (int)(row & 8191), cv = cin - 128;
#pragma unroll
                            for (int e = 0; e < 4; ++e) vt[((size_t)(b * 128 + cv + e)) * SEQ + s] = f2bf(v[e]);
                        } else {
                            bf16* dst;
                            if (pn < 2) { dst = QN + row * 512 + pn * 256 + cin; v = v * 0.18033688011112042f; }
                            else if (pn < 7) dst = Z1 + row * Z1P + (pn - 2) * 256 + cin;
                            else dst = GM + row * 2048 + (pn - 7) * 256 + cin;
                            u32x2 w; w.x = cvtpk(v[0], v[1]); w.y = cvtpk(v[2], v[3]); *(u32x2*)dst = w;
                        } } }
    }
};
struct EpiGelu { static constexpr bool PERM = false, AFTER_DRAIN = false; bf16* O; int ldc;
    __device__ __forceinline__ void operator()(const f32x4 (&acc)[2][2][4][2], const Unit& u, int wr, int wc, int fr, int fq) const {
#pragma unroll
        for (int ai = 0; ai < 2; ++ai)
#pragma unroll
            for (int m = 0; m < 4; ++m) { bf16* rp = O + EPI_ROW(ai, m) * ldc + u.pn * 256;
#pragma unroll
                for (int bj = 0; bj < 2; ++bj)
#pragma unroll
                    for (int n = 0; n < 2; ++n) { const f32x4 v = acc[ai][bj][m][n];
                        u32x2 w; w.x = cvtpk(gelu_tanh(v[0]), gelu_tanh(v[1])); w.y = cvtpk(gelu_tanh(v[2]), gelu_tanh(v[3])); *(u32x2*)(rp + EPI_CIN(bj, n)) = w; } }
    }
};
struct EpiQup { static constexpr bool PERM = false, AFTER_DRAIN = false; bf16* QM;
    __device__ __forceinline__ void operator()(const f32x4 (&acc)[2][2][4][2], const Unit& u, int wr, int wc, int fr, int fq) const {
        const float sc = 0.14724445614104196f;
#pragma unroll
        for (int ai = 0; ai < 2; ++ai)
#pragma unroll
            for (int m = 0; m < 4; ++m) { bf16* rp = QM + EPI_ROW(ai, m) * 768 + u.pn * 256;
#pragma unroll
                for (int bj = 0; bj < 2; ++bj)
#pragma unroll
                    for (int n = 0; n < 2; ++n) { const f32x4 v = acc[ai][bj][m][n] * sc;
                        u32x2 w; w.x = cvtpk(v[0], v[1]); w.y = cvtpk(v[2], v[3]); *(u32x2*)(rp + EPI_CIN(bj, n)) = w; } }
    }
};
struct EpiKVup { static constexpr bool PERM = false, AFTER_DRAIN = false; bf16* KM; bf16* VTM;
    __device__ __forceinline__ void operator()(const f32x4 (&acc)[2][2][4][2], const Unit& u, int wr, int wc, int fr, int fq) const {
        const int pn = u.pn;
#pragma unroll
        for (int ai = 0; ai < 2; ++ai)
#pragma unroll
            for (int m = 0; m < 4; ++m) { const size_t row = EPI_ROW(ai, m);
#pragma unroll
                for (int bj = 0; bj < 2; ++bj)
#pragma unroll
                    for (int n = 0; n < 2; ++n) { const int cin = EPI_CIN(bj, n); const f32x4 v = acc[ai][bj][m][n];
                        if (pn < 2) { u32x2 w; w.x = cvtpk(v[0], v[1]); w.y = cvtpk(v[2], v[3]); *(u32x2*)(KM + row * 512 + pn * 256 + cin) = w; }
                        else { const int b = (int)(row >> 13), s = (int)(row & 8191), cv = (pn - 2) * 256 + cin;
#pragma unroll
                            for (int e = 0; e < 4; ++e) VTM[((size_t)(b * 512 + cv + e)) * SEQ + s] = f2bf(v[e]); } } }
    }
};
template <bool SECOND> struct EpiProj { static constexpr bool PERM = false, AFTER_DRAIN = false; const bf16* GM; bf16* MG;
    __device__ __forceinline__ void operator()(const f32x4 (&acc)[2][2][4][2], const Unit& u, int wr, int wc, int fr, int fq) const {
#pragma unroll
        for (int ai = 0; ai < 2; ++ai)
#pragma unroll
            for (int m = 0; m < 4; ++m) { const size_t row = EPI_ROW(ai, m);
#pragma unroll
                for (int bj = 0; bj < 2; ++bj)
#pragma unroll
                    for (int n = 0; n < 2; ++n) { const int col = u.pn * 256 + EPI_CIN(bj, n); const f32x4 v = acc[ai][bj][m][n];
                        const u32x2 gw = *(const u32x2*)(GM + row * 2048 + (SECOND ? 1024 : 0) + col);
                        float o0 = sigmoidf(bflo(gw.x)) * v[0], o1 = sigmoidf(bfhi(gw.x)) * v[1], o2 = sigmoidf(bflo(gw.y)) * v[2], o3 = sigmoidf(bfhi(gw.y)) * v[3];
                        bf16* dst = MG + row * DM + col;
                        if (SECOND) { const u32x2 pw = *(const u32x2*)dst; o0 += bflo(pw.x); o1 += bfhi(pw.x); o2 += bflo(pw.y); o3 += bfhi(pw.y); }
                        u32x2 w; w.x = cvtpk(o0, o1); w.y = cvtpk(o2, o3); *(u32x2*)dst = w; } }
    }
};

__device__ __forceinline__ int crow(int r, int hi) { return (r & 3) + 8 * (r >> 2) + 4 * hi; }
template <int ND0> __device__ __forceinline__ f32x16 qk_sub(const LAS char* Kt, int pitch, int sub, const bf16x8* qr, const f32x16& cin, int r32, int hi) {
    f32x16 acc = cin;
    const LAS char* kb = Kt + (sub * 32 + r32) * pitch + hi * 16;
#pragma unroll
    for (int d0 = 0; d0 < ND0; ++d0) { const bf16x8 kf = *(const LAS bf16x8*)(kb + d0 * 32); acc = __builtin_amdgcn_mfma_f32_32x32x16_bf16(kf, qr[d0], acc, 0, 0, 0); }
    return acc;
}
__device__ __forceinline__ void fill16(f32x16& a, float v) {
#pragma unroll
    for (int r = 0; r < 16; ++r) a[r] = v;
}
__device__ __forceinline__ void pv_sub(f32x16& o0, f32x16& o1, const LAS char* Vt, int sub, const f32x16& p, int r32, int hi) {
#pragma unroll
    for (int j = 0; j < 2; ++j) {
        u32x4 pw; pw.x = cvtpk(p[8 * j + 0], p[8 * j + 1]); pw.y = cvtpk(p[8 * j + 2], p[8 * j + 3]); pw.z = cvtpk(p[8 * j + 4], p[8 * j + 5]); pw.w = cvtpk(p[8 * j + 6], p[8 * j + 7]);
        const bf16x8 pb = __builtin_bit_cast(bf16x8, pw);
#pragma unroll
        for (int dblk = 0; dblk < 2; ++dblk) {
            const LAS char* vp = Vt + (32 * dblk + r32) * 136 + (32 * sub + 16 * j + 4 * hi) * 2;
            const u32x2 lo = *(const LAS u32x2*)vp, h2 = *(const LAS u32x2*)(vp + 16);
            u32x4 vw; vw.x = lo.x; vw.y = lo.y; vw.z = h2.x; vw.w = h2.y;
            const bf16x8 vf = __builtin_bit_cast(bf16x8, vw);
            if (dblk == 0) o0 = __builtin_amdgcn_mfma_f32_32x32x16_bf16(vf, pb, o0, 0, 0, 0); else o1 = __builtin_amdgcn_mfma_f32_32x32x16_bf16(vf, pb, o1, 0, 0, 0);
        }
    }
}
__device__ __forceinline__ bool sm_tile(f32x16& s0, f32x16& s1, float& mref, float& thr, float& l, f32x16& o0, f32x16& o1) {
    float mx = fmaxf(s0[0], s1[0]);
#pragma unroll
    for (int r = 1; r < 16; ++r) mx = fmaxf(mx, fmaxf(s0[r], s1[r]));
    mx = fmaxf(mx, __shfl_xor(mx, 32));
    bool ch = false;
    if (__any(mx > thr)) {
        const bool up = mx > thr; const float d = up ? mx : 0.f; const float alpha = (thr > 0.f) ? __builtin_amdgcn_exp2f(-d) : 1.f;
        mref += d; thr = up ? 8.f : thr; l *= alpha;
#pragma unroll
        for (int r = 0; r < 16; ++r) { o0[r] *= alpha; o1[r] *= alpha; s0[r] -= d; s1[r] -= d; }
        ch = true;
    }
    float sum = 0.f;
#pragma unroll
    for (int r = 0; r < 16; ++r) { s0[r] = __builtin_amdgcn_exp2f(s0[r]); s1[r] = __builtin_amdgcn_exp2f(s1[r]); sum += s0[r] + s1[r]; }
    l += sum;
    return ch;
}
__device__ __forceinline__ void zero16(f32x16& a) {
#pragma unroll
    for (int r = 0; r < 16; ++r) a[r] = 0.f;
}

__device__ __forceinline__ void mla_unit(int b, int h, int qb, const bf16* QM, const bf16* KM, const bf16* KR, const bf16* VTM, bf16* YM, LAS char* lds, const int wid, const int lane) {
    const int tid = wid * 64 + lane, r32 = lane & 31, hi = lane >> 5;
    const int q0 = qb * 256 + wid * 32, t = q0 + r32;
    const size_t rowq = (size_t)b * SEQ + t;
    bf16x8 qr[6];
#pragma unroll
    for (int d0 = 0; d0 < 6; ++d0) qr[d0] = *(const bf16x8*)(QM + rowq * 768 + h * 96 + d0 * 16 + hi * 8);
    {
        u32x4 a = __builtin_bit_cast(u32x4, qr[4]), bb = __builtin_bit_cast(u32x4, qr[5]);
        float x1[8] = {bflo(a.x), bfhi(a.x), bflo(a.y), bfhi(a.y), bflo(a.z), bfhi(a.z), bflo(a.w), bfhi(a.w)};
        float x2[8] = {bflo(bb.x), bfhi(bb.x), bflo(bb.y), bfhi(bb.y), bflo(bb.z), bfhi(bb.z), bflo(bb.w), bfhi(bb.w)};
#pragma unroll
        for (int e = 0; e < 8; ++e) { float cs, sn; rope_cs(t, 8 * hi + e, cs, sn); const float y1 = x1[e] * cs - x2[e] * sn, y2 = x1[e] * sn + x2[e] * cs; x1[e] = y1; x2[e] = y2; }
        a.x = cvtpk(x1[0], x1[1]); a.y = cvtpk(x1[2], x1[3]); a.z = cvtpk(x1[4], x1[5]); a.w = cvtpk(x1[6], x1[7]);
        bb.x = cvtpk(x2[0], x2[1]); bb.y = cvtpk(x2[2], x2[3]); bb.z = cvtpk(x2[4], x2[5]); bb.w = cvtpk(x2[6], x2[7]);
        qr[4] = __builtin_bit_cast(bf16x8, a); qr[5] = __builtin_bit_cast(bf16x8, bb);
    }
    float mref = 0.f, thr = -1e29f, l = 0.f; f32x16 o0, o1, cinit; zero16(o0); zero16(o1); zero16(cinit);
    const int NT = (qb + 1) * 4;
    const bf16* ksrc = KM + ((size_t)b * SEQ + (tid >> 3)) * 512 + h * 64 + (tid & 7) * 8;
    const bf16* rsrc = KR + ((size_t)b * SEQ + ((tid & 255) >> 2)) * 32 + (tid & 3) * 8;
    const bf16* vsrc = VTM + ((size_t)(b * 8 + h) * 64 + (tid >> 3)) * SEQ + (tid & 7) * 8;
    const int kdst = (tid >> 3) * 208 + (tid & 7) * 16, rdst = ((tid & 255) >> 2) * 208 + 128 + (tid & 3) * 16, vdst = (tid >> 3) * 136 + (tid & 7) * 16;
    u32x4 sk, sr, sv;
#define MLA_LOAD(it) do { sk = *(const u32x4*)(ksrc + (size_t)(it) * 64 * 512); if (tid < 256) sr = *(const u32x4*)(rsrc + (size_t)(it) * 64 * 32); sv = *(const u32x4*)(vsrc + (it) * 64); } while (0)
#define MLA_STORE(buf) do { *(LAS u32x4*)(lds + L_KB + (buf) * KB_SZ + kdst) = sk; if (tid < 256) *(LAS u32x4*)(lds + L_KB + (buf) * KB_SZ + rdst) = sr; \
        LAS char* vp_ = lds + L_VB + (buf) * VB_SZ + vdst; u32x2 a_; a_.x = sv.x; a_.y = sv.y; *(LAS u32x2*)vp_ = a_; a_.x = sv.z; a_.y = sv.w; *(LAS u32x2*)(vp_ + 8) = a_; } while (0)
    sr = (u32x4){0u, 0u, 0u, 0u};
    MLA_LOAD(0); MLA_STORE(0); __syncthreads();
    for (int it = 0; it < NT; ++it) {
        const bool more = it + 1 < NT;
        if (more) MLA_LOAD(it + 1);
        const int kv0 = it * 64;
        if (kv0 <= q0 + 31) {
            const LAS char* Kb = lds + L_KB + (it & 1) * KB_SZ; const LAS char* Vb = lds + L_VB + (it & 1) * VB_SZ;
            f32x16 s0 = qk_sub<6>(Kb, 208, 0, qr, cinit, r32, hi), s1 = qk_sub<6>(Kb, 208, 1, qr, cinit, r32, hi);
            if (kv0 + 63 > q0) {
#pragma unroll
                for (int r = 0; r < 16; ++r) { const int kp = kv0 + crow(r, hi); if (kp > t) s0[r] = NEGF; if (kp + 32 > t) s1[r] = NEGF; }
            }
            if (sm_tile(s0, s1, mref, thr, l, o0, o1)) fill16(cinit, -mref);
            pv_sub(o0, o1, Vb, 0, s0, r32, hi); pv_sub(o0, o1, Vb, 1, s1, r32, hi);
        }
        if (more) MLA_STORE((it + 1) & 1);
        __syncthreads();
    }
#undef MLA_LOAD
#undef MLA_STORE
    l += __shfl_xor(l, 32);
    const float inv = 1.f / l;
    bf16* orow = YM + rowq * 512 + h * 64 + 4 * hi;
#pragma unroll
    for (int a = 0; a < 4; ++a) {
        u32x2 w; w.x = cvtpk(o0[4 * a] * inv, o0[4 * a + 1] * inv); w.y = cvtpk(o0[4 * a + 2] * inv, o0[4 * a + 3] * inv); *(u32x2*)(orow + 8 * a) = w;
        w.x = cvtpk(o1[4 * a] * inv, o1[4 * a + 1] * inv); w.y = cvtpk(o1[4 * a + 2] * inv, o1[4 * a + 3] * inv); *(u32x2*)(orow + 32 + 8 * a) = w;
    }
}

__device__ __forceinline__ int next_set(unsigned long long u0, unsigned long long u1, int from) {
    if (from < 64) { const unsigned long long x = u0 >> from; if (x) return from + __builtin_ctzll(x); from = 64; }
    if (from < 128) { const unsigned long long x = u1 >> (from - 64); if (x) return from + __builtin_ctzll(x); }
    return 128;
}
__device__ __forceinline__ void nsa_unit(int b, int g, int tile, bf16* QN  , const bf16* Z1, const bf16* KC, const bf16* VCT, const bf16* VTS, const bf16* VTW, LAS char* lds, const int wid, const int lane) {
    const int tid = wid * 64 + lane, r32 = lane & 31, hi = lane >> 5;
    const int t0 = tile * 64, cur = tile, tl = r32 >> 2, hh = r32 & 3, head = 4 * g + hh, tok = 8 * wid + tl, t = t0 + tok, bg = b * 2 + g;
    const size_t rowq = (size_t)b * SEQ + t;
    bf16x8 qr[4];
#pragma unroll
    for (int d0 = 0; d0 < 4; ++d0) qr[d0] = *(const bf16x8*)(QN + rowq * 512 + head * 64 + d0 * 16 + hi * 8);
    const float slope = __builtin_amdgcn_exp2f(-(float)(head + 1)) * 1.4426950408889634f;
    f32x16 czero; zero16(czero);
    const bf16* gz = Z1 + rowq * Z1P + 1184 + head * 3;
    const float g0 = sigmoidf(bf2f(gz[0])), g1 = sigmoidf(bf2f(gz[1])), g2 = sigmoidf(bf2f(gz[2]));
    LAS float* imp = (LAS float*)(lds + L_IMP);
    LAS unsigned* selm = (LAS unsigned*)(lds + L_SELM);
    LAS unsigned* wun = (LAS unsigned*)(lds + L_WUN);
    for (int i = lane; i < 8 * IMP_P; i += 64) imp[8 * wid * IMP_P + i] = 0.f;
    f32x16 out0, out1; zero16(out0); zero16(out1);
    const int krow = tid >> 3, kch = tid & 7;
    const int kdst = krow * 144 + kch * 16, vdst = krow * 136 + kch * 16;
    u32x4 sk, sv;
#define NSA_STORE(buf, withv) do { *(LAS u32x4*)(lds + L_KB + (buf) * KB_SZ + kdst) = sk; if (withv) { LAS char* vp_ = lds + L_VB + (buf) * VB_SZ + vdst; u32x2 a_; a_.x = sv.x; a_.y = sv.y; *(LAS u32x2*)vp_ = a_; a_.x = sv.z; a_.y = sv.w; *(LAS u32x2*)(vp_ + 8) = a_; } } while (0)

    const int ncmp = t0 / 16 + 3, nct = (ncmp + 63) / 64;
    const bf16* kcsrc = KC + ((size_t)bg * 512 + krow) * 64 + kch * 8;
    const bf16* vcsrc = VCT + ((size_t)bg * 64 + krow) * 512 + kch * 8;
    float mc = NEGF, lc = 0.f;
    {
        sk = *(const u32x4*)kcsrc; NSA_STORE(0, false); __syncthreads();
        for (int it = 0; it < nct; ++it) {
            const bool more = it + 1 < nct;
            if (more) sk = *(const u32x4*)(kcsrc + (size_t)(it + 1) * 64 * 64);
            const LAS char* Kb = lds + L_KB + (it & 1) * KB_SZ;
            f32x16 s0 = qk_sub<4>(Kb, 144, 0, qr, czero, r32, hi), s1 = qk_sub<4>(Kb, 144, 1, qr, czero, r32, hi);
            float mx = NEGF;
#pragma unroll
            for (int r = 0; r < 16; ++r) { const int i0 = it * 64 + crow(r, hi); const int d0_ = t - (16 * i0 + 31), d1_ = d0_ - 512;
                s0[r] = d0_ >= 0 ? s0[r] - slope * (float)d0_ : NEGF; s1[r] = d1_ >= 0 ? s1[r] - slope * (float)d1_ : NEGF; mx = fmaxf(mx, fmaxf(s0[r], s1[r])); }
            mx = fmaxf(mx, __shfl_xor(mx, 32));
            const float mn = fmaxf(mc, mx), alpha = __builtin_amdgcn_exp2f(mc - mn); mc = mn;
            float sum = 0.f;
#pragma unroll
            for (int r = 0; r < 16; ++r) { sum += (s0[r] > -1e29f ? __builtin_amdgcn_exp2f(s0[r] - mn) : 0.f) + (s1[r] > -1e29f ? __builtin_amdgcn_exp2f(s1[r] - mn) : 0.f); }
            lc = lc * alpha + sum;
            if (more) NSA_STORE((it + 1) & 1, false);
            __syncthreads();
        }
        lc += __shfl_xor(lc, 32);
    }
    {
        const float invl = 1.f / fmaxf(lc, 1e-30f);
        f32x16 o0, o1; zero16(o0); zero16(o1);
        sk = *(const u32x4*)kcsrc; sv = *(const u32x4*)vcsrc; NSA_STORE(0, true); __syncthreads();
        for (int it = 0; it < nct; ++it) {
            const bool more = it + 1 < nct;
            if (more) { sk = *(const u32x4*)(kcsrc + (size_t)(it + 1) * 64 * 64); sv = *(const u32x4*)(vcsrc + (it + 1) * 64); }
            const LAS char* Kb = lds + L_KB + (it & 1) * KB_SZ; const LAS char* Vb = lds + L_VB + (it & 1) * VB_SZ;
            f32x16 s0 = qk_sub<4>(Kb, 144, 0, qr, czero, r32, hi), s1 = qk_sub<4>(Kb, 144, 1, qr, czero, r32, hi);
#pragma unroll
            for (int r = 0; r < 16; ++r) { const int i0 = it * 64 + crow(r, hi); const int d0_ = t - (16 * i0 + 31), d1_ = d0_ - 512;
                s0[r] = d0_ >= 0 ? __builtin_amdgcn_exp2f(s0[r] - slope * (float)d0_ - mc) * invl : 0.f; s1[r] = d1_ >= 0 ? __builtin_amdgcn_exp2f(s1[r] - slope * (float)d1_ - mc) * invl : 0.f; }
            pv_sub(o0, o1, Vb, 0, s0, r32, hi); pv_sub(o0, o1, Vb, 1, s1, r32, hi);
#pragma unroll
            for (int sub = 0; sub < 2; ++sub) {
                f32x16 ps = sub ? s1 : s0;
#pragma unroll
                for (int r = 0; r < 16; ++r) { ps[r] += __shfl_xor(ps[r], 1); ps[r] += __shfl_xor(ps[r], 2); }
                LAS float* row = imp + tok * IMP_P + (it * 64 + sub * 32) / 4 + hi;
                if (hh == 0) {
#pragma unroll
                    for (int a = 0; a < 4; ++a) row[2 * a] += (ps[4 * a] + ps[4 * a + 1]) + (ps[4 * a + 2] + 0.5f * ps[4 * a + 3]);
                }
                LDS_WAIT();
                if (hh == 0) {
#pragma unroll
                    for (int a = 0; a < 4; ++a) row[2 * a + 1] += 0.5f * ps[4 * a + 3];
                }
                LDS_WAIT();
            }
            if (more) NSA_STORE((it + 1) & 1, true);
            __syncthreads();
        }
#pragma unroll
        for (int r = 0; r < 16; ++r) { out0[r] += g0 * o0[r]; out1[r] += g0 * o1[r]; }
    }
    {
        const int nlast = cur - 2;
#pragma unroll 1
        for (int tk = 0; tk < 8; ++tk) {
            const LAS float* row = imp + (8 * wid + tk) * IMP_P;
            const int j0 = lane, j1 = lane + 64; const float v0 = row[j0], v1 = row[j1];
            int c0 = 0, c1 = 0;
#pragma unroll 2
            for (int jj = 1; jj <= nlast; ++jj) { const float x = row[jj]; c0 += (x > v0 || (x == v0 && jj < j0)) ? 1 : 0; c1 += (x > v1 || (x == v1 && jj < j1)) ? 1 : 0; }
            const bool s0 = j0 >= 1 && j0 <= nlast && c0 < 13, s1 = j1 <= nlast && c1 < 13;
            unsigned long long m0 = __ballot(s0), m1 = __ballot(s1);
            m0 |= 1ull;
            if (cur < 64) m0 |= 1ull << cur; else m1 |= 1ull << (cur - 64);
            if (cur >= 1) { if (cur - 1 < 64) m0 |= 1ull << (cur - 1); else m1 |= 1ull << (cur - 65); }
            if (lane == 0) { selm[(8 * wid + tk) * 4 + 0] = (unsigned)m0; selm[(8 * wid + tk) * 4 + 1] = (unsigned)(m0 >> 32); selm[(8 * wid + tk) * 4 + 2] = (unsigned)m1; selm[(8 * wid + tk) * 4 + 3] = (unsigned)(m1 >> 32); }
        }
        LDS_WAIT();
        if (lane < 4) { unsigned x = 0; for (int tk = 0; tk < 8; ++tk) x |= selm[(8 * wid + tk) * 4 + lane]; wun[wid * 4 + lane] = x; }
        __syncthreads();
    }
    const unsigned long long tm0 = (unsigned long long)selm[tok * 4 + 0] | ((unsigned long long)selm[tok * 4 + 1] << 32), tm1 = (unsigned long long)selm[tok * 4 + 2] | ((unsigned long long)selm[tok * 4 + 3] << 32);
    unsigned long long wu0, wu1, gu0 = 0, gu1 = 0;
    {
        const unsigned a0 = __builtin_amdgcn_readfirstlane(wun[wid * 4 + 0]), a1 = __builtin_amdgcn_readfirstlane(wun[wid * 4 + 1]), a2 = __builtin_amdgcn_readfirstlane(wun[wid * 4 + 2]), a3 = __builtin_amdgcn_readfirstlane(wun[wid * 4 + 3]);
        wu0 = (unsigned long long)a0 | ((unsigned long long)a1 << 32); wu1 = (unsigned long long)a2 | ((unsigned long long)a3 << 32);
        for (int w = 0; w < 8; ++w) {
            const unsigned b0 = __builtin_amdgcn_readfirstlane(wun[w * 4 + 0]), b1 = __builtin_amdgcn_readfirstlane(wun[w * 4 + 1]), b2 = __builtin_amdgcn_readfirstlane(wun[w * 4 + 2]), b3 = __builtin_amdgcn_readfirstlane(wun[w * 4 + 3]);
            gu0 |= (unsigned long long)b0 | ((unsigned long long)b1 << 32); gu1 |= (unsigned long long)b2 | ((unsigned long long)b3 << 32);
        }
    }
    {
        const bf16* ksrc = Z1 + ((size_t)b * SEQ + krow) * Z1P + 256 + g * 64 + kch * 8;
        const bf16* vsrc = VTS + ((size_t)(b * 128 + g * 64 + krow)) * SEQ + kch * 8;
        float mref = 0.f, thr = -1e29f, l = 0.f; f32x16 o0, o1; zero16(o0); zero16(o1);
        const float sl4 = slope * (float)(4 * hi);
        int j = next_set(gu0, gu1, 0);
        sk = *(const u32x4*)(ksrc + (size_t)j * 64 * Z1P); sv = *(const u32x4*)(vsrc + j * 64); NSA_STORE(0, true); __syncthreads();
        int par = 0;
        while (j < 128) {
            const int nj = next_set(gu0, gu1, j + 1);
            const bool more = nj < 128;
            if (more) { sk = *(const u32x4*)(ksrc + (size_t)nj * 64 * Z1P); sv = *(const u32x4*)(vsrc + nj * 64); }
            const bool wsel = ((j < 64 ? (wu0 >> j) : (wu1 >> (j - 64))) & 1ull) != 0;
            if (wsel) {
                const LAS char* Kb = lds + L_KB + par * KB_SZ; const LAS char* Vb = lds + L_VB + par * VB_SZ;
                const bool tsel = ((j < 64 ? (tm0 >> j) : (tm1 >> (j - 64))) & 1ull) != 0;
                f32x16 cin; fill16(cin, tsel ? (sl4 - mref - slope * (float)(t - j * 64)) : NEGF);
                f32x16 s0 = qk_sub<4>(Kb, 144, 0, qr, cin, r32, hi), s1 = qk_sub<4>(Kb, 144, 1, qr, cin, r32, hi);
#pragma unroll
                for (int r = 0; r < 16; ++r) { s0[r] = __builtin_fmaf(slope, (float)((r & 3) + 8 * (r >> 2)), s0[r]); s1[r] = __builtin_fmaf(slope, (float)((r & 3) + 8 * (r >> 2) + 32), s1[r]); }
                if (j == cur) {
#pragma unroll
                    for (int r = 0; r < 16; ++r) { const int d0_ = t - (j * 64 + crow(r, hi)); if (d0_ < 0) s0[r] = NEGF; if (d0_ < 32) s1[r] = NEGF; }
                }
                sm_tile(s0, s1, mref, thr, l, o0, o1);
                pv_sub(o0, o1, Vb, 0, s0, r32, hi); pv_sub(o0, o1, Vb, 1, s1, r32, hi);
            }
            if (more) NSA_STORE(par ^ 1, true);
            __syncthreads();
            par ^= 1; j = nj;
        }
        l += __shfl_xor(l, 32);
        const float sc = g1 / fmaxf(l, 1e-30f);
#pragma unroll
        for (int r = 0; r < 16; ++r) { out0[r] += sc * o0[r]; out1[r] += sc * o1[r]; }
    }
    {
        const bf16* ksrc = Z1 + ((size_t)b * SEQ + krow) * Z1P + 512 + g * 64 + kch * 8;
        const bf16* vsrc = VTW + ((size_t)(b * 128 + g * 64 + krow)) * SEQ + kch * 8;
        float mref = 0.f, thr = -1e29f, l = 0.f; f32x16 o0, o1; zero16(o0); zero16(o1);
        const float sl4 = slope * (float)(4 * hi);
        const int tw0 = t0 + 8 * wid;
        const int kt_first = (t0 >= 512) ? (t0 - 512) / 64 : 0, kt_last = t0 / 64;
        sk = *(const u32x4*)(ksrc + (size_t)kt_first * 64 * Z1P); sv = *(const u32x4*)(vsrc + kt_first * 64); NSA_STORE(0, true); __syncthreads();
        int par = 0;
        for (int kt = kt_first; kt <= kt_last; ++kt) {
            const bool more = kt < kt_last;
            if (more) { sk = *(const u32x4*)(ksrc + (size_t)(kt + 1) * 64 * Z1P); sv = *(const u32x4*)(vsrc + (kt + 1) * 64); }
            const LAS char* Kb = lds + L_KB + par * KB_SZ; const LAS char* Vb = lds + L_VB + par * VB_SZ;
            f32x16 cin; fill16(cin, sl4 - mref - slope * (float)(t - kt * 64));
            f32x16 s0 = qk_sub<4>(Kb, 144, 0, qr, cin, r32, hi), s1 = qk_sub<4>(Kb, 144, 1, qr, cin, r32, hi);
#pragma unroll
            for (int r = 0; r < 16; ++r) { s0[r] = __builtin_fmaf(slope, (float)((r & 3) + 8 * (r >> 2)), s0[r]); s1[r] = __builtin_fmaf(slope, (float)((r & 3) + 8 * (r >> 2) + 32), s1[r]); }
            if (kt * 64 + 63 > tw0 || kt * 64 < tw0 + 7 - 511) {
#pragma unroll
                for (int r = 0; r < 16; ++r) { const int d0_ = t - (kt * 64 + crow(r, hi)), d1_ = d0_ - 32;
                    if (!(d0_ >= 0 && d0_ < 512)) s0[r] = NEGF; if (!(d1_ >= 0 && d1_ < 512)) s1[r] = NEGF; }
            }
            sm_tile(s0, s1, mref, thr, l, o0, o1);
            pv_sub(o0, o1, Vb, 0, s0, r32, hi); pv_sub(o0, o1, Vb, 1, s1, r32, hi);
            if (more) NSA_STORE(par ^ 1, true);
            __syncthreads();
            par ^= 1;
        }
        l += __shfl_xor(l, 32);
        const float sc = g2 / fmaxf(l, 1e-30f);
#pragma unroll
        for (int r = 0; r < 16; ++r) { out0[r] += sc * o0[r]; out1[r] += sc * o1[r]; }
    }
#undef NSA_STORE
    bf16* orow = QN + rowq * 512 + head * 64 + 4 * hi;
#pragma unroll
    for (int a = 0; a < 4; ++a) {
        u32x2 w; w.x = cvtpk(out0[4 * a], out0[4 * a + 1]); w.y = cvtpk(out0[4 * a + 2], out0[4 * a + 3]); *(u32x2*)(orow + 8 * a) = w;
        w.x = cvtpk(out1[4 * a], out1[4 * a + 1]); w.y = cvtpk(out1[4 * a + 2], out1[4 * a + 3]); *(u32x2*)(orow + 32 + 8 * a) = w;
    }
}

struct Args { const float* in[27]; float* out; unsigned char* ws; int ph_lo, ph_hi; };
enum { I_X = 0, I_F1PRE, I_F1POST, I_F1G, I_F1U, I_F1D, I_MPRE, I_MPOST, I_WIN, I_CPK, I_CW1K, I_CW2K, I_CPV, I_CW1V, I_CW2V, I_QNG, I_WUQ, I_KVNG, I_WUKV, I_WPN, I_WPM, I_WOUT, I_F2PRE, I_F2POST, I_F2G, I_F2U, I_F2D };

__global__ void __launch_bounds__(NWAVES * 64, 2) fwd_kernel(Args args) {
    extern __shared__ __attribute__((aligned(16))) unsigned char lds_raw[];
    LAS unsigned char* lds = (LAS unsigned char*)lds_raw;
    const int wave = __builtin_amdgcn_readfirstlane((int)threadIdx.x >> 6);
    const int G = gridDim.x, c = blockIdx.x;
    const int NGW = G * NWAVES, NGT = G * NWAVES * 64;
#define IDS() const int lane = mk_lane(); const int tid = wave * 64 + lane; const int gw = c * NWAVES + wave; const int gt = c * (NWAVES * 64) + tid; (void)tid; (void)gw; (void)gt
#define WGU1 ((bf16*)(args.ws + O_WGU1))
#define WD1 ((bf16*)(args.ws + O_WD1))
#define WGU2 ((bf16*)(args.ws + O_WGU2))
#define WD2 ((bf16*)(args.ws + O_WD2))
#define WIN ((bf16*)(args.ws + O_WIN))
#define WPN ((bf16*)(args.ws + O_WPN))
#define WPM ((bf16*)(args.ws + O_WPM))
#define WOUT ((bf16*)(args.ws + O_WOUT))
#define WUQ ((bf16*)(args.ws + O_WUQ))
#define WUKV ((bf16*)(args.ws + O_WUKV))
#define CW1K ((bf16*)(args.ws + O_CW1K))
#define CW1V ((bf16*)(args.ws + O_CW1V))
#define A1 ((bf16*)(args.ws + O_A1))
#define IM2K ((bf16*)(args.ws + O_IM2K))
#define IM2V ((bf16*)(args.ws + O_IM2V))
#define CQN ((bf16*)(args.ws + O_CQN))
#define CKVN ((bf16*)(args.ws + O_CKVN))
#define KR ((bf16*)(args.ws + O_KR))
#define HK ((bf16*)(args.ws + O_HK))
#define HV ((bf16*)(args.ws + O_HV))
#define KC ((bf16*)(args.ws + O_KC))
#define VCT ((bf16*)(args.ws + O_VCT))
#define MG ((bf16*)(args.ws + O_MG))
#define H ((bf16*)(args.ws + O_H))
#define Z1 ((bf16*)(args.ws + O_Z1))
#define QN ((bf16*)(args.ws + O_QN))
#define YM ((bf16*)(args.ws + O_YM))
#define KM ((bf16*)(args.ws + O_KM))
#define GM ((bf16*)(args.ws + O_GM))
#define QM ((bf16*)(args.ws + O_QM))
#define VTM ((bf16*)(args.ws + O_VTM))
#define VTS ((bf16*)(args.ws + O_VTS))
#define VTW ((bf16*)(args.ws + O_VTW))
#define F ((float*)(args.ws + O_F))
#define X (args.out)
    typedef const float* cfp_t;
    const __attribute__((address_space(4))) cfp_t* in = (const __attribute__((address_space(4))) cfp_t*)__builtin_amdgcn_kernarg_segment_ptr();
    asm volatile("" : "+s"(in));
    const int lo = args.ph_lo, hi_ph = args.ph_hi;
#define IN(k) (lo <= (k) && (k) < hi_ph)
#if MK_PER_PHASE
#define SEAM(k) do { } while (0)
#else
    if (lo == 0 && hi_ph == NPHASE) { cg::grid_group grid = cg::this_grid(); grid.sync(); }
    volatile LAS unsigned* xst = (volatile LAS unsigned*)(lds + 131072 + 512);
    XcdBarrier xbar;
    { const int l_ = mk_lane(); const int t_ = wave * 64 + l_; if (t_ < 2) xst[t_] = 0u; __syncthreads(); xbar = xcd_barrier_post((unsigned*)(args.ws + O_CTL), xst, t_); }
#define SEAM(k) do { if (IN(k) && IN((k) + 1)) { const int l_ = mk_lane(); xcd_barrier(xbar, wave * 64 + l_); } } while (0)
#endif
#define GEMM_CALL(EPI, A_, B_, M_, N_, K_, cc, E_) do { Gemm g_{(const pg8::bf16_t*)(A_), (const pg8::bf16_t*)(B_), (M_), (N_), (K_)}; StaticOrder S_; S_.init((M_), (N_), G, (cc)); \
        const int l_ = mk_lane(); pg8::gemm_phase<EPI, StaticOrder, false, PG8_SP2>(lds, g_, S_, (E_), wave, l_); } while (0)

    if (IN(0)) {
        IDS();
        LAS float* scr = (LAS float*)(lds + wave * 16384);
        transpose_mat(in[I_F1G], DFF, MapGU{0}, 1024, DFF, WGU1, scr, gw, NGW, lane);
        transpose_mat(in[I_F1U], DFF, MapGU{1}, 1024, DFF, WGU1, scr, gw, NGW, lane);
        transpose_mat(in[I_F1D], 1024, MapPlain{}, 2816, 1024, WD1, scr, gw, NGW, lane);
        transpose_mat(in[I_WIN], 3768, MapWin{}, 1024, 3840, WIN, scr, gw, NGW, lane);
        transpose_mat(in[I_F2G], DFF, MapGU{0}, 1024, DFF, WGU2, scr, gw, NGW, lane);
        transpose_mat(in[I_F2U], DFF, MapGU{1}, 1024, DFF, WGU2, scr, gw, NGW, lane);
        transpose_mat(in[I_F2D], 1024, MapPlain{}, 2816, 1024, WD2, scr, gw, NGW, lane);
        transpose_mat(in[I_WPN], 1024, MapPlain{}, 512, 1024, WPN, scr, gw, NGW, lane);
        transpose_mat(in[I_WPM], 1024, MapPlain{}, 512, 1024, WPM, scr, gw, NGW, lane);
        transpose_mat(in[I_WOUT], 1024, MapPlain{}, 1024, 1024, WOUT, scr, gw, NGW, lane);
        transpose_mat(in[I_WUQ], 768, MapPlain{}, 256, 768, WUQ, scr, gw, NGW, lane);
        transpose_mat(in[I_WUKV], 1024, MapUkv{}, 128, 1024, WUKV, scr, gw, NGW, lane);
        transpose_mat(in[I_CW1K], 256, MapPlain{}, 2048, 256, CW1K, scr, gw, NGW, lane);
        transpose_mat(in[I_CW1V], 256, MapPlain{}, 2048, 256, CW1V, scr, gw, NGW, lane);
        for (int m = gw; m < MTOK; m += NGW) { const f32x4* xr = (const f32x4*)(in[I_X] + (size_t)m * DM) + lane; f32x4 v[4];
#pragma unroll
            for (int j = 0; j < 4; ++j) v[j] = xr[64 * j];
            rms_row_to_bf16(v, in[I_F1PRE], A1 + (size_t)m * DM, lane); }
        __syncthreads();
    }
    SEAM(0);
    if (IN(1)) GEMM_CALL(EpiSwiglu, A1, WGU1, MTOK, 5632, 1024, c, (EpiSwiglu{H}));
    SEAM(1);
#ifdef PROBE_FFN2
    if (IN(2)) GEMM_CALL(EpiF32, H, WD1, MTOK, 1024, 2816, c, (EpiF32{F, DM}));
    if (IN(1)) GEMM_CALL(EpiSwiglu, A1, WGU1, MTOK, 5632, 1024, c, (EpiSwiglu{H}));
#endif
    if (IN(2)) GEMM_CALL(EpiF32, H, WD1, MTOK, 1024, 2816, c, (EpiF32{F, DM}));
    SEAM(2);
    if (IN(3)) { IDS(); rowop<true>(F, in[I_X], 0.5f, in[I_F1POST], X, in[I_MPRE], A1, gw, NGW, lane); }
    SEAM(3);
    if (IN(4)) GEMM_CALL(EpiWin, A1, WIN, MTOK, 3840, 1024, c, (EpiWin{QN, Z1, GM, VTS, VTW}));
    SEAM(4);
    if (IN(5)) {
        IDS();
        for (int ch = gt; ch < 2 * 4096 * 256; ch += NGT) {
            const int kv = ch >> 20, r = (ch >> 8) & 4095, c8 = ch & 255, l = c8 >> 3, d0 = (c8 & 7) * 8, bgi = r >> 9, i = r & 511, b = bgi >> 1, g = bgi & 1;
            u32x4 o = (u32x4){0u, 0u, 0u, 0u};
            if (i < 511) {
                const u32x4 z = *(const u32x4*)(Z1 + ((size_t)b * SEQ + 16 * i + l) * Z1P + kv * 128 + g * 64 + d0);
                const float* pe = (kv ? in[I_CPV] : in[I_CPK]) + l * 64 + d0; const f32x4 p0 = *(const f32x4*)pe, p1 = *(const f32x4*)(pe + 4);
                o.x = cvtpk(bflo(z.x) + p0.x, bfhi(z.x) + p0.y); o.y = cvtpk(bflo(z.y) + p0.z, bfhi(z.y) + p0.w); o.z = cvtpk(bflo(z.z) + p1.x, bfhi(z.z) + p1.y); o.w = cvtpk(bflo(z.w) + p1.z, bfhi(z.w) + p1.w);
            }
            *(u32x4*)((kv ? IM2V : IM2K) + (size_t)r * 2048 + c8 * 8) = o;
        }
        for (int m = gw; m < MTOK; m += NGW) {
            const bf16* zr = Z1 + (size_t)m * Z1P;
            { const u32x2 w = *(const u32x2*)(zr + 768 + 4 * lane); const float a0 = bflo(w.x), a1 = bfhi(w.x), a2 = bflo(w.y), a3 = bfhi(w.y);
              const float r = rsqrtf(wave_sum((a0 * a0 + a1 * a1) + (a2 * a2 + a3 * a3)) * (1.f / 256.f) + EPS); const f32x4 gq = *(const f32x4*)(in[I_QNG] + 4 * lane);
              u32x2 o; o.x = cvtpk(a0 * r * gq.x, a1 * r * gq.y); o.y = cvtpk(a2 * r * gq.z, a3 * r * gq.w); *(u32x2*)(CQN + (size_t)m * 256 + 4 * lane) = o; }
            { const unsigned w = *(const unsigned*)(zr + 1024 + 2 * lane); const float a0 = bflo(w), a1 = bfhi(w);
              const float r = rsqrtf(wave_sum(a0 * a0 + a1 * a1) * (1.f / 128.f) + EPS); const float gk0 = in[I_KVNG][2 * lane], gk1 = in[I_KVNG][2 * lane + 1];
              *(unsigned*)(CKVN + (size_t)m * 128 + 2 * lane) = cvtpk(a0 * r * gk0, a1 * r * gk1); }
            if (lane < 16) { const float x1 = bf2f(zr[1152 + lane]), x2 = bf2f(zr[1152 + 16 + lane]); float cs, sn; rope_cs(m & 8191, lane, cs, sn);
              KR[(size_t)m * 32 + lane] = f2bf(x1 * cs - x2 * sn); KR[(size_t)m * 32 + 16 + lane] = f2bf(x1 * sn + x2 * cs); }
        }
    }
    SEAM(5);
    if (IN(6)) {
        GEMM_CALL(EpiGelu, IM2K, CW1K, 4096, 256, 2048, c, (EpiGelu{HK, 256}));
        GEMM_CALL(EpiGelu, IM2V, CW1V, 4096, 256, 2048, (c + G / 2) % G, (EpiGelu{HV, 256}));
        GEMM_CALL(EpiQup, CQN, WUQ, MTOK, 768, 256, c, (EpiQup{QM}));
        GEMM_CALL(EpiKVup, CKVN, WUKV, MTOK, 1024, 128, c, (EpiKVup{KM, VTM}));
    }
    SEAM(6);
    if (IN(7)) {
        IDS();
        for (int idx = gt; idx < 2 * 4096 * 64; idx += NGT) {
            const int kv = idx >> 18, r = (idx >> 6) & 4095, d = idx & 63;
            const bf16* hrow = (kv ? HV : HK) + (size_t)r * 256; const float* w2 = (kv ? in[I_CW2V] : in[I_CW2K]) + d;
            float acc = 0.f;
            for (int j8 = 0; j8 < 32; ++j8) { const u32x4 hw = *(const u32x4*)(hrow + j8 * 8); const float* wp = w2 + (size_t)j8 * 8 * 64;
                acc += bflo(hw.x) * wp[0] + bfhi(hw.x) * wp[64] + bflo(hw.y) * wp[128] + bfhi(hw.y) * wp[192] + bflo(hw.z) * wp[256] + bfhi(hw.z) * wp[320] + bflo(hw.w) * wp[384] + bfhi(hw.w) * wp[448]; }
            if (kv == 0) KC[(size_t)r * 64 + d] = f2bf(acc); else VCT[((size_t)(r >> 9) * 64 + d) * 512 + (r & 511)] = f2bf(acc);
        }
    }
    SEAM(7);
    if (IN(8)) {
        IDS();
        LAS char* al = (LAS char*)lds;
#ifdef PROBE_MLA2
        for (int rep_ = 0; rep_ < 2; ++rep_)
#endif
        for (int i = 0; i * G < 1024; ++i) { const int p = (i & 1) ? (G - 1 - c) : c, uu = i * G + p;
            if (uu < 1024) { const int qb = 31 - (uu >> 5), bh = uu & 31;
#ifndef NO_MLA
 mla_unit(bh >> 3, bh & 7, qb, QM, KM, KR, VTM, YM, al, wave, lane);
#endif
 } }
        for (int i = 0; i * G < 1024; ++i) { const int p = (i & 1) ? (G - 1 - c) : c, uu = i * G + p;
            if (uu < 1024) { const int tile = 127 - (uu >> 3), bgi = uu & 7;
#ifndef NO_NSA
 nsa_unit(bgi >> 1, bgi & 1, tile, QN, Z1, KC, VCT, VTS, VTW, al, wave, lane);
#endif
 } }
    }
    SEAM(8);
    if (IN(9)) {
        GEMM_CALL(EpiProj<false>, QN, WPN, MTOK, 1024, 512, c, (EpiProj<false>{GM, MG}));
        GEMM_CALL(EpiProj<true>, YM, WPM, MTOK, 1024, 512, c, (EpiProj<true>{GM, MG}));
    }
    SEAM(9);
    if (IN(10)) GEMM_CALL(EpiF32, MG, WOUT, MTOK, 1024, 1024, c, (EpiF32{F, DM}));
    SEAM(10);
    if (IN(11)) { IDS(); rowop<true>(F, X, 1.0f, in[I_MPOST], X, in[I_F2PRE], A1, gw, NGW, lane); }
    SEAM(11);
    if (IN(12)) GEMM_CALL(EpiSwiglu, A1, WGU2, MTOK, 5632, 1024, c, (EpiSwiglu{H}));
    SEAM(12);
    if (IN(13)) GEMM_CALL(EpiF32, H, WD2, MTOK, 1024, 2816, c, (EpiF32{F, DM}));
    SEAM(13);
    if (IN(14)) { IDS(); rowop<false>(F, X, 0.5f, in[I_F2POST], X, nullptr, nullptr, gw, NGW, lane); }
#undef IN
#undef IDS
#undef SEAM
#undef GEMM_CALL
#undef WGU1
#undef WD1
#undef WGU2
#undef WD2
#undef WIN
#undef WPN
#undef WPM
#undef WOUT
#undef WUQ
#undef WUKV
#undef CW1K
#undef CW1V
#undef A1
#undef IM2K
#undef IM2V
#undef CQN
#undef CKVN
#undef KR
#undef HK
#undef HV
#undef KC
#undef VCT
#undef MG
#undef H
#undef Z1
#undef QN
#undef YM
#undef KM
#undef GM
#undef QM
#undef VTM
#undef VTS
#undef VTW
#undef F
#undef X
}
}

extern "C" void kernel_launch(void* const* d_in, const int* in_sizes, int n_in, void* d_out, int out_size, void* d_ws, size_t ws_size, hipStream_t stream) {
    using namespace mk;
    static int grid = 0;
    if (grid == 0) {
        if (n_in != 27 || out_size != MTOK * DM || ws_size < O_END) { fprintf(stderr, "kernel_launch: unexpected problem (n_in %d out %d ws %zu)\n", n_in, out_size, ws_size); grid = -1; return; }
        int dev = 0, cus = 0, per_cu = 0;
        hipGetDevice(&dev); hipDeviceGetAttribute(&cus, hipDeviceAttributeMultiprocessorCount, dev);
        if (hipFuncSetAttribute((const void*)fwd_kernel, hipFuncAttributeMaxDynamicSharedMemorySize, LDS_BYTES) != hipSuccess) { fprintf(stderr, "kernel_launch: hipFuncSetAttribute failed\n"); grid = -1; return; }
        if (hipOccupancyMaxActiveBlocksPerMultiprocessor(&per_cu, (const void*)fwd_kernel, NWAVES * 64, LDS_BYTES) != hipSuccess || per_cu < 1) { fprintf(stderr, "kernel_launch: occupancy query says %d\n", per_cu); per_cu = 1; }
        (void)hipGetLastError();
        grid = cus * per_cu;
    }
    if (grid < 0) return;
    if (hipMemsetAsync((char*)d_ws + O_CTL, 0, 16384, stream) != hipSuccess) { fprintf(stderr, "kernel_launch: memset failed\n"); return; }
    Args a{};
    for (int i = 0; i < 27; ++i) a.in[i] = (const float*)d_in[i];
    a.out = (float*)d_out; a.ws = (unsigned char*)d_ws;
#if MK_PER_PHASE
    for (int ph = 0; ph < NPHASE; ++ph) { a.ph_lo = ph; a.ph_hi = ph + 1; hipLaunchKernelGGL(fwd_kernel, dim3(grid), dim3(NWAVES * 64), LDS_BYTES, stream, a); }
#else
    a.ph_lo = 0; a.ph_hi = NPHASE;
    void* kargs[] = {&a};
    hipError_t e = hipLaunchCooperativeKernel((const void*)fwd_kernel, dim3(grid), dim3(NWAVES * 64), kargs, LDS_BYTES, stream);
    if (e != hipSuccess) fprintf(stderr, "cooperative launch failed: %s (grid %d)\n", hipGetErrorString(e), grid);
#endif
}
```

```cpp
#include <hip/hip_runtime.h>
#include <hip/hip_cooperative_groups.h>
#include <cstdio>
#include <cstdint>
namespace cg = cooperative_groups;
namespace pg8 {
#define PG8_LAS __attribute__((address_space(3)))
typedef unsigned short bf16_t;
typedef short bf16x8 __attribute__((ext_vector_type(8)));
typedef float f32x4 __attribute__((ext_vector_type(4)));
typedef unsigned u32x4 __attribute__((ext_vector_type(4)));
constexpr int BM = 256, BK = 64, HALF = 128, HTB = HALF * BK * 2  , STAGE_BYTES = 8 * HTB, NXCD = 8, WGM = 8;

__host__ __device__ __forceinline__ int lds_byte(int r, int c) { const int st = (r >> 4) * 2 + (c >> 5), rr = r & 15, cc = c & 31, ob = rr * 64 + cc * 2; return st * 1024 + (ob ^ (((ob >> 9) & 1) << 5)); }
__host__ __device__ __forceinline__ void stage_rc(int b, int& R, int& C) { const int st = b / 1024, sb = b % 1024, swz = sb ^ (((sb >> 9) & 1) << 5); R = (st >> 1) * 16 + swz / 64; C = (st & 1) * 32 + (swz % 64) / 2; }
__host__ __device__ __forceinline__ int perm32(int rho) { const int n = rho >> 4, i = rho & 15; return 8 * (i >> 2) + 4 * n + (i & 3); }

struct Unit { int pm, pn; };
struct Gemm { const bf16_t* A; const bf16_t* Bt; int M, N, K; };

struct StaticOrder {
    int nM, nN, nwg, G, c;
    __host__ __device__ void init(int M, int N, int G_, int c_) { nM = M / BM; nN = N / BM; nwg = nM * nN; G = G_; c = c_; }
    __host__ __device__ bool next(int i, Unit& u) const {
        const long L = (long)i * G + c; if (L >= nwg) return false;
        int wgid = (int)L; { const int q = nwg / NXCD, r = nwg % NXCD, xcd = wgid % NXCD, off = wgid / NXCD; wgid = (xcd < r ? xcd * (q + 1) : r * (q + 1) + (xcd - r) * q) + off; }
        const int nig = WGM * nN, gid = wgid / nig, fm = gid * WGM, gsz = (nM - fm) < WGM ? (nM - fm) : WGM;
        u.pm = fm + ((wgid % nig) % gsz); u.pn = (wgid % nig) / gsz; return true;
    }
    __device__ __forceinline__ void a_ready(const Unit&) const {}
    __device__ __forceinline__ void done(const Unit&) const {}
};

__device__ __forceinline__ unsigned cvt_pk_bf16(float lo, float hi) { unsigned r; asm volatile("v_cvt_pk_bf16_f32 %0, %1, %2" : "=v"(r) : "v"(lo), "v"(hi)); return r; }
typedef float f32x2 __attribute__((ext_vector_type(2)));
template <class Epi, class Sched, bool ALIGN_EPI = false, bool SP2 = false>
__device__ __forceinline__ void gemm_phase(PG8_LAS unsigned char* lds, const Gemm g, const Sched& S, const Epi& E, const int wid, const int lane) {
    const int tid = wid * 64 + lane, wr = wid >> 2, wc = wid & 3, fr = lane & 15, fq = lane >> 4;
    const int K = g.K, nt = K / BK;
    unsigned voffA[2], voffB[2];
#pragma unroll
    for (int i = 0; i < 2; ++i) { int R, C; stage_rc(tid * 16 + i * 8192, R, C); const int Rb = Epi::PERM ? ((R & ~31) + perm32(R & 31)) : R;
        voffA[i] = (unsigned)(R * K + C) * 2u; voffB[i] = (unsigned)(Rb * K + C) * 2u; }
    const size_t kstep = (size_t)(BK * 2);
    const size_t hstep = (size_t)HALF * K * 2;
    const size_t tstep = 2 * hstep;
    const unsigned ldsw = (unsigned)wid * 1024u;
    const int aoff = lds_byte(wr * 64 + fr, fq * 8), boff = lds_byte(wc * 32 + fr, fq * 8);
#define PG8_SA(b, h) (((b) * 2 + (h)) * HTB)
#define PG8_SB(b, h) ((4 + (b) * 2 + (h)) * HTB)
#define PG8_STAGE(bufoff, gbase, voff) do { _Pragma("unroll") for (int _i = 0; _i < 2; ++_i) \
        __builtin_amdgcn_global_load_lds((const unsigned*)((const char*)(gbase) + (voff)[_i]), (PG8_LAS unsigned*)(lds + (bufoff) + ldsw + _i * 8192), 16, 0, 0); } while (0)
#define PG8_LDA(dst, b, h) do { _Pragma("unroll") for (int m = 0; m < 4; ++m) _Pragma("unroll") for (int k = 0; k < 2; ++k) dst[m][k] = *(const PG8_LAS bf16x8*)(lds + PG8_SA(b, h) + aoff + m * 2048 + k * 1024); } while (0)
#define PG8_LDB(dst, b, h) do { _Pragma("unroll") for (int n = 0; n < 2; ++n) _Pragma("unroll") for (int k = 0; k < 2; ++k) dst[n][k] = *(const PG8_LAS bf16x8*)(lds + PG8_SB(b, h) + boff + n * 2048 + k * 1024); } while (0)
#define PG8_MMA(ai, bj, At, Bt) do { __builtin_amdgcn_s_setprio(1); _Pragma("unroll") for (int m = 0; m < 4; ++m) _Pragma("unroll") for (int n = 0; n < 2; ++n) _Pragma("unroll") for (int k = 0; k < 2; ++k) \
        acc[ai][bj][m][n] = __builtin_amdgcn_mfma_f32_16x16x32_bf16(Bt[n][k], At[m][k], acc[ai][bj][m][n], 0, 0, 0); __builtin_amdgcn_s_setprio(0); } while (0)
#define PG8_WAIT_V(n) asm volatile("s_waitcnt vmcnt(" #n ")" ::: "memory")
#define PG8_WAIT_L(n) asm volatile("s_waitcnt lgkmcnt(" #n ")" ::: "memory")
#define PG8_BAR __builtin_amdgcn_s_barrier()
#define PG8_SCHED __builtin_amdgcn_sched_barrier(0)
    Unit cur, nxt; int ui = 0;
    if (!S.next(0, cur)) return;
    f32x4 acc[2][2][4][2];
#pragma unroll
    for (int a = 0; a < 2; ++a)
#pragma unroll
        for (int b = 0; b < 2; ++b)
#pragma unroll
            for (int m = 0; m < 4; ++m)
#pragma unroll
                for (int n = 0; n < 2; ++n) acc[a][b][m][n] = (f32x4){0.f, 0.f, 0.f, 0.f};
    bf16x8 At[4][2], B0[2][2], B1[2][2];
    const char* cA = (const char*)g.A + (size_t)cur.pm * tstep; const char* cB = (const char*)g.Bt + (size_t)cur.pn * tstep;
    S.a_ready(cur);
    if constexpr (SP2) {
        PG8_STAGE(PG8_SB(0, 0), cB, voffB); PG8_STAGE(PG8_SB(0, 1), cB + hstep, voffB); PG8_STAGE(PG8_SA(0, 0), cA, voffA); PG8_STAGE(PG8_SA(0, 1), cA + hstep, voffA);
        if (wr == 1) PG8_BAR;
        PG8_WAIT_V(2); PG8_BAR;
        PG8_STAGE(PG8_SB(1, 0), cB + kstep, voffB); PG8_STAGE(PG8_SA(1, 0), cA + kstep, voffA); PG8_STAGE(PG8_SB(1, 1), cB + hstep + kstep, voffB);
        PG8_WAIT_V(6); PG8_BAR;
    } else {
        PG8_STAGE(PG8_SB(0, 0), cB, voffB); PG8_STAGE(PG8_SA(0, 0), cA, voffA); PG8_STAGE(PG8_SB(0, 1), cB + hstep, voffB); PG8_STAGE(PG8_SA(0, 1), cA + hstep, voffA);
        if (wr == 1) PG8_BAR;
        PG8_WAIT_V(4); PG8_BAR;
        PG8_STAGE(PG8_SB(1, 0), cB + kstep, voffB); PG8_STAGE(PG8_SA(1, 0), cA + kstep, voffA); PG8_STAGE(PG8_SB(1, 1), cB + hstep + kstep, voffB);
        PG8_WAIT_V(6); PG8_BAR;
    }
    for (;;) {
        const bool has_next = S.next(ui + 1, nxt);
        const char* nA = has_next ? (const char*)g.A + (size_t)nxt.pm * tstep : cA; const char* nB = has_next ? (const char*)g.Bt + (size_t)nxt.pn * tstep : cB;
        for (int t = 0; t < nt; t += 2) {
            const bool last = (t == nt - 2);
            const char* a1 = cA + (size_t)(t + 1) * kstep;
            const char* a2 = last ? nA : cA + (size_t)(t + 2) * kstep; const char* b2 = last ? nB : cB + (size_t)(t + 2) * kstep;
            const char* a3 = a2 + kstep; const char* b3 = b2 + kstep;
            if (last && has_next) S.a_ready(nxt);
            if constexpr (SP2) {
            PG8_LDB(B0, 0, 0); PG8_LDB(B1, 0, 1); PG8_SCHED; PG8_LDA(At, 0, 0); PG8_STAGE(PG8_SA(1, 1), a1 + hstep, voffA);
            PG8_WAIT_V(8); PG8_WAIT_L(0); PG8_BAR; PG8_MMA(0, 0, At, B0); PG8_MMA(0, 1, At, B1); PG8_BAR; PG8_SCHED;
            PG8_LDA(At, 0, 1); PG8_STAGE(PG8_SB(0, 0), b2, voffB); PG8_STAGE(PG8_SB(0, 1), b2 + hstep, voffB); PG8_STAGE(PG8_SA(0, 0), a2, voffA);
            PG8_WAIT_V(8); PG8_WAIT_L(0); PG8_BAR; PG8_MMA(1, 0, At, B0); PG8_MMA(1, 1, At, B1); PG8_BAR; PG8_SCHED;
            PG8_LDB(B0, 1, 0); PG8_LDB(B1, 1, 1); PG8_SCHED; PG8_LDA(At, 1, 0); PG8_STAGE(PG8_SA(0, 1), a2 + hstep, voffA);
            PG8_WAIT_V(8); PG8_WAIT_L(0); PG8_BAR; PG8_MMA(0, 0, At, B0); PG8_MMA(0, 1, At, B1); PG8_BAR; PG8_SCHED;
            PG8_LDA(At, 1, 1); PG8_STAGE(PG8_SB(1, 0), b3, voffB); PG8_STAGE(PG8_SB(1, 1), b3 + hstep, voffB); PG8_STAGE(PG8_SA(1, 0), a3, voffA);
            PG8_WAIT_V(8); PG8_WAIT_L(0); PG8_BAR; PG8_MMA(1, 0, At, B0); PG8_MMA(1, 1, At, B1); PG8_BAR; PG8_SCHED;
            } else {
            PG8_LDB(B0, 0, 0); PG8_SCHED; PG8_LDA(At, 0, 0); PG8_STAGE(PG8_SA(1, 1), a1 + hstep, voffA);
            PG8_WAIT_L(8); PG8_BAR; PG8_WAIT_L(0); PG8_MMA(0, 0, At, B0); PG8_BAR; PG8_SCHED;
            PG8_LDB(B1, 0, 1); PG8_STAGE(PG8_SB(0, 0), b2, voffB);
            PG8_BAR; PG8_WAIT_L(0); PG8_MMA(0, 1, At, B1); PG8_BAR;
            PG8_LDA(At, 0, 1); PG8_STAGE(PG8_SA(0, 0), a2, voffA);
            PG8_BAR; PG8_WAIT_L(0); PG8_MMA(1, 0, At, B0); PG8_BAR; PG8_SCHED;
            PG8_STAGE(PG8_SB(0, 1), b2 + hstep, voffB);
            PG8_WAIT_V(6); PG8_BAR; PG8_MMA(1, 1, At, B1); PG8_BAR;
            PG8_LDB(B0, 1, 0); PG8_SCHED; PG8_LDA(At, 1, 0); PG8_STAGE(PG8_SA(0, 1), a2 + hstep, voffA);
            PG8_WAIT_L(8); PG8_BAR; PG8_WAIT_L(0); PG8_MMA(0, 0, At, B0); PG8_BAR; PG8_SCHED;
            PG8_LDB(B1, 1, 1); PG8_STAGE(PG8_SB(1, 0), b3, voffB);
            PG8_BAR; PG8_WAIT_L(0); PG8_MMA(0, 1, At, B1); PG8_BAR;
            PG8_LDA(At, 1, 1); PG8_STAGE(PG8_SA(1, 0), a3, voffA);
            PG8_BAR; PG8_WAIT_L(0); PG8_MMA(1, 0, At, B0); PG8_BAR; PG8_SCHED;
            PG8_STAGE(PG8_SB(1, 1), b3 + hstep, voffB);
            PG8_WAIT_V(6); PG8_BAR; PG8_MMA(1, 1, At, B1); PG8_BAR;
            }
        }
        if constexpr (ALIGN_EPI) { if (wr == 0) PG8_BAR; }
        if constexpr (!Epi::AFTER_DRAIN) { E(acc, cur, wr, wc, fr, fq); S.done(cur); }
        if (!has_next) break;
#pragma unroll
        for (int a = 0; a < 2; ++a)
#pragma unroll
            for (int b = 0; b < 2; ++b)
#pragma unroll
                for (int m = 0; m < 4; ++m)
#pragma unroll
                    for (int n = 0; n < 2; ++n) acc[a][b][m][n] = (f32x4){0.f, 0.f, 0.f, 0.f};
        cur = nxt; cA = nA; cB = nB; ++ui;
        if constexpr (ALIGN_EPI) { if (wr == 1) PG8_BAR; }
    }
    PG8_WAIT_V(0);
    if constexpr (!ALIGN_EPI) { if (wr == 0) PG8_BAR; }
    PG8_BAR;
    if constexpr (Epi::AFTER_DRAIN) { E.fused(acc, cur, wr, wc, fr, fq, lds, wid, lane); S.done(cur); }
#undef PG8_SA
#undef PG8_SB
#undef PG8_STAGE
#undef PG8_LDA
#undef PG8_LDB
#undef PG8_MMA
#undef PG8_WAIT_V
#undef PG8_WAIT_L
#undef PG8_BAR
#undef PG8_SCHED
}
}

#ifndef PG8_SP2
#define PG8_SP2 true
#endif
#ifndef MK_PER_PHASE
#define MK_PER_PHASE 0
#endif

namespace mk {
using pg8::bf16x8; using pg8::f32x4; using pg8::u32x4; using pg8::Unit; using pg8::Gemm; using pg8::StaticOrder;
typedef unsigned short bf16;
typedef float f32x16 __attribute__((ext_vector_type(16)));
typedef unsigned u32x2 __attribute__((ext_vector_type(2)));
typedef float f32x2_t __attribute__((ext_vector_type(2)));
typedef __bf16 bf16x2_t __attribute__((ext_vector_type(2)));
#define LAS __attribute__((address_space(3)))
#define LDS_WAIT() asm volatile("s_waitcnt lgkmcnt(0)" ::: "memory")

#define XB_TMO      128
#define XB_XCNT(j)  (256  + 64 * (j))
#define XB_XSUB(j)  (1280 + 64 * (j))
#define XB_XGEN(j)  (2304 + 64 * (j))
#define XB_TOP      3328
#define XB_TOPGEN   3392
#define XCD_BAR_WORDS 3456
#define XB_SPIN_CAP (1u << 18)

__device__ __forceinline__ unsigned xb_ld(unsigned* p)              { return __hip_atomic_load(p, __ATOMIC_RELAXED, __HIP_MEMORY_SCOPE_AGENT); }
__device__ __forceinline__ unsigned xb_add(unsigned* p, unsigned v) { return __hip_atomic_fetch_add(p, v, __ATOMIC_RELAXED, __HIP_MEMORY_SCOPE_AGENT); }
__device__ __forceinline__ unsigned xb_xcc_id() { return (unsigned)__builtin_amdgcn_s_getreg((3 << 11) | 20) & 0xFu; }
#define XB_SPIN(cond, bar) do { unsigned _sp = 0; while (cond) { __builtin_amdgcn_s_sleep(1); \
    if ((++_sp & 255u) == 0u) { if (xb_ld(&(bar)[XB_TMO])) break; if (_sp > XB_SPIN_CAP) { atomicAdd(&(bar)[XB_TMO], 1u); break; } } } } while (0)

struct XcdBarrier {
    unsigned* bar; unsigned x;
    volatile LAS unsigned* st;
};

__device__ __forceinline__ XcdBarrier xcd_barrier_post(unsigned* bar, volatile LAS unsigned* st, const int tid) {
    XcdBarrier b; b.bar = bar; b.x = xb_xcc_id(); b.st = st;
    if (tid == 0) (void)xb_add(&bar[XB_XCNT(b.x)], 1u);
    return b;
}
__device__ __forceinline__ void xcd_barrier_complete(unsigned* bar, unsigned x, unsigned& nloc, unsigned& nx) {
    const unsigned G = gridDim.x * gridDim.y * gridDim.z;
    unsigned sum, cnt, mine, sp = 0u;
    for (;;) {
        sum = 0u; cnt = 0u; mine = 0u;
#pragma unroll
        for (unsigned j = 0; j < 16; ++j) { const unsigned c = xb_ld(&bar[XB_XCNT(j)]); sum += c; cnt += (c > 0u) ? 1u : 0u; mine = (j == x) ? c : mine; }
        if (sum == G) break;
        __builtin_amdgcn_s_sleep(1);
        if ((++sp & 255u) == 0u) { if (xb_ld(&bar[XB_TMO])) break; if (sp > XB_SPIN_CAP) { atomicAdd(&bar[XB_TMO], 1u); break; } }
    }
    nloc = mine > 0u ? mine : 1u; nx = cnt > 0u ? cnt : 1u;
}

__device__ __forceinline__ void xcd_barrier(const XcdBarrier& b, const int tid) {
    asm volatile("s_waitcnt vmcnt(0)" ::: "memory");
    __syncthreads();
    if (tid == 0) {
        unsigned* bar = b.bar;
        __builtin_amdgcn_s_waitcnt(0);
        unsigned nloc = b.st[0], nx = b.st[1];
        if (nloc == 0u) { xcd_barrier_complete(bar, b.x, nloc, nx); b.st[0] = nloc; b.st[1] = nx; }
        const unsigned old = xb_add(&bar[XB_XSUB(b.x)], 1u);
        const unsigned gen = old / nloc;
        if (old + 1u == (gen + 1u) * nloc) {
            __builtin_amdgcn_fence(__ATOMIC_RELEASE, "agent");
            asm volatile("s_waitcnt vmcnt(0)" ::: "memory");
            const unsigned og = xb_add(&bar[XB_TOP], 1u);
            const unsigned tg = og / nx;
            if (og + 1u == (tg + 1u) * nx) xb_add(&bar[XB_TOPGEN], 1u);
            else XB_SPIN(xb_ld(&bar[XB_TOPGEN]) == tg, bar);
            __builtin_amdgcn_fence(__ATOMIC_ACQUIRE, "agent");
            xb_add(&bar[XB_XGEN(b.x)], 1u);
            asm volatile("s_waitcnt vmcnt(0)" ::: "memory");
        } else {
            XB_SPIN(xb_ld(&bar[XB_XGEN(b.x)]) == gen, bar);
            __builtin_amdgcn_fence(__ATOMIC_ACQUIRE, "agent");
            asm volatile("s_waitcnt vmcnt(0)" ::: "memory");
        }
    }
    __syncthreads();
}

constexpr int NB = 4, SEQ = 8192, DM = 1024, MTOK = NB * SEQ, DFF = 2816;
constexpr float EPS = 1e-6f, NEGF = -1e30f;
constexpr int NPHASE = 15;
constexpr int NWAVES = 8;
constexpr size_t MiB = 1u << 20;
constexpr size_t SZ_WGU = (size_t)5632 * 1024 * 2, SZ_WD = (size_t)1024 * 2816 * 2, SZ_WIN = (size_t)3840 * 1024 * 2;
constexpr size_t O_WGU1 = 0, O_WD1 = O_WGU1 + SZ_WGU, O_WGU2 = O_WD1 + SZ_WD, O_WD2 = O_WGU2 + SZ_WGU, O_WIN = O_WD2 + SZ_WD,
                 O_WPN = O_WIN + SZ_WIN, O_WPM = O_WPN + MiB, O_WOUT = O_WPM + MiB, O_WUQ = O_WOUT + 2 * MiB, O_WUKV = O_WUQ + 768 * 256 * 2,
                 O_CW1K = O_WUKV + 1024 * 128 * 2, O_CW1V = O_CW1K + MiB, O_WEND = O_CW1V + MiB;
static_assert(O_WEND <= 48 * MiB - 16384, "weights");
constexpr size_t O_CTL = 48 * MiB - 16384;
constexpr size_t O_A1 = 48 * MiB;
constexpr size_t O_IM2K = 48 * MiB, O_IM2V = 64 * MiB, O_CQN = 80 * MiB, O_CKVN = 96 * MiB, O_KR = 104 * MiB, O_HK = 106 * MiB, O_HV = 108 * MiB,
                 O_KC = 110 * MiB, O_VCT = 110 * MiB + 512 * 1024;
constexpr size_t O_MG = 48 * MiB;
constexpr size_t O_H = 112 * MiB;
constexpr size_t O_Z1 = 112 * MiB, O_QN = 192 * MiB, O_YM = 224 * MiB, O_KM = 256 * MiB;
constexpr size_t O_F = 288 * MiB, O_GM = 288 * MiB;
constexpr size_t O_QM = 416 * MiB, O_VTM = 464 * MiB, O_VTS = 496 * MiB, O_VTW = 504 * MiB, O_END = 512 * MiB;
constexpr int Z1P = 1280;
constexpr int LDS_BYTES = 147456;
constexpr int L_KB = 0, KB_SZ = 13312, L_VB = 2 * KB_SZ, VB_SZ = 8704, L_IMP = L_VB + 2 * VB_SZ, IMP_P = 132, L_SELM = L_IMP + 64 * IMP_P * 4, L_WUN = L_SELM + 1024, L_ATT_END = L_WUN + 128;
static_assert(L_ATT_END <= 131072, "attention LDS");

__device__ __forceinline__ int mk_lane() { int l; asm volatile("v_mbcnt_lo_u32_b32 %0, -1, 0\n\tv_mbcnt_hi_u32_b32 %0, -1, %0" : "=v"(l)); return l; }
__device__ __forceinline__ void grid_barrier(unsigned* ctr, unsigned target, int tid) {
    asm volatile("s_waitcnt vmcnt(0)" ::: "memory");
    __syncthreads();
    if (tid == 0) {
        __builtin_amdgcn_fence(__ATOMIC_RELEASE, "agent");
        asm volatile("s_waitcnt vmcnt(0)" ::: "memory");
        __hip_atomic_fetch_add(ctr, 1u, __ATOMIC_RELAXED, __HIP_MEMORY_SCOPE_AGENT);
        while (__hip_atomic_load(ctr, __ATOMIC_RELAXED, __HIP_MEMORY_SCOPE_AGENT) < target) __builtin_amdgcn_s_sleep(2);
        __builtin_amdgcn_fence(__ATOMIC_ACQUIRE, "agent");
        asm volatile("s_waitcnt vmcnt(0)" ::: "memory");
    }
    __syncthreads();
}
__device__ __forceinline__ unsigned cvtpk(float lo, float hi) { f32x2_t v = {lo, hi}; bf16x2_t b = __builtin_convertvector(v, bf16x2_t); return __builtin_bit_cast(unsigned, b); }
__device__ __forceinline__ float bflo(unsigned w) { return __builtin_bit_cast(float, w << 16); }
__device__ __forceinline__ float bfhi(unsigned w) { return __builtin_bit_cast(float, w & 0xffff0000u); }
__device__ __forceinline__ float bf2f(bf16 b) { return __builtin_bit_cast(float, (unsigned)b << 16); }
__device__ __forceinline__ bf16 f2bf(float f) { return (bf16)(cvtpk(f, 0.f) & 0xffffu); }
__device__ __forceinline__ float wave_sum(float v) {
#pragma unroll
    for (int o = 1; o < 64; o <<= 1) v += __shfl_xor(v, o);
    return v;
}
__device__ __forceinline__ float sigmoidf(float x) { return 1.f / (1.f + __expf(-x)); }
__device__ __forceinline__ float gelu_tanh(float x) { const float u = 0.7978845608028654f * (x + 0.044715f * x * x * x); const float t = 1.f - 2.f / (__expf(2.f * u) + 1.f); return 0.5f * x * (1.f + t); }
__device__ __forceinline__ void rope_cs(int pos, int j, float& c, float& s) {
    const float freq = __builtin_amdgcn_exp2f(-(float)j * 0.8304820237218406f);
    const float ang = (float)pos * freq;
    double rev = (double)ang * 0.15915494309189535; rev -= __builtin_rint(rev);
    const float fr = (float)rev;
    s = __builtin_amdgcn_sinf(fr); c = __builtin_amdgcn_cosf(fr);
}

struct MapPlain { __device__ __forceinline__ int col(int r) const { return r; } __device__ __forceinline__ int drow(int r) const { return r; } };
struct MapGU { int sel; __device__ __forceinline__ int col(int r) const { return r; } __device__ __forceinline__ int drow(int r) const { return (r >> 7) * 256 + sel * 128 + (r & 127); } };
struct MapWin { __device__ __forceinline__ int drow(int r) const { return r; } __device__ __forceinline__ int col(int r) const {
    int col;
    if (r < 1280) col = r; else if (r < 1536) col = 1304 + (r - 1280); else if (r < 1664) col = 1560 + (r - 1536); else if (r < 1696) col = 1688 + (r - 1664);
    else if (r < 1720) col = 1280 + (r - 1696); else if (r < 1792) col = -1; else col = 1720 + (r - 1792);
    return col; } };
struct MapUkv { __device__ __forceinline__ int drow(int r) const { return r; } __device__ __forceinline__ int col(int r) const {
    if (r < 512) return (r >> 6) * 128 + (r & 63); const int rr = r - 512; return (rr >> 6) * 128 + 64 + (rr & 63); } };
template <class Map> __device__ __forceinline__ void transpose_mat(const float* W, int N, const Map mp, int K, int Nvirt, bf16* WT, LAS float* scr, int gw, int NGW, int lane) {
    const int nblk = Nvirt / 32, nitems = (K / 64) * nblk;
    for (int it = gw; it < nitems; it += NGW) {
        const int kb = it / nblk, nb = it % nblk, k0 = 64 * kb, n0 = 32 * nb;
        const int col = mp.col(n0 + (lane & 31));
#pragma unroll 8
        for (int i = 0; i < 32; ++i) { const int kk = 2 * i + (lane >> 5); scr[kk * 33 + (lane & 31)] = (col >= 0) ? W[(size_t)(k0 + kk) * N + col] : 0.f; }
        LDS_WAIT();
        const int c = lane & 7;
#pragma unroll
        for (int j = 0; j < 4; ++j) { const int n = (lane >> 3) + 8 * j; const LAS float* s = scr + (8 * c) * 33 + n;
            u32x4 o; o.x = cvtpk(s[0 * 33], s[1 * 33]); o.y = cvtpk(s[2 * 33], s[3 * 33]); o.z = cvtpk(s[4 * 33], s[5 * 33]); o.w = cvtpk(s[6 * 33], s[7 * 33]);
            *(u32x4*)(WT + (size_t)mp.drow(n0 + n) * K + k0 + 8 * c) = o; }
        LDS_WAIT();
    }
}

__device__ __forceinline__ void rms_row_to_bf16(const f32x4 (&v)[4], const float* gain, bf16* orow, int lane) {
    float ss = 0.f;
#pragma unroll
    for (int j = 0; j < 4; ++j) ss += (v[j].x * v[j].x + v[j].y * v[j].y) + (v[j].z * v[j].z + v[j].w * v[j].w);
    const float r = rsqrtf(wave_sum(ss) * (1.f / DM) + EPS);
#pragma unroll
    for (int j = 0; j < 4; ++j) { const f32x4 g = *(const f32x4*)(gain + 4 * (lane + 64 * j)); const f32x4 o = v[j] * r * g;
        u32x2 w; w.x = cvtpk(o.x, o.y); w.y = cvtpk(o.z, o.w); *(u32x2*)(orow + 4 * (lane + 64 * j)) = w; }
}
template <bool NEXT> __device__ __forceinline__ void rowop(const bf16* Fb, const float* base, float coef, const float* gpost, float* xout, const float* gnext, bf16* A1, int gw, int NGW, int lane) {
    for (int m = gw; m < MTOK; m += NGW) {
        const u32x2* fr = (const u32x2*)(Fb + (size_t)m * DM) + lane; const f32x4* br = (const f32x4*)(base + (size_t)m * DM) + lane;
        f32x4 v[4], bs[4]; float ss = 0.f;
#pragma unroll
        for (int j = 0; j < 4; ++j) { const u32x2 w = fr[64 * j]; v[j].x = bflo(w.x); v[j].y = bfhi(w.x); v[j].z = bflo(w.y); v[j].w = bfhi(w.y); bs[j] = br[64 * j]; ss += (v[j].x * v[j].x + v[j].y * v[j].y) + (v[j].z * v[j].z + v[j].w * v[j].w); }
        const float r = rsqrtf(wave_sum(ss) * (1.f / DM) + EPS) * coef;
#pragma unroll
        for (int j = 0; j < 4; ++j) { const f32x4 g = *(const f32x4*)(gpost + 4 * (lane + 64 * j)); v[j] = bs[j] + v[j] * r * g; *((f32x4*)(xout + (size_t)m * DM) + lane + 64 * j) = v[j]; }
        if (NEXT) rms_row_to_bf16(v, gnext, A1 + (size_t)m * DM, lane);
    }
}

#define EPI_ROW(ai, m) ((size_t)u.pm * 256 + (ai) * 128 + wr * 64 + (m) * 16 + fr)
#define EPI_CIN(bj, n) ((bj) * 128 + wc * 32 + (n) * 16 + fq * 4)
struct EpiSwiglu { static constexpr bool PERM = false, AFTER_DRAIN = false; bf16* H;
    __device__ __forceinline__ void operator()(const f32x4 (&acc)[2][2][4][2], const Unit& u, int wr, int wc, int fr, int fq) const {
#pragma unroll
        for (int ai = 0; ai < 2; ++ai)
#pragma unroll
            for (int m = 0; m < 4; ++m) { bf16* rp = H + EPI_ROW(ai, m) * DFF + u.pn * 128 + wc * 32 + fq * 4;
#pragma unroll
                for (int n = 0; n < 2; ++n) { const f32x4 g = acc[ai][0][m][n], up = acc[ai][1][m][n]; float v[4];
#pragma unroll
                    for (int e = 0; e < 4; ++e) v[e] = g[e] / (1.f + __expf(-g[e])) * up[e];
                    u32x2 w; w.x = cvtpk(v[0], v[1]); w.y = cvtpk(v[2], v[3]); *(u32x2*)(rp + n * 16) = w; } }
    }
};
struct EpiF32 { static constexpr bool PERM = false, AFTER_DRAIN = false; bf16* Fb; int ldc;
    __device__ __forceinline__ void operator()(const f32x4 (&acc)[2][2][4][2], const Unit& u, int wr, int wc, int fr, int fq) const {
#pragma unroll
        for (int ai = 0; ai < 2; ++ai)
#pragma unroll
            for (int m = 0; m < 4; ++m) { bf16* rp = Fb + EPI_ROW(ai, m) * ldc + u.pn * 256;
#pragma unroll
                for (int bj = 0; bj < 2; ++bj)
#pragma unroll
                    for (int n = 0; n < 2; ++n) { const f32x4 v = acc[ai][bj][m][n]; u32x2 w; w.x = cvtpk(v[0], v[1]); w.y = cvtpk(v[2], v[3]); *(u32x2*)(rp + EPI_CIN(bj, n)) = w; } }
    }
};
struct EpiWin { static constexpr bool PERM = false, AFTER_DRAIN = false; bf16* QN; bf16* Z1; bf16* GM; bf16* VTS; bf16* VTW;
    __device__ __forceinline__ void operator()(const f32x4 (&acc)[2][2][4][2], const Unit& u, int wr, int wc, int fr, int fq) const {
        const int pn = u.pn;
#pragma unroll
        for (int ai = 0; ai < 2; ++ai)
#pragma unroll
            for (int m = 0; m < 4; ++m) { const size_t row = EPI_ROW(ai, m);
#pragma unroll
                for (int bj = 0; bj < 2; ++bj)
#pragma unroll
                    for (int n = 0; n < 2; ++n) { const int cin = EPI_CIN(bj, n); f32x4 v = acc[ai][bj][m][n];
                        if ((pn == 3 || pn == 4) && bj == 1) {
                            bf16* vt = (pn == 3) ? VTS : VTW; const int b = (int)(row >> 13), s = (int)(row & 8191), cv = cin - 128;
#pragma unroll
                            for (int e = 0; e < 4; ++e) vt[((size_t)(b * 128 + cv + e)) * SEQ + s] = f2bf(v[e]);
                        } else {
                            bf16* dst;
                            if (pn < 2) { dst = QN + row * 512 + pn * 256 + cin; v = v * 0.18033688011112042f; }
                            else if (pn < 7) dst = Z1 + row * Z1P + (pn - 2) * 256 + cin;
                            else dst = GM + row * 2048 + (pn - 7) * 256 + cin;
                            u32x2 w; w.x = cvtpk(v[0], v[1]); w.y = cvtpk(v[2], v[3]); *(u32x2*)dst = w;
                        } } }
    }
};
struct EpiGelu { static constexpr bool PERM = false, AFTER_DRAIN = false; bf16* O; int ldc;
    __device__ __forceinline__ void operator()(const f32x4 (&acc)[2][2][4][2], const Unit& u, int wr, int wc, int fr, int fq) const {
#pragma unroll
        for (int ai = 0; ai < 2; ++ai)
#pragma unroll
            for (int m = 0; m < 4; ++m) { bf16* rp = O + EPI_ROW(ai, m) * ldc + u.pn * 256;
#pragma unroll
                for (int bj = 0; bj < 2; ++bj)
#pragma unroll
                    for (int n = 0; n < 2; ++n) { const f32x4 v = acc[ai][bj][m][n];
                        u32x2 w; w.x = cvtpk(gelu_tanh(v[0]), gelu_tanh(v[1])); w.y = cvtpk(gelu_tanh(v[2]), gelu_tanh(v[3])); *(u32x2*)(rp + EPI_CIN(bj, n)) = w; } }
    }
};
struct EpiQup { static constexpr bool PERM = false, AFTER_DRAIN = false; bf16* QM;
    __device__ __forceinline__ void operator()(const f32x4 (&acc)[2][2][4][2], const Unit& u, int wr, int wc, int fr, int fq) const {
        const float sc = 0.14724445614104196f;
#pragma unroll
        for (int ai = 0; ai < 2; ++ai)
#pragma unroll
            for (int m = 0; m < 4; ++m) { bf16* rp = QM + EPI_ROW(ai, m) * 768 + u.pn * 256;
#pragma unroll
                for (int bj = 0; bj < 2; ++bj)
#pragma unroll
                    for (int n = 0; n < 2; ++n) { const f32x4 v = acc[ai][bj][m][n] * sc;
                        u32x2 w; w.x = cvtpk(v[0], v[1]); w.y = cvtpk(v[2], v[3]); *(u32x2*)(rp + EPI_CIN(bj, n)) = w; } }
    }
};
struct EpiKVup { static constexpr bool PERM = false, AFTER_DRAIN = false; bf16* KM; bf16* VTM;
    __device__ __forceinline__ void operator()(const f32x4 (&acc)[2][2][4][2], const Unit& u, int wr, int wc, int fr, int fq) const {
        const int pn = u.pn;
#pragma unroll
        for (int ai = 0; ai < 2; ++ai)
#pragma unroll
            for (int m = 0; m < 4; ++m) { const size_t row = EPI_ROW(ai, m);
#pragma unroll
                for (int bj = 0; bj < 2; ++bj)
#pragma unroll
                    for (int n = 0; n < 2; ++n) { const int cin = EPI_CIN(bj, n); const f32x4 v = acc[ai][bj][m][n];
                        if (pn < 2) { u32x2 w; w.x = cvtpk(v[0], v[1]); w.y = cvtpk(v[2], v[3]); *(u32x2*)(KM + row * 512 + pn * 256 + cin) = w; }
                        else { const int b = (int)(row >> 13), s = (int)(row & 8191), cv = (pn - 2) * 256 + cin;
#pragma unroll
                            for (int e = 0; e < 4; ++e) VTM[((size_t)(b * 512 + cv + e)) * SEQ + s] = f2bf(v[e]); } } }
    }
};
template <bool SECOND> struct EpiProj { static constexpr bool PERM = false, AFTER_DRAIN = false; const bf16* GM; bf16* MG;
    __device__ __forceinline__ void operator()(const f32x4 (&acc)[2][2][4][2], const Unit& u, int wr, int wc, int fr, int fq) const {
#pragma unroll
        for (int ai = 0; ai < 2; ++ai)
#pragma unroll
            for (int m = 0; m < 4; ++m) { const size_t row = EPI_ROW(ai, m);
#pragma unroll
                for (int bj = 0; bj < 2; ++bj)
#pragma unroll
                    for (int n = 0; n < 2; ++n) { const int col = u.pn * 256 + EPI_CIN(bj, n); const f32x4 v = acc[ai][bj][m][n];
                        const u32x2 gw = *(const u32x2*)(GM + row * 2048 + (SECOND ? 1024 : 0) + col);
                        float o0 = sigmoidf(bflo(gw.x)) * v[0], o1 = sigmoidf(bfhi(gw.x)) * v[1], o2 = sigmoidf(bflo(gw.y)) * v[2], o3 = sigmoidf(bfhi(gw.y)) * v[3];
                        bf16* dst = MG + row * DM + col;
                        if (SECOND) { const u32x2 pw = *(const u32x2*)dst; o0 += bflo(pw.x); o1 += bfhi(pw.x); o2 += bflo(pw.y); o3 += bfhi(pw.y); }
                        u32x2 w; w.x = cvtpk(o0, o1); w.y = cvtpk(o2, o3); *(u32x2*)dst = w; } }
    }
};

__device__ __forceinline__ int crow(int r, int hi) { return (r & 3) + 8 * (r >> 2) + 4 * hi; }
template <int ND0> __device__ __forceinline__ f32x16 qk_sub(const LAS char* Kt, int pitch, int sub, const bf16x8* qr, const f32x16& cin, int r32, int hi) {
    f32x16 acc = cin;
    const LAS char* kb = Kt + (sub * 32 + r32) * pitch + hi * 16;
#pragma unroll
    for (int d0 = 0; d0 < ND0; ++d0) { const bf16x8 kf = *(const LAS bf16x8*)(kb + d0 * 32); acc = __builtin_amdgcn_mfma_f32_32x32x16_bf16(kf, qr[d0], acc, 0, 0, 0); }
    return acc;
}
__device__ __forceinline__ void fill16(f32x16& a, float v) {
#pragma unroll
    for (int r = 0; r < 16; ++r) a[r] = v;
}
__device__ __forceinline__ void pv_sub(f32x16& o0, f32x16& o1, const LAS char* Vt, int sub, const f32x16& p, int r32, int hi) {
#pragma unroll
    for (int j = 0; j < 2; ++j) {
        u32x4 pw; pw.x = cvtpk(p[8 * j + 0], p[8 * j + 1]); pw.y = cvtpk(p[8 * j + 2], p[8 * j + 3]); pw.z = cvtpk(p[8 * j + 4], p[8 * j + 5]); pw.w = cvtpk(p[8 * j + 6], p[8 * j + 7]);
        const bf16x8 pb = __builtin_bit_cast(bf16x8, pw);
#pragma unroll
        for (int dblk = 0; dblk < 2; ++dblk) {
            const LAS char* vp = Vt + (32 * dblk + r32) * 136 + (32 * sub + 16 * j + 4 * hi) * 2;
            const u32x2 lo = *(const LAS u32x2*)vp, h2 = *(const LAS u32x2*)(vp + 16);
            u32x4 vw; vw.x = lo.x; vw.y = lo.y; vw.z = h2.x; vw.w = h2.y;
            const bf16x8 vf = __builtin_bit_cast(bf16x8, vw);
            if (dblk == 0) o0 = __builtin_amdgcn_mfma_f32_32x32x16_bf16(vf, pb, o0, 0, 0, 0); else o1 = __builtin_amdgcn_mfma_f32_32x32x16_bf16(vf, pb, o1, 0, 0, 0);
        }
    }
}
__device__ __forceinline__ bool sm_tile(f32x16& s0, f32x16& s1, float& mref, float& thr, float& l, f32x16& o0, f32x16& o1) {
    float mx = fmaxf(s0[0], s1[0]);
#pragma unroll
    for (int r = 1; r < 16; ++r) mx = fmaxf(mx, fmaxf(s0[r], s1[r]));
    mx = fmaxf(mx, __shfl_xor(mx, 32));
    bool ch = false;
    if (__any(mx > thr)) {
        const bool up = mx > thr; const float d = up ? mx : 0.f; const float alpha = (thr > 0.f) ? __builtin_amdgcn_exp2f(-d) : 1.f;
        mref += d; thr = up ? 8.f : thr; l *= alpha;
#pragma unroll
        for (int r = 0; r < 16; ++r) { o0[r] *= alpha; o1[r] *= alpha; s0[r] -= d; s1[r] -= d; }
        ch = true;
    }
    float sum = 0.f;
#pragma unroll
    for (int r = 0; r < 16; ++r) { s0[r] = __builtin_amdgcn_exp2f(s0[r]); s1[r] = __builtin_amdgcn_exp2f(s1[r]); sum += s0[r] + s1[r]; }
    l += sum;
    return ch;
}
__device__ __forceinline__ void zero16(f32x16& a) {
#pragma unroll
    for (int r = 0; r < 16; ++r) a[r] = 0.f;
}

__device__ __forceinline__ void mla_unit(int b, int h, int qb, const bf16* QM, const bf16* KM, const bf16* KR, const bf16* VTM, bf16* YM, LAS char* lds, const int wid, const int lane) {
    const int tid = wid * 64 + lane, r32 = lane & 31, hi = lane >> 5;
    const int q0 = qb * 256 + wid * 32, t = q0 + r32;
    const size_t rowq = (size_t)b * SEQ + t;
    bf16x8 qr[6];
#pragma unroll
    for (int d0 = 0; d0 < 6; ++d0) qr[d0] = *(const bf16x8*)(QM + rowq * 768 + h * 96 + d0 * 16 + hi * 8);
    {
        u32x4 a = __builtin_bit_cast(u32x4, qr[4]), bb = __builtin_bit_cast(u32x4, qr[5]);
        float x1[8] = {bflo(a.x), bfhi(a.x), bflo(a.y), bfhi(a.y), bflo(a.z), bfhi(a.z), bflo(a.w), bfhi(a.w)};
        float x2[8] = {bflo(bb.x), bfhi(bb.x), bflo(bb.y), bfhi(bb.y), bflo(bb.z), bfhi(bb.z), bflo(bb.w), bfhi(bb.w)};
#pragma unroll
        for (int e = 0; e < 8; ++e) { float cs, sn; rope_cs(t, 8 * hi + e, cs, sn); const float y1 = x1[e] * cs - x2[e] * sn, y2 = x1[e] * sn + x2[e] * cs; x1[e] = y1; x2[e] = y2; }
        a.x = cvtpk(x1[0], x1[1]); a.y = cvtpk(x1[2], x1[3]); a.z = cvtpk(x1[4], x1[5]); a.w = cvtpk(x1[6], x1[7]);
        bb.x = cvtpk(x2[0], x2[1]); bb.y = cvtpk(x2[2], x2[3]); bb.z = cvtpk(x2[4], x2[5]); bb.w = cvtpk(x2[6], x2[7]);
        qr[4] = __builtin_bit_cast(bf16x8, a); qr[5] = __builtin_bit_cast(bf16x8, bb);
    }
    float mref = 0.f, thr = -1e29f, l = 0.f; f32x16 o0, o1, cinit; zero16(o0); zero16(o1); zero16(cinit);
    const int NT = (qb + 1) * 4;
    const bf16* ksrc = KM + ((size_t)b * SEQ + (tid >> 3)) * 512 + h * 64 + (tid & 7) * 8;
    const bf16* rsrc = KR + ((size_t)b * SEQ + ((tid & 255) >> 2)) * 32 + (tid & 3) * 8;
    const bf16* vsrc = VTM + ((size_t)(b * 8 + h) * 64 + (tid >> 3)) * SEQ + (tid & 7) * 8;
    const int kdst = (tid >> 3) * 208 + (tid & 7) * 16, rdst = ((tid & 255) >> 2) * 208 + 128 + (tid & 3) * 16, vdst = (tid >> 3) * 136 + (tid & 7) * 16;
    u32x4 sk, sr, sv;
#define MLA_LOAD(it) do { sk = *(const u32x4*)(ksrc + (size_t)(it) * 64 * 512); if (tid < 256) sr = *(const u32x4*)(rsrc + (size_t)(it) * 64 * 32); sv = *(const u32x4*)(vsrc + (it) * 64); } while (0)
#define MLA_STORE(buf) do { *(LAS u32x4*)(lds + L_KB + (buf) * KB_SZ + kdst) = sk; if (tid < 256) *(LAS u32x4*)(lds + L_KB + (buf) * KB_SZ + rdst) = sr; \
        LAS char* vp_ = lds + L_VB + (buf) * VB_SZ + vdst; u32x2 a_; a_.x = sv.x; a_.y = sv.y; *(LAS u32x2*)vp_ = a_; a_.x = sv.z; a_.y = sv.w; *(LAS u32x2*)(vp_ + 8) = a_; } while (0)
    sr = (u32x4){0u, 0u, 0u, 0u};
    MLA_LOAD(0); MLA_STORE(0); __syncthreads();
    for (int it = 0; it < NT; ++it) {
        const bool more = it + 1 < NT;
        if (more) MLA_LOAD(it + 1);
        const int kv0 = it * 64;
        if (kv0 <= q0 + 31) {
            const LAS char* Kb = lds + L_KB + (it & 1) * KB_SZ; const LAS char* Vb = lds + L_VB + (it & 1) * VB_SZ;
            f32x16 s0 = qk_sub<6>(Kb, 208, 0, qr, cinit, r32, hi), s1 = qk_sub<6>(Kb, 208, 1, qr, cinit, r32, hi);
            if (kv0 + 63 > q0) {
#pragma unroll
                for (int r = 0; r < 16; ++r) { const int kp = kv0 + crow(r, hi); if (kp > t) s0[r] = NEGF; if (kp + 32 > t) s1[r] = NEGF; }
            }
            if (sm_tile(s0, s1, mref, thr, l, o0, o1)) fill16(cinit, -mref);
            pv_sub(o0, o1, Vb, 0, s0, r32, hi); pv_sub(o0, o1, Vb, 1, s1, r32, hi);
        }
        if (more) MLA_STORE((it + 1) & 1);
        __syncthreads();
    }
#undef MLA_LOAD
#undef MLA_STORE
    l += __shfl_xor(l, 32);
    const float inv = 1.f / l;
    bf16* orow = YM + rowq * 512 + h * 64 + 4 * hi;
#pragma unroll
    for (int a = 0; a < 4; ++a) {
        u32x2 w; w.x = cvtpk(o0[4 * a] * inv, o0[4 * a + 1] * inv); w.y = cvtpk(o0[4 * a + 2] * inv, o0[4 * a + 3] * inv); *(u32x2*)(orow + 8 * a) = w;
        w.x = cvtpk(o1[4 * a] * inv, o1[4 * a + 1] * inv); w.y = cvtpk(o1[4 * a + 2] * inv, o1[4 * a + 3] * inv); *(u32x2*)(orow + 32 + 8 * a) = w;
    }
}

__device__ __forceinline__ int next_set(unsigned long long u0, unsigned long long u1, int from) {
    if (from < 64) { const unsigned long long x = u0 >> from; if (x) return from + __builtin_ctzll(x); from = 64; }
    if (from < 128) { const unsigned long long x = u1 >> (from - 64); if (x) return from + __builtin_ctzll(x); }
    return 128;
}
__device__ __forceinline__ void nsa_unit(int b, int g, int tile, bf16* QN  , const bf16* Z1, const bf16* KC, const bf16* VCT, const bf16* VTS, const bf16* VTW, LAS char* lds, const int wid, const int lane) {
    const int tid = wid * 64 + lane, r32 = lane & 31, hi = lane >> 5;
    const int t0 = tile * 64, cur = tile, tl = r32 >> 2, hh = r32 & 3, head = 4 * g + hh, tok = 8 * wid + tl, t = t0 + tok, bg = b * 2 + g;
    const size_t rowq = (size_t)b * SEQ + t;
    bf16x8 qr[4];
#pragma unroll
    for (int d0 = 0; d0 < 4; ++d0) qr[d0] = *(const bf16x8*)(QN + rowq * 512 + head * 64 + d0 * 16 + hi * 8);
    const float slope = __builtin_amdgcn_exp2f(-(float)(head + 1)) * 1.4426950408889634f;
    f32x16 czero; zero16(czero);
    const bf16* gz = Z1 + rowq * Z1P + 1184 + head * 3;
    const float g0 = sigmoidf(bf2f(gz[0])), g1 = sigmoidf(bf2f(gz[1])), g2 = sigmoidf(bf2f(gz[2]));
    LAS float* imp = (LAS float*)(lds + L_IMP);
    LAS unsigned* selm = (LAS unsigned*)(lds + L_SELM);
    LAS unsigned* wun = (LAS unsigned*)(lds + L_WUN);
    for (int i = lane; i < 8 * IMP_P; i += 64) imp[8 * wid * IMP_P + i] = 0.f;
    f32x16 out0, out1; zero16(out0); zero16(out1);
    const int krow = tid >> 3, kch = tid & 7;
    const int kdst = krow * 144 + kch * 16, vdst = krow * 136 + kch * 16;
    u32x4 sk, sv;
#define NSA_STORE(buf, withv) do { *(LAS u32x4*)(lds + L_KB + (buf) * KB_SZ + kdst) = sk; if (withv) { LAS char* vp_ = lds + L_VB + (buf) * VB_SZ + vdst; u32x2 a_; a_.x = sv.x; a_.y = sv.y; *(LAS u32x2*)vp_ = a_; a_.x = sv.z; a_.y = sv.w; *(LAS u32x2*)(vp_ + 8) = a_; } } while (0)

    const int ncmp = t0 / 16 + 3, nct = (ncmp + 63) / 64;
    const bf16* kcsrc = KC + ((size_t)bg * 512 + krow) * 64 + kch * 8;
    const bf16* vcsrc = VCT + ((size_t)bg * 64 + krow) * 512 + kch * 8;
    float mc = NEGF, lc = 0.f;
    {
        sk = *(const u32x4*)kcsrc; NSA_STORE(0, false); __syncthreads();
        for (int it = 0; it < nct; ++it) {
            const bool more = it + 1 < nct;
            if (more) sk = *(const u32x4*)(kcsrc + (size_t)(it + 1) * 64 * 64);
            const LAS char* Kb = lds + L_KB + (it & 1) * KB_SZ;
            f32x16 s0 = qk_sub<4>(Kb, 144, 0, qr, czero, r32, hi), s1 = qk_sub<4>(Kb, 144, 1, qr, czero, r32, hi);
            float mx = NEGF;
#pragma unroll
            for (int r = 0; r < 16; ++r) { const int i0 = it * 64 + crow(r, hi); const int d0_ = t - (16 * i0 + 31), d1_ = d0_ - 512;
                s0[r] = d0_ >= 0 ? s0[r] - slope * (float)d0_ : NEGF; s1[r] = d1_ >= 0 ? s1[r] - slope * (float)d1_ : NEGF; mx = fmaxf(mx, fmaxf(s0[r], s1[r])); }
            mx = fmaxf(mx, __shfl_xor(mx, 32));
            const float mn = fmaxf(mc, mx), alpha = __builtin_amdgcn_exp2f(mc - mn); mc = mn;
            float sum = 0.f;
#pragma unroll
            for (int r = 0; r < 16; ++r) { sum += (s0[r] > -1e29f ? __builtin_amdgcn_exp2f(s0[r] - mn) : 0.f) + (s1[r] > -1e29f ? __builtin_amdgcn_exp2f(s1[r] - mn) : 0.f); }
            lc = lc * alpha + sum;
            if (more) NSA_STORE((it + 1) & 1, false);
            __syncthreads();
        }
        lc += __shfl_xor(lc, 32);
    }
    {
        const float invl = 1.f / fmaxf(lc, 1e-30f);
        f32x16 o0, o1; zero16(o0); zero16(o1);
        sk = *(const u32x4*)kcsrc; sv = *(const u32x4*)vcsrc; NSA_STORE(0, true); __syncthreads();
        for (int it = 0; it < nct; ++it) {
            const bool more = it + 1 < nct;
            if (more) { sk = *(const u32x4*)(kcsrc + (size_t)(it + 1) * 64 * 64); sv = *(const u32x4*)(vcsrc + (it + 1) * 64); }
            const LAS char* Kb = lds + L_KB + (it & 1) * KB_SZ; const LAS char* Vb = lds + L_VB + (it & 1) * VB_SZ;
            f32x16 s0 = qk_sub<4>(Kb, 144, 0, qr, czero, r32, hi), s1 = qk_sub<4>(Kb, 144, 1, qr, czero, r32, hi);
#pragma unroll
            for (int r = 0; r < 16; ++r) { const int i0 = it * 64 + crow(r, hi); const int d0_ = t - (16 * i0 + 31), d1_ = d0_ - 512;
                s0[r] = d0_ >= 0 ? __builtin_amdgcn_exp2f(s0[r] - slope * (float)d0_ - mc) * invl : 0.f; s1[r] = d1_ >= 0 ? __builtin_amdgcn_exp2f(s1[r] - slope * (float)d1_ - mc) * invl : 0.f; }
            pv_sub(o0, o1, Vb, 0, s0, r32, hi); pv_sub(o0, o1, Vb, 1, s1, r32, hi);
#pragma unroll
            for (int sub = 0; sub < 2; ++sub) {
                f32x16 ps = sub ? s1 : s0;
#pragma unroll
                for (int r = 0; r < 16; ++r) { ps[r] += __shfl_xor(ps[r], 1); ps[r] += __shfl_xor(ps[r], 2); }
                LAS float* row = imp + tok * IMP_P + (it * 64 + sub * 32) / 4 + hi;
                if (hh == 0) {
#pragma unroll
                    for (int a = 0; a < 4; ++a) row[2 * a] += (ps[4 * a] + ps[4 * a + 1]) + (ps[4 * a + 2] + 0.5f * ps[4 * a + 3]);
                }
                LDS_WAIT();
                if (hh == 0) {
#pragma unroll
                    for (int a = 0; a < 4; ++a) row[2 * a + 1] += 0.5f * ps[4 * a + 3];
                }
                LDS_WAIT();
            }
            if (more) NSA_STORE((it + 1) & 1, true);
            __syncthreads();
        }
#pragma unroll
        for (int r = 0; r < 16; ++r) { out0[r] += g0 * o0[r]; out1[r] += g0 * o1[r]; }
    }
    {
        const int nlast = cur - 2;
#pragma unroll 1
        for (int tk = 0; tk < 8; ++tk) {
            const LAS float* row = imp + (8 * wid + tk) * IMP_P;
            const int j0 = lane, j1 = lane + 64; const float v0 = row[j0], v1 = row[j1];
            int c0 = 0, c1 = 0;
#pragma unroll 2
            for (int jj = 1; jj <= nlast; ++jj) { const float x = row[jj]; c0 += (x > v0 || (x == v0 && jj < j0)) ? 1 : 0; c1 += (x > v1 || (x == v1 && jj < j1)) ? 1 : 0; }
            const bool s0 = j0 >= 1 && j0 <= nlast && c0 < 13, s1 = j1 <= nlast && c1 < 13;
            unsigned long long m0 = __ballot(s0), m1 = __ballot(s1);
            m0 |= 1ull;
            if (cur < 64) m0 |= 1ull << cur; else m1 |= 1ull << (cur - 64);
            if (cur >= 1) { if (cur - 1 < 64) m0 |= 1ull << (cur - 1); else m1 |= 1ull << (cur - 65); }
            if (lane == 0) { selm[(8 * wid + tk) * 4 + 0] = (unsigned)m0; selm[(8 * wid + tk) * 4 + 1] = (unsigned)(m0 >> 32); selm[(8 * wid + tk) * 4 + 2] = (unsigned)m1; selm[(8 * wid + tk) * 4 + 3] = (unsigned)(m1 >> 32); }
        }
        LDS_WAIT();
        if (lane < 4) { unsigned x = 0; for (int tk = 0; tk < 8; ++tk) x |= selm[(8 * wid + tk) * 4 + lane]; wun[wid * 4 + lane] = x; }
        __syncthreads();
    }
    const unsigned long long tm0 = (unsigned long long)selm[tok * 4 + 0] | ((unsigned long long)selm[tok * 4 + 1] << 32), tm1 = (unsigned long long)selm[tok * 4 + 2] | ((unsigned long long)selm[tok * 4 + 3] << 32);
    unsigned long long wu0, wu1, gu0 = 0, gu1 = 0;
    {
        const unsigned a0 = __builtin_amdgcn_readfirstlane(wun[wid * 4 + 0]), a1 = __builtin_amdgcn_readfirstlane(wun[wid * 4 + 1]), a2 = __builtin_amdgcn_readfirstlane(wun[wid * 4 + 2]), a3 = __builtin_amdgcn_readfirstlane(wun[wid * 4 + 3]);
        wu0 = (unsigned long long)a0 | ((unsigned long long)a1 << 32); wu1 = (unsigned long long)a2 | ((unsigned long long)a3 << 32);
        for (int w = 0; w < 8; ++w) {
            const unsigned b0 = __builtin_amdgcn_readfirstlane(wun[w * 4 + 0]), b1 = __builtin_amdgcn_readfirstlane(wun[w * 4 + 1]), b2 = __builtin_amdgcn_readfirstlane(wun[w * 4 + 2]), b3 = __builtin_amdgcn_readfirstlane(wun[w * 4 + 3]);
            gu0 |= (unsigned long long)b0 | ((unsigned long long)b1 << 32); gu1 |= (unsigned long long)b2 | ((unsigned long long)b3 << 32);
        }
    }
    {
        const bf16* ksrc = Z1 + ((size_t)b * SEQ + krow) * Z1P + 256 + g * 64 + kch * 8;
        const bf16* vsrc = VTS + ((size_t)(b * 128 + g * 64 + krow)) * SEQ + kch * 8;
        float mref = 0.f, thr = -1e29f, l = 0.f; f32x16 o0, o1; zero16(o0); zero16(o1);
        const float sl4 = slope * (float)(4 * hi);
        int j = next_set(gu0, gu1, 0);
        sk = *(const u32x4*)(ksrc + (size_t)j * 64 * Z1P); sv = *(const u32x4*)(vsrc + j * 64); NSA_STORE(0, true); __syncthreads();
        int par = 0;
        while (j < 128) {
            const int nj = next_set(gu0, gu1, j + 1);
            const bool more = nj < 128;
            if (more) { sk = *(const u32x4*)(ksrc + (size_t)nj * 64 * Z1P); sv = *(const u32x4*)(vsrc + nj * 64); }
            const bool wsel = ((j < 64 ? (wu0 >> j) : (wu1 >> (j - 64))) & 1ull) != 0;
            if (wsel) {
                const LAS char* Kb = lds + L_KB + par * KB_SZ; const LAS char* Vb = lds + L_VB + par * VB_SZ;
                const bool tsel = ((j < 64 ? (tm0 >> j) : (tm1 >> (j - 64))) & 1ull) != 0;
                f32x16 cin; fill16(cin, tsel ? (sl4 - mref - slope * (float)(t - j * 64)) : NEGF);
                f32x16 s0 = qk_sub<4>(Kb, 144, 0, qr, cin, r32, hi), s1 = qk_sub<4>(Kb, 144, 1, qr, cin, r32, hi);
#pragma unroll
                for (int r = 0; r < 16; ++r) { s0[r] = __builtin_fmaf(slope, (float)((r & 3) + 8 * (r >> 2)), s0[r]); s1[r] = __builtin_fmaf(slope, (float)((r & 3) + 8 * (r >> 2) + 32), s1[r]); }
                if (j == cur) {
#pragma unroll
                    for (int r = 0; r < 16; ++r) { const int d0_ = t - (j * 64 + crow(r, hi)); if (d0_ < 0) s0[r] = NEGF; if (d0_ < 32) s1[r] = NEGF; }
                }
                sm_tile(s0, s1, mref, thr, l, o0, o1);
                pv_sub(o0, o1, Vb, 0, s0, r32, hi); pv_sub(o0, o1, Vb, 1, s1, r32, hi);
            }
            if (more) NSA_STORE(par ^ 1, true);
            __syncthreads();
            par ^= 1; j = nj;
        }
        l += __shfl_xor(l, 32);
        const float sc = g1 / fmaxf(l, 1e-30f);
#pragma unroll
        for (int r = 0; r < 16; ++r) { out0[r] += sc * o0[r]; out1[r] += sc * o1[r]; }
    }
    {
        const bf16* ksrc = Z1 + ((size_t)b * SEQ + krow) * Z1P + 512 + g * 64 + kch * 8;
        const bf16* vsrc = VTW + ((size_t)(b * 128 + g * 64 + krow)) * SEQ + kch * 8;
        float mref = 0.f, thr = -1e29f, l = 0.f; f32x16 o0, o1; zero16(o0); zero16(o1);
        const float sl4 = slope * (float)(4 * hi);
        const int tw0 = t0 + 8 * wid;
        const int kt_first = (t0 >= 512) ? (t0 - 512) / 64 : 0, kt_last = t0 / 64;
        sk = *(const u32x4*)(ksrc + (size_t)kt_first * 64 * Z1P); sv = *(const u32x4*)(vsrc + kt_first * 64); NSA_STORE(0, true); __syncthreads();
        int par = 0;
        for (int kt = kt_first; kt <= kt_last; ++kt) {
            const bool more = kt < kt_last;
            if (more) { sk = *(const u32x4*)(ksrc + (size_t)(kt + 1) * 64 * Z1P); sv = *(const u32x4*)(vsrc + (kt + 1) * 64); }
            const LAS char* Kb = lds + L_KB + par * KB_SZ; const LAS char* Vb = lds + L_VB + par * VB_SZ;
            f32x16 cin; fill16(cin, sl4 - mref - slope * (float)(t - kt * 64));
            f32x16 s0 = qk_sub<4>(Kb, 144, 0, qr, cin, r32, hi), s1 = qk_sub<4>(Kb, 144, 1, qr, cin, r32, hi);
#pragma unroll
            for (int r = 0; r < 16; ++r) { s0[r] = __builtin_fmaf(slope, (float)((r & 3) + 8 * (r >> 2)), s0[r]); s1[r] = __builtin_fmaf(slope, (float)((r & 3) + 8 * (r >> 2) + 32), s1[r]); }
            if (kt * 64 + 63 > tw0 || kt * 64 < tw0 + 7 - 511) {
#pragma unroll
                for (int r = 0; r < 16; ++r) { const int d0_ = t - (kt * 64 + crow(r, hi)), d1_ = d0_ - 32;
                    if (!(d0_ >= 0 && d0_ < 512)) s0[r] = NEGF; if (!(d1_ >= 0 && d1_ < 512)) s1[r] = NEGF; }
            }
            sm_tile(s0, s1, mref, thr, l, o0, o1);
            pv_sub(o0, o1, Vb, 0, s0, r32, hi); pv_sub(o0, o1, Vb, 1, s1, r32, hi);
            if (more) NSA_STORE(par ^ 1, true);
            __syncthreads();
            par ^= 1;
        }
        l += __shfl_xor(l, 32);
        const float sc = g2 / fmaxf(l, 1e-30f);
#pragma unroll
        for (int r = 0; r < 16; ++r) { out0[r] += sc * o0[r]; out1[r] += sc * o1[r]; }
    }
#undef NSA_STORE
    bf16* orow = QN + rowq * 512 + head * 64 + 4 * hi;
#pragma unroll
    for (int a = 0; a < 4; ++a) {
        u32x2 w; w.x = cvtpk(out0[4 * a], out0[4 * a + 1]); w.y = cvtpk(out0[4 * a + 2], out0[4 * a + 3]); *(u32x2*)(orow + 8 * a) = w;
        w.x = cvtpk(out1[4 * a], out1[4 * a + 1]); w.y = cvtpk(out1[4 * a + 2], out1[4 * a + 3]); *(u32x2*)(orow + 32 + 8 * a) = w;
    }
}

struct Args { const float* in[27]; float* out; unsigned char* ws; int ph_lo, ph_hi; };
enum { I_X = 0, I_F1PRE, I_F1POST, I_F1G, I_F1U, I_F1D, I_MPRE, I_MPOST, I_WIN, I_CPK, I_CW1K, I_CW2K, I_CPV, I_CW1V, I_CW2V, I_QNG, I_WUQ, I_KVNG, I_WUKV, I_WPN, I_WPM, I_WOUT, I_F2PRE, I_F2POST, I_F2G, I_F2U, I_F2D };

__global__ void __launch_bounds__(NWAVES * 64, 2) fwd_kernel(Args args) {
    extern __shared__ __attribute__((aligned(16))) unsigned char lds_raw[];
    LAS unsigned char* lds = (LAS unsigned char*)lds_raw;
    const int wave = __builtin_amdgcn_readfirstlane((int)threadIdx.x >> 6);
    const int G = gridDim.x, c = blockIdx.x;
    const int NGW = G * NWAVES, NGT = G * NWAVES * 64;
#define IDS() const int lane = mk_lane(); const int tid = wave * 64 + lane; const int gw = c * NWAVES + wave; const int gt = c * (NWAVES * 64) + tid; (void)tid; (void)gw; (void)gt
#define WGU1 ((bf16*)(args.ws + O_WGU1))
#define WD1 ((bf16*)(args.ws + O_WD1))
#define WGU2 ((bf16*)(args.ws + O_WGU2))
#define WD2 ((bf16*)(args.ws + O_WD2))
#define WIN ((bf16*)(args.ws + O_WIN))
#define WPN ((bf16*)(args.ws + O_WPN))
#define WPM ((bf16*)(args.ws + O_WPM))
#define WOUT ((bf16*)(args.ws + O_WOUT))
#define WUQ ((bf16*)(args.ws + O_WUQ))
#define WUKV ((bf16*)(args.ws + O_WUKV))
#define CW1K ((bf16*)(args.ws + O_CW1K))
#define CW1V ((bf16*)(args.ws + O_CW1V))
#define A1 ((bf16*)(args.ws + O_A1))
#define IM2K ((bf16*)(args.ws + O_IM2K))
#define IM2V ((bf16*)(args.ws + O_IM2V))
#define CQN ((bf16*)(args.ws + O_CQN))
#define CKVN ((bf16*)(args.ws + O_CKVN))
#define KR ((bf16*)(args.ws + O_KR))
#define HK ((bf16*)(args.ws + O_HK))
#define HV ((bf16*)(args.ws + O_HV))
#define KC ((bf16*)(args.ws + O_KC))
#define VCT ((bf16*)(args.ws + O_VCT))
#define MG ((bf16*)(args.ws + O_MG))
#define H ((bf16*)(args.ws + O_H))
#define Z1 ((bf16*)(args.ws + O_Z1))
#define QN ((bf16*)(args.ws + O_QN))
#define YM ((bf16*)(args.ws + O_YM))
#define KM ((bf16*)(args.ws + O_KM))
#define GM ((bf16*)(args.ws + O_GM))
#define QM ((bf16*)(args.ws + O_QM))
#define VTM ((bf16*)(args.ws + O_VTM))
#define VTS ((bf16*)(args.ws + O_VTS))
#define VTW ((bf16*)(args.ws + O_VTW))
#define F ((bf16*)(args.ws + O_F))
#define X (args.out)
    typedef const float* cfp_t;
    const __attribute__((address_space(4))) cfp_t* in = (const __attribute__((address_space(4))) cfp_t*)__builtin_amdgcn_kernarg_segment_ptr();
    asm volatile("" : "+s"(in));
    const int lo = args.ph_lo, hi_ph = args.ph_hi;
#define IN(k) (lo <= (k) && (k) < hi_ph)
#if MK_PER_PHASE
#define SEAM(k) do { } while (0)
#else
    if (lo == 0 && hi_ph == NPHASE) { cg::grid_group grid = cg::this_grid(); grid.sync(); }
    volatile LAS unsigned* xst = (volatile LAS unsigned*)(lds + 131072 + 512);
    XcdBarrier xbar;
    { const int l_ = mk_lane(); const int t_ = wave * 64 + l_; if (t_ < 2) xst[t_] = 0u; __syncthreads(); xbar = xcd_barrier_post((unsigned*)(args.ws + O_CTL), xst, t_); }
#define SEAM(k) do { if (IN(k) && IN((k) + 1)) { const int l_ = mk_lane(); xcd_barrier(xbar, wave * 64 + l_); } } while (0)
#endif
#define GEMM_CALL(EPI, A_, B_, M_, N_, K_, cc, E_) do { Gemm g_{(const pg8::bf16_t*)(A_), (const pg8::bf16_t*)(B_), (M_), (N_), (K_)}; StaticOrder S_; S_.init((M_), (N_), G, (cc)); \
        const int l_ = mk_lane(); pg8::gemm_phase<EPI, StaticOrder, true, PG8_SP2>(lds, g_, S_, (E_), wave, l_); } while (0)

    if (IN(0)) {
        IDS();
        LAS float* scr = (LAS float*)(lds + wave * 16384);
        transpose_mat(in[I_F1G], DFF, MapGU{0}, 1024, DFF, WGU1, scr, gw, NGW, lane);
        transpose_mat(in[I_F1U], DFF, MapGU{1}, 1024, DFF, WGU1, scr, gw, NGW, lane);
        transpose_mat(in[I_F1D], 1024, MapPlain{}, 2816, 1024, WD1, scr, gw, NGW, lane);
        transpose_mat(in[I_WIN], 3768, MapWin{}, 1024, 3840, WIN, scr, gw, NGW, lane);
        transpose_mat(in[I_F2G], DFF, MapGU{0}, 1024, DFF, WGU2, scr, gw, NGW, lane);
        transpose_mat(in[I_F2U], DFF, MapGU{1}, 1024, DFF, WGU2, scr, gw, NGW, lane);
        transpose_mat(in[I_F2D], 1024, MapPlain{}, 2816, 1024, WD2, scr, gw, NGW, lane);
        transpose_mat(in[I_WPN], 1024, MapPlain{}, 512, 1024, WPN, scr, gw, NGW, lane);
        transpose_mat(in[I_WPM], 1024, MapPlain{}, 512, 1024, WPM, scr, gw, NGW, lane);
        transpose_mat(in[I_WOUT], 1024, MapPlain{}, 1024, 1024, WOUT, scr, gw, NGW, lane);
        transpose_mat(in[I_WUQ], 768, MapPlain{}, 256, 768, WUQ, scr, gw, NGW, lane);
        transpose_mat(in[I_WUKV], 1024, MapUkv{}, 128, 1024, WUKV, scr, gw, NGW, lane);
        transpose_mat(in[I_CW1K], 256, MapPlain{}, 2048, 256, CW1K, scr, gw, NGW, lane);
        transpose_mat(in[I_CW1V], 256, MapPlain{}, 2048, 256, CW1V, scr, gw, NGW, lane);
        for (int m = gw; m < MTOK; m += NGW) { const f32x4* xr = (const f32x4*)(in[I_X] + (size_t)m * DM) + lane; f32x4 v[4];
#pragma unroll
            for (int j = 0; j < 4; ++j) v[j] = xr[64 * j];
            rms_row_to_bf16(v, in[I_F1PRE], A1 + (size_t)m * DM, lane); }
        __syncthreads();
    }
    SEAM(0);
    if (IN(1)) GEMM_CALL(EpiSwiglu, A1, WGU1, MTOK, 5632, 1024, c, (EpiSwiglu{H}));
    SEAM(1);
#ifdef PROBE_FFN2
    if (IN(2)) GEMM_CALL(EpiF32, H, WD1, MTOK, 1024, 2816, c, (EpiF32{F, DM}));
    if (IN(1)) GEMM_CALL(EpiSwiglu, A1, WGU1, MTOK, 5632, 1024, c, (EpiSwiglu{H}));
#endif
    if (IN(2)) GEMM_CALL(EpiF32, H, WD1, MTOK, 1024, 2816, c, (EpiF32{F, DM}));
    SEAM(2);
    if (IN(3)) { IDS(); rowop<true>(F, in[I_X], 0.5f, in[I_F1POST], X, in[I_MPRE], A1, gw, NGW, lane); }
    SEAM(3);
    if (IN(4)) GEMM_CALL(EpiWin, A1, WIN, MTOK, 3840, 1024, c, (EpiWin{QN, Z1, GM, VTS, VTW}));
    SEAM(4);
    if (IN(5)) {
        IDS();
        for (int ch = gt; ch < 2 * 4096 * 256; ch += NGT) {
            const int kv = ch >> 20, r = (ch >> 8) & 4095, c8 = ch & 255, l = c8 >> 3, d0 = (c8 & 7) * 8, bgi = r >> 9, i = r & 511, b = bgi >> 1, g = bgi & 1;
            u32x4 o = (u32x4){0u, 0u, 0u, 0u};
            if (i < 511) {
                const u32x4 z = *(const u32x4*)(Z1 + ((size_t)b * SEQ + 16 * i + l) * Z1P + kv * 128 + g * 64 + d0);
                const float* pe = (kv ? in[I_CPV] : in[I_CPK]) + l * 64 + d0; const f32x4 p0 = *(const f32x4*)pe, p1 = *(const f32x4*)(pe + 4);
                o.x = cvtpk(bflo(z.x) + p0.x, bfhi(z.x) + p0.y); o.y = cvtpk(bflo(z.y) + p0.z, bfhi(z.y) + p0.w); o.z = cvtpk(bflo(z.z) + p1.x, bfhi(z.z) + p1.y); o.w = cvtpk(bflo(z.w) + p1.z, bfhi(z.w) + p1.w);
            }
            *(u32x4*)((kv ? IM2V : IM2K) + (size_t)r * 2048 + c8 * 8) = o;
        }
        for (int m = gw; m < MTOK; m += NGW) {
            const bf16* zr = Z1 + (size_t)m * Z1P;
            { const u32x2 w = *(const u32x2*)(zr + 768 + 4 * lane); const float a0 = bflo(w.x), a1 = bfhi(w.x), a2 = bflo(w.y), a3 = bfhi(w.y);
              const float r = rsqrtf(wave_sum((a0 * a0 + a1 * a1) + (a2 * a2 + a3 * a3)) * (1.f / 256.f) + EPS); const f32x4 gq = *(const f32x4*)(in[I_QNG] + 4 * lane);
              u32x2 o; o.x = cvtpk(a0 * r * gq.x, a1 * r * gq.y); o.y = cvtpk(a2 * r * gq.z, a3 * r * gq.w); *(u32x2*)(CQN + (size_t)m * 256 + 4 * lane) = o; }
            { const unsigned w = *(const unsigned*)(zr + 1024 + 2 * lane); const float a0 = bflo(w), a1 = bfhi(w);
              const float r = rsqrtf(wave_sum(a0 * a0 + a1 * a1) * (1.f / 128.f) + EPS); const float gk0 = in[I_KVNG][2 * lane], gk1 = in[I_KVNG][2 * lane + 1];
              *(unsigned*)(CKVN + (size_t)m * 128 + 2 * lane) = cvtpk(a0 * r * gk0, a1 * r * gk1); }
            if (lane < 16) { const float x1 = bf2f(zr[1152 + lane]), x2 = bf2f(zr[1152 + 16 + lane]); float cs, sn; rope_cs(m & 8191, lane, cs, sn);
              KR[(size_t)m * 32 + lane] = f2bf(x1 * cs - x2 * sn); KR[(size_t)m * 32 + 16 + lane] = f2bf(x1 * sn + x2 * cs); }
        }
    }
    SEAM(5);
    if (IN(6)) {
        GEMM_CALL(EpiGelu, IM2K, CW1K, 4096, 256, 2048, c, (EpiGelu{HK, 256}));
        GEMM_CALL(EpiGelu, IM2V, CW1V, 4096, 256, 2048, (c + G / 2) % G, (EpiGelu{HV, 256}));
        GEMM_CALL(EpiQup, CQN, WUQ, MTOK, 768, 256, c, (EpiQup{QM}));
        GEMM_CALL(EpiKVup, CKVN, WUKV, MTOK, 1024, 128, c, (EpiKVup{KM, VTM}));
    }
    SEAM(6);
    if (IN(7)) {
        IDS();
        for (int idx = gt; idx < 2 * 4096 * 64; idx += NGT) {
            const int kv = idx >> 18, r = (idx >> 6) & 4095, d = idx & 63;
            const bf16* hrow = (kv ? HV : HK) + (size_t)r * 256; const float* w2 = (kv ? in[I_CW2V] : in[I_CW2K]) + d;
            float acc = 0.f;
            for (int j8 = 0; j8 < 32; ++j8) { const u32x4 hw = *(const u32x4*)(hrow + j8 * 8); const float* wp = w2 + (size_t)j8 * 8 * 64;
                acc += bflo(hw.x) * wp[0] + bfhi(hw.x) * wp[64] + bflo(hw.y) * wp[128] + bfhi(hw.y) * wp[192] + bflo(hw.z) * wp[256] + bfhi(hw.z) * wp[320] + bflo(hw.w) * wp[384] + bfhi(hw.w) * wp[448]; }
            if (kv == 0) KC[(size_t)r * 64 + d] = f2bf(acc); else VCT[((size_t)(r >> 9) * 64 + d) * 512 + (r & 511)] = f2bf(acc);
        }
    }
    SEAM(7);
    if (IN(8)) {
        IDS();
        LAS char* al = (LAS char*)lds;
#ifdef PROBE_MLA2
        for (int rep_ = 0; rep_ < 2; ++rep_)
#endif
        for (int i = 0; i * G < 1024; ++i) { const int p = (i & 1) ? (G - 1 - c) : c, uu = i * G + p;
            if (uu < 1024) { const int qb = 31 - (uu >> 5), bh = uu & 31;
#ifndef NO_MLA
 mla_unit(bh >> 3, bh & 7, qb, QM, KM, KR, VTM, YM, al, wave, lane);
#endif
 } }
        for (int i = 0; i * G < 1024; ++i) { const int p = (i & 1) ? (G - 1 - c) : c, uu = i * G + p;
            if (uu < 1024) { const int tile = 127 - (uu >> 3), bgi = uu & 7;
#ifndef NO_NSA
 nsa_unit(bgi >> 1, bgi & 1, tile, QN, Z1, KC, VCT, VTS, VTW, al, wave, lane);
#endif
 } }
    }
    SEAM(8);
    if (IN(9)) {
        GEMM_CALL(EpiProj<false>, QN, WPN, MTOK, 1024, 512, c, (EpiProj<false>{GM, MG}));
        GEMM_CALL(EpiProj<true>, YM, WPM, MTOK, 1024, 512, c, (EpiProj<true>{GM, MG}));
    }
    SEAM(9);
    if (IN(10)) GEMM_CALL(EpiF32, MG, WOUT, MTOK, 1024, 1024, c, (EpiF32{F, DM}));
    SEAM(10);
    if (IN(11)) { IDS(); rowop<true>(F, X, 1.0f, in[I_MPOST], X, in[I_F2PRE], A1, gw, NGW, lane); }
    SEAM(11);
    if (IN(12)) GEMM_CALL(EpiSwiglu, A1, WGU2, MTOK, 5632, 1024, c, (EpiSwiglu{H}));
    SEAM(12);
    if (IN(13)) GEMM_CALL(EpiF32, H, WD2, MTOK, 1024, 2816, c, (EpiF32{F, DM}));
    SEAM(13);
    if (IN(14)) { IDS(); rowop<false>(F, X, 0.5f, in[I_F2POST], X, nullptr, nullptr, gw, NGW, lane); }
#undef IN
#undef IDS
#undef SEAM
#undef GEMM_CALL
#undef WGU1
#undef WD1
#undef WGU2
#undef WD2
#undef WIN
#undef WPN
#undef WPM
#undef WOUT
#undef WUQ
#undef WUKV
#undef CW1K
#undef CW1V
#undef A1
#undef IM2K
#undef IM2V
#undef CQN
#undef CKVN
#undef KR
#undef HK
#undef HV
#undef KC
#undef VCT
#undef MG
#undef H
#undef Z1
#undef QN
#undef YM
#undef KM
#undef GM
#undef QM
#undef VTM
#undef VTS
#undef VTW
#undef F
#undef X
}
}

extern "C" void kernel_launch(void* const* d_in, const int* in_sizes, int n_in, void* d_out, int out_size, void* d_ws, size_t ws_size, hipStream_t stream) {
    using namespace mk;
    static int grid = 0;
    if (grid == 0) {
        if (n_in != 27 || out_size != MTOK * DM || ws_size < O_END) { fprintf(stderr, "kernel_launch: unexpected problem (n_in %d out %d ws %zu)\n", n_in, out_size, ws_size); grid = -1; return; }
        int dev = 0, cus = 0, per_cu = 0;
        hipGetDevice(&dev); hipDeviceGetAttribute(&cus, hipDeviceAttributeMultiprocessorCount, dev);
        if (hipFuncSetAttribute((const void*)fwd_kernel, hipFuncAttributeMaxDynamicSharedMemorySize, LDS_BYTES) != hipSuccess) { fprintf(stderr, "kernel_launch: hipFuncSetAttribute failed\n"); grid = -1; return; }
        if (hipOccupancyMaxActiveBlocksPerMultiprocessor(&per_cu, (const void*)fwd_kernel, NWAVES * 64, LDS_BYTES) != hipSuccess || per_cu < 1) { fprintf(stderr, "kernel_launch: occupancy query says %d\n", per_cu); per_cu = 1; }
        (void)hipGetLastError();
        grid = cus * per_cu;
    }
    if (grid < 0) return;
    if (hipMemsetAsync((char*)d_ws + O_CTL, 0, 16384, stream) != hipSuccess) { fprintf(stderr, "kernel_launch: memset failed\n"); return; }
    Args a{};
    for (int i = 0; i < 27; ++i) a.in[i] = (const float*)d_in[i];
    a.out = (float*)d_out; a.ws = (unsigned char*)d_ws;
#if MK_PER_PHASE
    for (int ph = 0; ph < NPHASE; ++ph) { a.ph_lo = ph; a.ph_hi = ph + 1; hipLaunchKernelGGL(fwd_kernel, dim3(grid), dim3(NWAVES * 64), LDS_BYTES, stream, a); }
#else
    a.ph_lo = 0; a.ph_hi = NPHASE;
    void* kargs[] = {&a};
    hipError_t e = hipLaunchCooperativeKernel((const void*)fwd_kernel, dim3(grid), dim3(NWAVES * 64), kargs, LDS_BYTES, stream);
    if (e != hipSuccess) fprintf(stderr, "cooperative launch failed: %s (grid %d)\n", hipGetErrorString(e), grid);
#endif
}
```

```cpp
#include <hip/hip_runtime.h>
#include <hip/hip_cooperative_groups.h>
#include <cstdio>
#include <cstdint>
namespace cg = cooperative_groups;
namespace pg8 {
#define PG8_LAS __attribute__((address_space(3)))
typedef unsigned short bf16_t;
typedef short bf16x8 __attribute__((ext_vector_type(8)));
typedef float f32x4 __attribute__((ext_vector_type(4)));
typedef unsigned u32x4 __attribute__((ext_vector_type(4)));
constexpr int BM = 256, BK = 64, HALF = 128, HTB = HALF * BK * 2  , STAGE_BYTES = 8 * HTB, NXCD = 8, WGM = 16;

__host__ __device__ __forceinline__ int lds_byte(int r, int c) { const int st = (r >> 4) * 2 + (c >> 5), rr = r & 15, cc = c & 31, ob = rr * 64 + cc * 2; return st * 1024 + (ob ^ (((ob >> 9) & 1) << 5)); }
__host__ __device__ __forceinline__ void stage_rc(int b, int& R, int& C) { const int st = b / 1024, sb = b % 1024, swz = sb ^ (((sb >> 9) & 1) << 5); R = (st >> 1) * 16 + swz / 64; C = (st & 1) * 32 + (swz % 64) / 2; }
__host__ __device__ __forceinline__ int perm32(int rho) { const int n = rho >> 4, i = rho & 15; return 8 * (i >> 2) + 4 * n + (i & 3); }

struct Unit { int pm, pn; };
struct Gemm { const bf16_t* A; const bf16_t* Bt; int M, N, K; };

struct StaticOrder {
    int nM, nN, nwg, G, c;
    __host__ __device__ void init(int M, int N, int G_, int c_) { nM = M / BM; nN = N / BM; nwg = nM * nN; G = G_; c = c_; }
    __host__ __device__ bool next(int i, Unit& u) const {
        const long L = (long)i * G + c; if (L >= nwg) return false;
        int wgid = (int)L; { const int q = nwg / NXCD, r = nwg % NXCD, xcd = wgid % NXCD, off = wgid / NXCD; wgid = (xcd < r ? xcd * (q + 1) : r * (q + 1) + (xcd - r) * q) + off; }
        const int nig = WGM * nN, gid = wgid / nig, fm = gid * WGM, gsz = (nM - fm) < WGM ? (nM - fm) : WGM;
        u.pm = fm + ((wgid % nig) % gsz); u.pn = (wgid % nig) / gsz; return true;
    }
    __device__ __forceinline__ void a_ready(const Unit&) const {}
    __device__ __forceinline__ void done(const Unit&) const {}
};

__device__ __forceinline__ unsigned cvt_pk_bf16(float lo, float hi) { unsigned r; asm volatile("v_cvt_pk_bf16_f32 %0, %1, %2" : "=v"(r) : "v"(lo), "v"(hi)); return r; }
typedef float f32x2 __attribute__((ext_vector_type(2)));
template <class Epi, class Sched, bool ALIGN_EPI = false, bool SP2 = false>
__device__ __forceinline__ void gemm_phase(PG8_LAS unsigned char* lds, const Gemm g, const Sched& S, const Epi& E, const int wid, const int lane) {
    const int tid = wid * 64 + lane, wr = wid >> 2, wc = wid & 3, fr = lane & 15, fq = lane >> 4;
    const int K = g.K, nt = K / BK;
    unsigned voffA[2], voffB[2];
#pragma unroll
    for (int i = 0; i < 2; ++i) { int R, C; stage_rc(tid * 16 + i * 8192, R, C); const int Rb = Epi::PERM ? ((R & ~31) + perm32(R & 31)) : R;
        voffA[i] = (unsigned)(R * K + C) * 2u; voffB[i] = (unsigned)(Rb * K + C) * 2u; }
    const size_t kstep = (size_t)(BK * 2);
    const size_t hstep = (size_t)HALF * K * 2;
    const size_t tstep = 2 * hstep;
    const unsigned ldsw = (unsigned)wid * 1024u;
    const int aoff = lds_byte(wr * 64 + fr, fq * 8), boff = lds_byte(wc * 32 + fr, fq * 8);
#define PG8_SA(b, h) (((b) * 2 + (h)) * HTB)
#define PG8_SB(b, h) ((4 + (b) * 2 + (h)) * HTB)
#define PG8_STAGE(bufoff, gbase, voff) do { _Pragma("unroll") for (int _i = 0; _i < 2; ++_i) \
        __builtin_amdgcn_global_load_lds((const unsigned*)((const char*)(gbase) + (voff)[_i]), (PG8_LAS unsigned*)(lds + (bufoff) + ldsw + _i * 8192), 16, 0, 0); } while (0)
#define PG8_LDA(dst, b, h) do { _Pragma("unroll") for (int m = 0; m < 4; ++m) _Pragma("unroll") for (int k = 0; k < 2; ++k) dst[m][k] = *(const PG8_LAS bf16x8*)(lds + PG8_SA(b, h) + aoff + m * 2048 + k * 1024); } while (0)
#define PG8_LDB(dst, b, h) do { _Pragma("unroll") for (int n = 0; n < 2; ++n) _Pragma("unroll") for (int k = 0; k < 2; ++k) dst[n][k] = *(const PG8_LAS bf16x8*)(lds + PG8_SB(b, h) + boff + n * 2048 + k * 1024); } while (0)
#define PG8_MMA(ai, bj, At, Bt) do { __builtin_amdgcn_s_setprio(1); _Pragma("unroll") for (int m = 0; m < 4; ++m) _Pragma("unroll") for (int n = 0; n < 2; ++n) _Pragma("unroll") for (int k = 0; k < 2; ++k) \
        acc[ai][bj][m][n] = __builtin_amdgcn_mfma_f32_16x16x32_bf16(Bt[n][k], At[m][k], acc[ai][bj][m][n], 0, 0, 0); __builtin_amdgcn_s_setprio(0); } while (0)
#define PG8_WAIT_V(n) asm volatile("s_waitcnt vmcnt(" #n ")" ::: "memory")
#define PG8_WAIT_L(n) asm volatile("s_waitcnt lgkmcnt(" #n ")" ::: "memory")
#define PG8_BAR __builtin_amdgcn_s_barrier()
#define PG8_SCHED __builtin_amdgcn_sched_barrier(0)
    Unit cur, nxt; int ui = 0;
    if (!S.next(0, cur)) return;
    f32x4 acc[2][2][4][2];
#pragma unroll
    for (int a = 0; a < 2; ++a)
#pragma unroll
        for (int b = 0; b < 2; ++b)
#pragma unroll
            for (int m = 0; m < 4; ++m)
#pragma unroll
                for (int n = 0; n < 2; ++n) acc[a][b][m][n] = (f32x4){0.f, 0.f, 0.f, 0.f};
    bf16x8 At[4][2], B0[2][2], B1[2][2];
    const char* cA = (const char*)g.A + (size_t)cur.pm * tstep; const char* cB = (const char*)g.Bt + (size_t)cur.pn * tstep;
    S.a_ready(cur);
    if constexpr (SP2) {
        PG8_STAGE(PG8_SB(0, 0), cB, voffB); PG8_STAGE(PG8_SB(0, 1), cB + hstep, voffB); PG8_STAGE(PG8_SA(0, 0), cA, voffA); PG8_STAGE(PG8_SA(0, 1), cA + hstep, voffA);
        if (wr == 1) PG8_BAR;
        PG8_WAIT_V(2); PG8_BAR;
        PG8_STAGE(PG8_SB(1, 0), cB + kstep, voffB); PG8_STAGE(PG8_SA(1, 0), cA + kstep, voffA); PG8_STAGE(PG8_SB(1, 1), cB + hstep + kstep, voffB);
        PG8_WAIT_V(6); PG8_BAR;
    } else {
        PG8_STAGE(PG8_SB(0, 0), cB, voffB); PG8_STAGE(PG8_SA(0, 0), cA, voffA); PG8_STAGE(PG8_SB(0, 1), cB + hstep, voffB); PG8_STAGE(PG8_SA(0, 1), cA + hstep, voffA);
        if (wr == 1) PG8_BAR;
        PG8_WAIT_V(4); PG8_BAR;
        PG8_STAGE(PG8_SB(1, 0), cB + kstep, voffB); PG8_STAGE(PG8_SA(1, 0), cA + kstep, voffA); PG8_STAGE(PG8_SB(1, 1), cB + hstep + kstep, voffB);
        PG8_WAIT_V(6); PG8_BAR;
    }
    for (;;) {
        const bool has_next = S.next(ui + 1, nxt);
        const char* nA = has_next ? (const char*)g.A + (size_t)nxt.pm * tstep : cA; const char* nB = has_next ? (const char*)g.Bt + (size_t)nxt.pn * tstep : cB;
        for (int t = 0; t < nt; t += 2) {
            const bool last = (t == nt - 2);
            const char* a1 = cA + (size_t)(t + 1) * kstep;
            const char* a2 = last ? nA : cA + (size_t)(t + 2) * kstep; const char* b2 = last ? nB : cB + (size_t)(t + 2) * kstep;
            const char* a3 = a2 + kstep; const char* b3 = b2 + kstep;
            if (last && has_next) S.a_ready(nxt);
            if constexpr (SP2) {
            PG8_LDB(B0, 0, 0); PG8_LDB(B1, 0, 1); PG8_SCHED; PG8_LDA(At, 0, 0); PG8_STAGE(PG8_SA(1, 1), a1 + hstep, voffA);
            PG8_WAIT_V(8); PG8_WAIT_L(0); PG8_BAR; PG8_MMA(0, 0, At, B0); PG8_MMA(0, 1, At, B1); PG8_BAR; PG8_SCHED;
            PG8_LDA(At, 0, 1); PG8_STAGE(PG8_SB(0, 0), b2, voffB); PG8_STAGE(PG8_SB(0, 1), b2 + hstep, voffB); PG8_STAGE(PG8_SA(0, 0), a2, voffA);
            PG8_WAIT_V(8); PG8_WAIT_L(0); PG8_BAR; PG8_MMA(1, 0, At, B0); PG8_MMA(1, 1, At, B1); PG8_BAR; PG8_SCHED;
            PG8_LDB(B0, 1, 0); PG8_LDB(B1, 1, 1); PG8_SCHED; PG8_LDA(At, 1, 0); PG8_STAGE(PG8_SA(0, 1), a2 + hstep, voffA);
            PG8_WAIT_V(8); PG8_WAIT_L(0); PG8_BAR; PG8_MMA(0, 0, At, B0); PG8_MMA(0, 1, At, B1); PG8_BAR; PG8_SCHED;
            PG8_LDA(At, 1, 1); PG8_STAGE(PG8_SB(1, 0), b3, voffB); PG8_STAGE(PG8_SB(1, 1), b3 + hstep, voffB); PG8_STAGE(PG8_SA(1, 0), a3, voffA);
            PG8_WAIT_V(8); PG8_WAIT_L(0); PG8_BAR; PG8_MMA(1, 0, At, B0); PG8_MMA(1, 1, At, B1); PG8_BAR; PG8_SCHED;
            } else {
            PG8_LDB(B0, 0, 0); PG8_SCHED; PG8_LDA(At, 0, 0); PG8_STAGE(PG8_SA(1, 1), a1 + hstep, voffA);
            PG8_WAIT_L(8); PG8_BAR; PG8_WAIT_L(0); PG8_MMA(0, 0, At, B0); PG8_BAR; PG8_SCHED;
            PG8_LDB(B1, 0, 1); PG8_STAGE(PG8_SB(0, 0), b2, voffB);
            PG8_BAR; PG8_WAIT_L(0); PG8_MMA(0, 1, At, B1); PG8_BAR;
            PG8_LDA(At, 0, 1); PG8_STAGE(PG8_SA(0, 0), a2, voffA);
            PG8_BAR; PG8_WAIT_L(0); PG8_MMA(1, 0, At, B0); PG8_BAR; PG8_SCHED;
            PG8_STAGE(PG8_SB(0, 1), b2 + hstep, voffB);
            PG8_WAIT_V(6); PG8_BAR; PG8_MMA(1, 1, At, B1); PG8_BAR;
            PG8_LDB(B0, 1, 0); PG8_SCHED; PG8_LDA(At, 1, 0); PG8_STAGE(PG8_SA(0, 1), a2 + hstep, voffA);
            PG8_WAIT_L(8); PG8_BAR; PG8_WAIT_L(0); PG8_MMA(0, 0, At, B0); PG8_BAR; PG8_SCHED;
            PG8_LDB(B1, 1, 1); PG8_STAGE(PG8_SB(1, 0), b3, voffB);
            PG8_BAR; PG8_WAIT_L(0); PG8_MMA(0, 1, At, B1); PG8_BAR;
            PG8_LDA(At, 1, 1); PG8_STAGE(PG8_SA(1, 0), a3, voffA);
            PG8_BAR; PG8_WAIT_L(0); PG8_MMA(1, 0, At, B0); PG8_BAR; PG8_SCHED;
            PG8_STAGE(PG8_SB(1, 1), b3 + hstep, voffB);
            PG8_WAIT_V(6); PG8_BAR; PG8_MMA(1, 1, At, B1); PG8_BAR;
            }
        }
        if constexpr (ALIGN_EPI) { if (wr == 0) PG8_BAR; }
        if constexpr (!Epi::AFTER_DRAIN) { E(acc, cur, wr, wc, fr, fq); S.done(cur); }
        if (!has_next) break;
#pragma unroll
        for (int a = 0; a < 2; ++a)
#pragma unroll
            for (int b = 0; b < 2; ++b)
#pragma unroll
                for (int m = 0; m < 4; ++m)
#pragma unroll
                    for (int n = 0; n < 2; ++n) acc[a][b][m][n] = (f32x4){0.f, 0.f, 0.f, 0.f};
        cur = nxt; cA = nA; cB = nB; ++ui;
        if constexpr (ALIGN_EPI) { if (wr == 1) PG8_BAR; }
    }
    PG8_WAIT_V(0);
    if constexpr (!ALIGN_EPI) { if (wr == 0) PG8_BAR; }
    PG8_BAR;
    if constexpr (Epi::AFTER_DRAIN) { E.fused(acc, cur, wr, wc, fr, fq, lds, wid, lane); S.done(cur); }
#undef PG8_SA
#undef PG8_SB
#undef PG8_STAGE
#undef PG8_LDA
#undef PG8_LDB
#undef PG8_MMA
#undef PG8_WAIT_V
#undef PG8_WAIT_L
#undef PG8_BAR
#undef PG8_SCHED
}
}

#ifndef PG8_SP2
#define PG8_SP2 true
#endif
#ifndef MK_PER_PHASE
#define MK_PER_PHASE 0
#endif

namespace mk {
using pg8::bf16x8; using pg8::f32x4; using pg8::u32x4; using pg8::Unit; using pg8::Gemm; using pg8::StaticOrder;
typedef unsigned short bf16;
typedef float f32x16 __attribute__((ext_vector_type(16)));
typedef unsigned u32x2 __attribute__((ext_vector_type(2)));
typedef float f32x2_t __attribute__((ext_vector_type(2)));
typedef __bf16 bf16x2_t __attribute__((ext_vector_type(2)));
#define LAS __attribute__((address_space(3)))
#define LDS_WAIT() asm volatile("s_waitcnt lgkmcnt(0)" ::: "memory")

#define XB_TMO      128
#define XB_XCNT(j)  (256  + 64 * (j))
#define XB_XSUB(j)  (1280 + 64 * (j))
#define XB_XGEN(j)  (2304 + 64 * (j))
#define XB_TOP      3328
#define XB_TOPGEN   3392
#define XCD_BAR_WORDS 3456
#define XB_SPIN_CAP (1u << 18)

__device__ __forceinline__ unsigned xb_ld(unsigned* p)              { return __hip_atomic_load(p, __ATOMIC_RELAXED, __HIP_MEMORY_SCOPE_AGENT); }
__device__ __forceinline__ unsigned xb_add(unsigned* p, unsigned v) { return __hip_atomic_fetch_add(p, v, __ATOMIC_RELAXED, __HIP_MEMORY_SCOPE_AGENT); }
__device__ __forceinline__ unsigned xb_xcc_id() { return (unsigned)__builtin_amdgcn_s_getreg((3 << 11) | 20) & 0xFu; }
#define XB_SPIN(cond, bar) do { unsigned _sp = 0; while (cond) { __builtin_amdgcn_s_sleep(1); \
    if ((++_sp & 255u) == 0u) { if (xb_ld(&(bar)[XB_TMO])) break; if (_sp > XB_SPIN_CAP) { atomicAdd(&(bar)[XB_TMO], 1u); break; } } } } while (0)

struct XcdBarrier {
    unsigned* bar; unsigned x;
    volatile LAS unsigned* st;
};

__device__ __forceinline__ XcdBarrier xcd_barrier_post(unsigned* bar, volatile LAS unsigned* st, const int tid) {
    XcdBarrier b; b.bar = bar; b.x = xb_xcc_id(); b.st = st;
    if (tid == 0) (void)xb_add(&bar[XB_XCNT(b.x)], 1u);
    return b;
}
__device__ __forceinline__ void xcd_barrier_complete(unsigned* bar, unsigned x, unsigned& nloc, unsigned& nx) {
    const unsigned G = gridDim.x * gridDim.y * gridDim.z;
    unsigned sum, cnt, mine, sp = 0u;
    for (;;) {
        sum = 0u; cnt = 0u; mine = 0u;
#pragma unroll
        for (unsigned j = 0; j < 16; ++j) { const unsigned c = xb_ld(&bar[XB_XCNT(j)]); sum += c; cnt += (c > 0u) ? 1u : 0u; mine = (j == x) ? c : mine; }
        if (sum == G) break;
        __builtin_amdgcn_s_sleep(1);
        if ((++sp & 255u) == 0u) { if (xb_ld(&bar[XB_TMO])) break; if (sp > XB_SPIN_CAP) { atomicAdd(&bar[XB_TMO], 1u); break; } }
    }
    nloc = mine > 0u ? mine : 1u; nx = cnt > 0u ? cnt : 1u;
}

__device__ __forceinline__ void xcd_barrier(const XcdBarrier& b, const int tid) {
    asm volatile("s_waitcnt vmcnt(0)" ::: "memory");
    __syncthreads();
    if (tid == 0) {
        unsigned* bar = b.bar;
        __builtin_amdgcn_s_waitcnt(0);
        unsigned nloc = b.st[0], nx = b.st[1];
        if (nloc == 0u) { xcd_barrier_complete(bar, b.x, nloc, nx); b.st[0] = nloc; b.st[1] = nx; }
        const unsigned old = xb_add(&bar[XB_XSUB(b.x)], 1u);
        const unsigned gen = old / nloc;
        if (old + 1u == (gen + 1u) * nloc) {
            __builtin_amdgcn_fence(__ATOMIC_RELEASE, "agent");
            asm volatile("s_waitcnt vmcnt(0)" ::: "memory");
            const unsigned og = xb_add(&bar[XB_TOP], 1u);
            const unsigned tg = og / nx;
            if (og + 1u == (tg + 1u) * nx) xb_add(&bar[XB_TOPGEN], 1u);
            else XB_SPIN(xb_ld(&bar[XB_TOPGEN]) == tg, bar);
            __builtin_amdgcn_fence(__ATOMIC_ACQUIRE, "agent");
            xb_add(&bar[XB_XGEN(b.x)], 1u);
            asm volatile("s_waitcnt vmcnt(0)" ::: "memory");
        } else {
            XB_SPIN(xb_ld(&bar[XB_XGEN(b.x)]) == gen, bar);
            __builtin_amdgcn_fence(__ATOMIC_ACQUIRE, "agent");
            asm volatile("s_waitcnt vmcnt(0)" ::: "memory");
        }
    }
    __syncthreads();
}

constexpr int NB = 4, SEQ = 8192, DM = 1024, MTOK = NB * SEQ, DFF = 2816;
constexpr float EPS = 1e-6f, NEGF = -1e30f;
constexpr int NPHASE = 15;
constexpr int NWAVES = 8;
constexpr size_t MiB = 1u << 20;
constexpr size_t SZ_WGU = (size_t)5632 * 1024 * 2, SZ_WD = (size_t)1024 * 2816 * 2, SZ_WIN = (size_t)3840 * 1024 * 2;
constexpr size_t O_WGU1 = 0, O_WD1 = O_WGU1 + SZ_WGU, O_WGU2 = O_WD1 + SZ_WD, O_WD2 = O_WGU2 + SZ_WGU, O_WIN = O_WD2 + SZ_WD,
                 O_WPN = O_WIN + SZ_WIN, O_WPM = O_WPN + MiB, O_WOUT = O_WPM + MiB, O_WUQ = O_WOUT + 2 * MiB, O_WUKV = O_WUQ + 768 * 256 * 2,
                 O_CW1K = O_WUKV + 1024 * 128 * 2, O_CW1V = O_CW1K + MiB, O_WEND = O_CW1V + MiB;
static_assert(O_WEND <= 48 * MiB - 16384, "weights");
constexpr size_t O_CTL = 48 * MiB - 16384;
constexpr size_t O_A1 = 48 * MiB;
constexpr size_t O_IM2K = 48 * MiB, O_IM2V = 64 * MiB, O_CQN = 80 * MiB, O_CKVN = 96 * MiB, O_KR = 104 * MiB, O_HK = 106 * MiB, O_HV = 108 * MiB,
                 O_KC = 110 * MiB, O_VCT = 110 * MiB + 512 * 1024;
constexpr size_t O_ROPE = 111 * MiB;
constexpr size_t O_MG = 48 * MiB;
constexpr size_t O_H = 112 * MiB;
constexpr size_t O_Z1 = 112 * MiB, O_QN = 192 * MiB, O_YM = 224 * MiB, O_KM = 256 * MiB;
constexpr size_t O_X2B = 352 * MiB;
constexpr size_t O_F = 288 * MiB, O_GM = 288 * MiB;
constexpr size_t O_QM = 416 * MiB, O_VTM = 464 * MiB, O_VTS = 496 * MiB, O_VTW = 504 * MiB, O_END = 512 * MiB;
constexpr int Z1P = 1280;
constexpr int LDS_BYTES = 147456;
constexpr int L_KB = 0, KB_SZ = 13312, L_VB = 4 * KB_SZ, VB_SZ = 8704, L_IMP = L_VB + 4 * VB_SZ, IMP_P = 132, L_SELM = L_IMP + 64 * IMP_P * 4, L_WUN = L_SELM + 1024, L_ATT_END = L_WUN + 128;
static_assert(L_ATT_END <= 131072, "attention LDS");

__device__ __forceinline__ int mk_lane() { int l; asm volatile("v_mbcnt_lo_u32_b32 %0, -1, 0\n\tv_mbcnt_hi_u32_b32 %0, -1, %0" : "=v"(l)); return l; }
__device__ __forceinline__ void grid_barrier(unsigned* ctr, unsigned target, int tid) {
    asm volatile("s_waitcnt vmcnt(0)" ::: "memory");
    __syncthreads();
    if (tid == 0) {
        __builtin_amdgcn_fence(__ATOMIC_RELEASE, "agent");
        asm volatile("s_waitcnt vmcnt(0)" ::: "memory");
        __hip_atomic_fetch_add(ctr, 1u, __ATOMIC_RELAXED, __HIP_MEMORY_SCOPE_AGENT);
        while (__hip_atomic_load(ctr, __ATOMIC_RELAXED, __HIP_MEMORY_SCOPE_AGENT) < target) __builtin_amdgcn_s_sleep(2);
        __builtin_amdgcn_fence(__ATOMIC_ACQUIRE, "agent");
        asm volatile("s_waitcnt vmcnt(0)" ::: "memory");
    }
    __syncthreads();
}
__device__ __forceinline__ unsigned cvtpk(float lo, float hi) { f32x2_t v = {lo, hi}; bf16x2_t b = __builtin_convertvector(v, bf16x2_t); return __builtin_bit_cast(unsigned, b); }
__device__ __forceinline__ float bflo(unsigned w) { return __builtin_bit_cast(float, w << 16); }
__device__ __forceinline__ float bfhi(unsigned w) { return __builtin_bit_cast(float, w & 0xffff0000u); }
__device__ __forceinline__ float bf2f(bf16 b) { return __builtin_bit_cast(float, (unsigned)b << 16); }
__device__ __forceinline__ bf16 f2bf(float f) { return (bf16)(cvtpk(f, 0.f) & 0xffffu); }
__device__ __forceinline__ float wave_sum(float v) {
#pragma unroll
    for (int o = 1; o < 64; o <<= 1) v += __shfl_xor(v, o);
    return v;
}
__device__ __forceinline__ float sigmoidf(float x) { return __builtin_amdgcn_rcpf(1.f + __builtin_amdgcn_exp2f(-1.4426950408889634f * x)); }
__device__ __forceinline__ float gelu_tanh(float x) { const float u = 0.7978845608028654f * (x + 0.044715f * x * x * x); const float t = 1.f - 2.f * __builtin_amdgcn_rcpf(__builtin_amdgcn_exp2f(2.8853900817779268f * u) + 1.f); return 0.5f * x * (1.f + t); }
__device__ __forceinline__ void rope_cs(int pos, int j, float& c, float& s) {
    const float freq = __builtin_amdgcn_exp2f(-(float)j * 0.8304820237218406f);
    const float ang = (float)pos * freq;
    double rev = (double)ang * 0.15915494309189535; rev -= __builtin_rint(rev);
    const float fr = (float)rev;
    s = __builtin_amdgcn_sinf(fr); c = __builtin_amdgcn_cosf(fr);
}

struct MapPlain { __device__ __forceinline__ int col(int r) const { return r; } __device__ __forceinline__ int drow(int r) const { return r; } };
struct MapGU { int sel; __device__ __forceinline__ int col(int r) const { return r; } __device__ __forceinline__ int drow(int r) const { return (r >> 7) * 256 + sel * 128 + (r & 127); } };
struct MapWin { __device__ __forceinline__ int drow(int r) const { return r; } __device__ __forceinline__ int col(int r) const {
    int col;
    if (r < 1280) col = r; else if (r < 1536) col = 1304 + (r - 1280); else if (r < 1664) col = 1560 + (r - 1536); else if (r < 1696) col = 1688 + (r - 1664);
    else if (r < 1720) col = 1280 + (r - 1696); else if (r < 1792) col = -1; else col = 1720 + (r - 1792);
    return col; } };
struct MapUkv { __device__ __forceinline__ int drow(int r) const { return r; } __device__ __forceinline__ int col(int r) const {
    if (r < 512) return (r >> 6) * 128 + (r & 63); const int rr = r - 512; return (rr >> 6) * 128 + 64 + (rr & 63); } };
template <class Map> __device__ __forceinline__ void transpose_mat(const float* W, int N, const Map mp, int K, int Nvirt, bf16* WT, LAS float* scr, int gw, int NGW, int lane) {
    const int nblk = Nvirt / 32, nitems = (K / 64) * nblk;
    const int c4 = lane & 7, rr = lane >> 3;
    f32x4 ld[8];
    int it = gw;
#define TR_LOAD(itv) do { const int kb_ = (itv) / nblk, nb_ = (itv) % nblk; const int col_ = mp.col(32 * nb_ + 4 * c4); \
        _Pragma("unroll") for (int i = 0; i < 8; ++i) ld[i] = (col_ >= 0) ? *(const f32x4*)(W + (size_t)(64 * kb_ + 8 * i + rr) * N + col_) : (f32x4){0.f, 0.f, 0.f, 0.f}; } while (0)
    if (it < nitems) TR_LOAD(it);
    for (; it < nitems; it += NGW) {
        const int kb = it / nblk, nb = it % nblk, k0 = 64 * kb, n0 = 32 * nb;
#pragma unroll
        for (int i = 0; i < 8; ++i) { LAS float* d = scr + (8 * i + rr) * 33 + 4 * c4; d[0] = ld[i].x; d[1] = ld[i].y; d[2] = ld[i].z; d[3] = ld[i].w; }
        LDS_WAIT();
        if (it + NGW < nitems) TR_LOAD(it + NGW);
        const int c = lane & 7;
#pragma unroll
        for (int j = 0; j < 4; ++j) { const int n = (lane >> 3) + 8 * j; const LAS float* s = scr + (8 * c) * 33 + n;
            u32x4 o; o.x = cvtpk(s[0 * 33], s[1 * 33]); o.y = cvtpk(s[2 * 33], s[3 * 33]); o.z = cvtpk(s[4 * 33], s[5 * 33]); o.w = cvtpk(s[6 * 33], s[7 * 33]);
            *(u32x4*)(WT + (size_t)mp.drow(n0 + n) * K + k0 + 8 * c) = o; }
        LDS_WAIT();
    }
#undef TR_LOAD
}

__device__ __forceinline__ void load_gain(f32x4 (&g)[4], const float* gain, int lane) {
#pragma unroll
    for (int j = 0; j < 2; ++j) { g[2 * j] = *(const f32x4*)(gain + 512 * j + 8 * lane); g[2 * j + 1] = *(const f32x4*)(gain + 512 * j + 8 * lane + 4); }
}
__device__ __forceinline__ void unpack8(const u32x4 w, f32x4& a, f32x4& b) { a.x = bflo(w.x); a.y = bfhi(w.x); a.z = bflo(w.y); a.w = bfhi(w.y); b.x = bflo(w.z); b.y = bfhi(w.z); b.z = bflo(w.w); b.w = bfhi(w.w); }
__device__ __forceinline__ u32x4 pack8(const f32x4 a, const f32x4 b) { u32x4 w; w.x = cvtpk(a.x, a.y); w.y = cvtpk(a.z, a.w); w.z = cvtpk(b.x, b.y); w.w = cvtpk(b.z, b.w); return w; }
__device__ __forceinline__ void rms_row_to_bf16(const f32x4 (&v)[4], const f32x4 (&gain)[4], bf16* orow, int lane) {
    float ss = 0.f;
#pragma unroll
    for (int j = 0; j < 4; ++j) ss += (v[j].x * v[j].x + v[j].y * v[j].y) + (v[j].z * v[j].z + v[j].w * v[j].w);
    const float r = rsqrtf(wave_sum(ss) * (1.f / DM) + EPS);
#pragma unroll
    for (int j = 0; j < 2; ++j) *(u32x4*)(orow + 512 * j + 8 * lane) = pack8(v[2 * j] * r * gain[2 * j], v[2 * j + 1] * r * gain[2 * j + 1]);
}
template <bool BASE_BF16> __device__ __forceinline__ void rowop_load(int m, const bf16* Fb, const void* base, f32x4 (&v)[4], f32x4 (&bs)[4], int lane) {
#pragma unroll
    for (int j = 0; j < 2; ++j) { unpack8(*(const u32x4*)(Fb + (size_t)m * DM + 512 * j + 8 * lane), v[2 * j], v[2 * j + 1]);
        if (BASE_BF16) unpack8(*(const u32x4*)((const bf16*)base + (size_t)m * DM + 512 * j + 8 * lane), bs[2 * j], bs[2 * j + 1]);
        else { const float* bp = (const float*)base + (size_t)m * DM + 512 * j + 8 * lane; bs[2 * j] = *(const f32x4*)bp; bs[2 * j + 1] = *(const f32x4*)(bp + 4); } }
}
template <bool OUT_BF16, bool NEXT> __device__ __forceinline__ void rowop_finish(int m, f32x4 (&v)[4], const f32x4 (&bs)[4], float coef, const f32x4 (&gpost)[4], void* xout, const f32x4 (&gnext)[4], bf16* A1, int lane) {
    float ss = 0.f;
#pragma unroll
    for (int j = 0; j < 4; ++j) ss += (v[j].x * v[j].x + v[j].y * v[j].y) + (v[j].z * v[j].z + v[j].w * v[j].w);
    const float r = rsqrtf(wave_sum(ss) * (1.f / DM) + EPS) * coef;
#pragma unroll
    for (int j = 0; j < 4; ++j) v[j] = bs[j] + v[j] * r * gpost[j];
#pragma unroll
    for (int j = 0; j < 2; ++j) {
        if (OUT_BF16) *(u32x4*)((bf16*)xout + (size_t)m * DM + 512 * j + 8 * lane) = pack8(v[2 * j], v[2 * j + 1]);
        else { float* op = (float*)xout + (size_t)m * DM + 512 * j + 8 * lane; *(f32x4*)op = v[2 * j]; *(f32x4*)(op + 4) = v[2 * j + 1]; } }
    if (NEXT) rms_row_to_bf16(v, gnext, A1 + (size_t)m * DM, lane);
}
template <bool BASE_BF16, bool OUT_BF16, bool NEXT> __device__ __forceinline__ void rowop(const bf16* Fb, const void* base, float coef, const float* gpost_p, void* xout, const float* gnext_p, bf16* A1, int gw, int NGW, int lane) {
    f32x4 gpost[4], gnext[4];
    load_gain(gpost, gpost_p, lane); if (NEXT) load_gain(gnext, gnext_p, lane); else load_gain(gnext, gpost_p, lane);
    for (int m = gw; m < MTOK; m += 2 * NGW) {
        const int m2 = m + NGW; const bool two = m2 < MTOK;
        f32x4 vA[4], bA[4], vB[4], bB[4];
        rowop_load<BASE_BF16>(m, Fb, base, vA, bA, lane);
        if (two) rowop_load<BASE_BF16>(m2, Fb, base, vB, bB, lane);
        rowop_finish<OUT_BF16, NEXT>(m, vA, bA, coef, gpost, xout, gnext, A1, lane);
        if (two) rowop_finish<OUT_BF16, NEXT>(m2, vB, bB, coef, gpost, xout, gnext, A1, lane);
    }
}

#define EPI_ROW(ai, m) ((size_t)u.pm * 256 + (ai) * 128 + wr * 64 + (m) * 16 + fr)
#define EPI_CIN(bj, n) ((bj) * 128 + wc * 32 + (n) * 16 + fq * 4)
#define EPI_C8(bj) ((bj) * 128 + wc * 32 + fq * 8)
struct EpiSwiglu { static constexpr bool PERM = true, AFTER_DRAIN = false; bf16* H;
    __device__ __forceinline__ void operator()(const f32x4 (&acc)[2][2][4][2], const Unit& u, int wr, int wc, int fr, int fq) const {
#pragma unroll
        for (int ai = 0; ai < 2; ++ai)
#pragma unroll
            for (int m = 0; m < 4; ++m) { bf16* rp = H + EPI_ROW(ai, m) * DFF + u.pn * 128 + wc * 32 + fq * 8; float v[8];
#pragma unroll
                for (int n = 0; n < 2; ++n) { const f32x4 g = acc[ai][0][m][n], up = acc[ai][1][m][n];
#pragma unroll
                    for (int e = 0; e < 4; ++e) v[4 * n + e] = g[e] * __builtin_amdgcn_rcpf(1.f + __builtin_amdgcn_exp2f(-1.4426950408889634f * g[e])) * up[e]; }
                u32x4 w; w.x = cvtpk(v[0], v[1]); w.y = cvtpk(v[2], v[3]); w.z = cvtpk(v[4], v[5]); w.w = cvtpk(v[6], v[7]); *(u32x4*)rp = w; }
    }
};
struct EpiF32 { static constexpr bool PERM = true, AFTER_DRAIN = false; bf16* Fb; int ldc;
    __device__ __forceinline__ void operator()(const f32x4 (&acc)[2][2][4][2], const Unit& u, int wr, int wc, int fr, int fq) const {
#pragma unroll
        for (int ai = 0; ai < 2; ++ai)
#pragma unroll
            for (int m = 0; m < 4; ++m) { bf16* rp = Fb + EPI_ROW(ai, m) * ldc + u.pn * 256;
#pragma unroll
                for (int bj = 0; bj < 2; ++bj) { const f32x4 v0 = acc[ai][bj][m][0], v1 = acc[ai][bj][m][1];
                    u32x4 w; w.x = cvtpk(v0[0], v0[1]); w.y = cvtpk(v0[2], v0[3]); w.z = cvtpk(v1[0], v1[1]); w.w = cvtpk(v1[2], v1[3]); *(u32x4*)(rp + EPI_C8(bj)) = w; } }
    }
};
struct EpiWin { static constexpr bool PERM = true, AFTER_DRAIN = false; bf16* QN; bf16* Z1; bf16* GM; bf16* VTS; bf16* VTW;
    __device__ __forceinline__ void operator()(const f32x4 (&acc)[2][2][4][2], const Unit& u, int wr, int wc, int fr, int fq) const {
        const int pn = u.pn;
#pragma unroll
        for (int ai = 0; ai < 2; ++ai)
#pragma unroll
            for (int m = 0; m < 4; ++m) { const size_t row = EPI_ROW(ai, m);
#pragma unroll
                for (int bj = 0; bj < 2; ++bj) { const int c8 = EPI_C8(bj); f32x4 v0 = acc[ai][bj][m][0], v1 = acc[ai][bj][m][1];
                    if ((pn == 3 || pn == 4) && bj == 1) {
                        bf16* vt = (pn == 3) ? VTS : VTW; const int b = (int)(row >> 13), s = (int)(row & 8191), cv = c8 - 128;
#pragma unroll
                        for (int e = 0; e < 4; ++e) { vt[((size_t)(b * 128 + cv + e)) * SEQ + s] = f2bf(v0[e]); vt[((size_t)(b * 128 + cv + 4 + e)) * SEQ + s] = f2bf(v1[e]); }
                    } else {
                        bf16* dst;
                        if (pn < 2) { dst = QN + row * 512 + pn * 256 + c8; v0 = v0 * 0.18033688011112042f; v1 = v1 * 0.18033688011112042f; }
                        else if (pn < 7) dst = Z1 + row * Z1P + (pn - 2) * 256 + c8;
                        else dst = nullptr;
                        if (pn < 7) { u32x4 w; w.x = cvtpk(v0[0], v0[1]); w.y = cvtpk(v0[2], v0[3]); w.z = cvtpk(v1[0], v1[1]); w.w = cvtpk(v1[2], v1[3]); *(u32x4*)dst = w; }
                        else {
                            unsigned lo = 0u, hi2 = 0u;
                            lo = __builtin_amdgcn_cvt_pk_u8_f32(sigmoidf(v0[0]) * 255.f, 0, lo); lo = __builtin_amdgcn_cvt_pk_u8_f32(sigmoidf(v0[1]) * 255.f, 1, lo);
                            lo = __builtin_amdgcn_cvt_pk_u8_f32(sigmoidf(v0[2]) * 255.f, 2, lo); lo = __builtin_amdgcn_cvt_pk_u8_f32(sigmoidf(v0[3]) * 255.f, 3, lo);
                            hi2 = __builtin_amdgcn_cvt_pk_u8_f32(sigmoidf(v1[0]) * 255.f, 0, hi2); hi2 = __builtin_amdgcn_cvt_pk_u8_f32(sigmoidf(v1[1]) * 255.f, 1, hi2);
                            hi2 = __builtin_amdgcn_cvt_pk_u8_f32(sigmoidf(v1[2]) * 255.f, 2, hi2); hi2 = __builtin_amdgcn_cvt_pk_u8_f32(sigmoidf(v1[3]) * 255.f, 3, hi2);
                            u32x2 w; w.x = lo; w.y = hi2; *(u32x2*)((unsigned char*)GM + row * 2048 + (pn - 7) * 256 + c8) = w; }
                    } } }
    }
};
struct EpiGelu { static constexpr bool PERM = false, AFTER_DRAIN = false; bf16* O; int ldc;
    __device__ __forceinline__ void operator()(const f32x4 (&acc)[2][2][4][2], const Unit& u, int wr, int wc, int fr, int fq) const {
#pragma unroll
        for (int ai = 0; ai < 2; ++ai)
#pragma unroll
            for (int m = 0; m < 4; ++m) { bf16* rp = O + EPI_ROW(ai, m) * ldc + u.pn * 256;
#pragma unroll
                for (int bj = 0; bj < 2; ++bj)
#pragma unroll
                    for (int n = 0; n < 2; ++n) { const f32x4 v = acc[ai][bj][m][n];
                        u32x2 w; w.x = cvtpk(gelu_tanh(v[0]), gelu_tanh(v[1])); w.y = cvtpk(gelu_tanh(v[2]), gelu_tanh(v[3])); *(u32x2*)(rp + EPI_CIN(bj, n)) = w; } }
    }
};
struct EpiQup { static constexpr bool PERM = false, AFTER_DRAIN = false; bf16* QM;
    __device__ __forceinline__ void operator()(const f32x4 (&acc)[2][2][4][2], const Unit& u, int wr, int wc, int fr, int fq) const {
        const float sc = 0.14724445614104196f;
#pragma unroll
        for (int ai = 0; ai < 2; ++ai)
#pragma unroll
            for (int m = 0; m < 4; ++m) { bf16* rp = QM + EPI_ROW(ai, m) * 768 + u.pn * 256;
#pragma unroll
                for (int bj = 0; bj < 2; ++bj)
#pragma unroll
                    for (int n = 0; n < 2; ++n) { const f32x4 v = acc[ai][bj][m][n] * sc;
                        u32x2 w; w.x = cvtpk(v[0], v[1]); w.y = cvtpk(v[2], v[3]); *(u32x2*)(rp + EPI_CIN(bj, n)) = w; } }
    }
};
struct EpiKVup { static constexpr bool PERM = false, AFTER_DRAIN = false; bf16* KM; bf16* VTM;
    __device__ __forceinline__ void operator()(const f32x4 (&acc)[2][2][4][2], const Unit& u, int wr, int wc, int fr, int fq) const {
        const int pn = u.pn;
#pragma unroll
        for (int ai = 0; ai < 2; ++ai)
#pragma unroll
            for (int m = 0; m < 4; ++m) { const size_t row = EPI_ROW(ai, m);
#pragma unroll
                for (int bj = 0; bj < 2; ++bj)
#pragma unroll
                    for (int n = 0; n < 2; ++n) { const int cin = EPI_CIN(bj, n); const f32x4 v = acc[ai][bj][m][n];
                        if (pn < 2) { u32x2 w; w.x = cvtpk(v[0], v[1]); w.y = cvtpk(v[2], v[3]); *(u32x2*)(KM + row * 512 + pn * 256 + cin) = w; }
                        else { const int b = (int)(row >> 13), s = (int)(row & 8191), cv = (pn - 2) * 256 + cin;
#pragma unroll
                            for (int e = 0; e < 4; ++e) VTM[((size_t)(b * 512 + cv + e)) * SEQ + s] = f2bf(v[e]); } } }
    }
};
template <bool SECOND> struct EpiProj { static constexpr bool PERM = true, AFTER_DRAIN = false; const bf16* GM; bf16* MG;
    __device__ __forceinline__ void operator()(const f32x4 (&acc)[2][2][4][2], const Unit& u, int wr, int wc, int fr, int fq) const {
#pragma unroll
        for (int ai = 0; ai < 2; ++ai) {
            u32x2 gwv[4][2]; u32x4 pwv[4][2];
#pragma unroll
            for (int m = 0; m < 4; ++m) { const size_t row = EPI_ROW(ai, m);
#pragma unroll
                for (int bj = 0; bj < 2; ++bj) { const int col = u.pn * 256 + EPI_C8(bj);
                    gwv[m][bj] = *(const u32x2*)((const unsigned char*)GM + row * 2048 + (SECOND ? 1024 : 0) + col);
                    if (SECOND) pwv[m][bj] = *(const u32x4*)(MG + row * DM + col); } }
#pragma unroll
            for (int m = 0; m < 4; ++m) { const size_t row = EPI_ROW(ai, m);
#pragma unroll
                for (int bj = 0; bj < 2; ++bj) { const int col = u.pn * 256 + EPI_C8(bj); const f32x4 v0 = acc[ai][bj][m][0], v1 = acc[ai][bj][m][1];
                    const u32x2 gw = gwv[m][bj]; const float q8 = 1.f / 255.f;
                    float o0 = (float)(gw.x & 255u) * q8 * v0[0], o1 = (float)((gw.x >> 8) & 255u) * q8 * v0[1], o2 = (float)((gw.x >> 16) & 255u) * q8 * v0[2], o3 = (float)(gw.x >> 24) * q8 * v0[3];
                    float o4 = (float)(gw.y & 255u) * q8 * v1[0], o5 = (float)((gw.y >> 8) & 255u) * q8 * v1[1], o6 = (float)((gw.y >> 16) & 255u) * q8 * v1[2], o7 = (float)(gw.y >> 24) * q8 * v1[3];
                    if (SECOND) { const u32x4 pw = pwv[m][bj]; o0 += bflo(pw.x); o1 += bfhi(pw.x); o2 += bflo(pw.y); o3 += bfhi(pw.y); o4 += bflo(pw.z); o5 += bfhi(pw.z); o6 += bflo(pw.w); o7 += bfhi(pw.w); }
                    u32x4 w; w.x = cvtpk(o0, o1); w.y = cvtpk(o2, o3); w.z = cvtpk(o4, o5); w.w = cvtpk(o6, o7); *(u32x4*)(MG + row * DM + col) = w; } }
        }
    }
};

__device__ __forceinline__ int crow(int r, int hi) { return (r & 3) + 8 * (r >> 2) + 4 * hi; }
template <int ND0> __device__ __forceinline__ f32x16 qk_sub(const LAS char* Kt, int pitch, int sub, const bf16x8* qr, const f32x16& cin, int r32, int hi) {
    f32x16 acc = cin;
    const LAS char* kb = Kt + (sub * 32 + r32) * pitch + hi * 16;
#pragma unroll
    for (int d0 = 0; d0 < ND0; ++d0) { const bf16x8 kf = *(const LAS bf16x8*)(kb + d0 * 32); acc = __builtin_amdgcn_mfma_f32_32x32x16_bf16(kf, qr[d0], acc, 0, 0, 0); }
    return acc;
}
__device__ __forceinline__ void fill16(f32x16& a, float v) {
#pragma unroll
    for (int r = 0; r < 16; ++r) a[r] = v;
}
__device__ __forceinline__ void pv_sub(f32x16& o0, f32x16& o1, const LAS char* Vt, int sub, const f32x16& p, int r32, int hi) {
#pragma unroll
    for (int j = 0; j < 2; ++j) {
        u32x4 pw; pw.x = cvtpk(p[8 * j + 0], p[8 * j + 1]); pw.y = cvtpk(p[8 * j + 2], p[8 * j + 3]); pw.z = cvtpk(p[8 * j + 4], p[8 * j + 5]); pw.w = cvtpk(p[8 * j + 6], p[8 * j + 7]);
        const bf16x8 pb = __builtin_bit_cast(bf16x8, pw);
#pragma unroll
        for (int dblk = 0; dblk < 2; ++dblk) {
            const LAS char* vp = Vt + (32 * dblk + r32) * 136 + (32 * sub + 16 * j + 4 * hi) * 2;
            const u32x2 lo = *(const LAS u32x2*)vp, h2 = *(const LAS u32x2*)(vp + 16);
            u32x4 vw; vw.x = lo.x; vw.y = lo.y; vw.z = h2.x; vw.w = h2.y;
            const bf16x8 vf = __builtin_bit_cast(bf16x8, vw);
            if (dblk == 0) o0 = __builtin_amdgcn_mfma_f32_32x32x16_bf16(vf, pb, o0, 0, 0, 0); else o1 = __builtin_amdgcn_mfma_f32_32x32x16_bf16(vf, pb, o1, 0, 0, 0);
        }
    }
}
template <int ND0> __device__ __forceinline__ void qk_pair(f32x16& s0, f32x16& s1, const LAS char* Kt, int pitch, const bf16x8* qr, const f32x16& cin, int r32, int hi) {
    bf16x8 kf[2 * ND0];
    const LAS char* kb = Kt + r32 * pitch + hi * 16;
#pragma unroll
    for (int i = 0; i < 2 * ND0; ++i) kf[i] = *(const LAS bf16x8*)(kb + (i / ND0) * 32 * pitch + (i % ND0) * 32);
#pragma unroll
    for (int g = 0; g < ND0; ++g) {
        s0 = __builtin_amdgcn_mfma_f32_32x32x16_bf16(kf[g], qr[g], g == 0 ? cin : s0, 0, 0, 0);
        s1 = __builtin_amdgcn_mfma_f32_32x32x16_bf16(kf[ND0 + g], qr[g], g == 0 ? cin : s1, 0, 0, 0);
    }
}
__device__ __forceinline__ void pv_tile(f32x16& o0, f32x16& o1, const LAS char* Vt, const f32x16& p0, const f32x16& p1, int r32, int hi) {
    bf16x8 vf[8];
#pragma unroll
    for (int i = 0; i < 8; ++i) { const int sub = i >> 2, j = (i >> 1) & 1, dblk = i & 1;
        const LAS char* vp = Vt + (32 * dblk + r32) * 136 + (32 * sub + 16 * j + 4 * hi) * 2;
        const u32x2 lo = *(const LAS u32x2*)vp, h2 = *(const LAS u32x2*)(vp + 16);
        u32x4 vw; vw.x = lo.x; vw.y = lo.y; vw.z = h2.x; vw.w = h2.y; vf[i] = __builtin_bit_cast(bf16x8, vw); }
#pragma unroll
    for (int i = 0; i < 4; ++i) { const int sub = i >> 1, j = i & 1;
        u32x4 pw;
        if (sub == 0) { pw.x = cvtpk(p0[8 * j + 0], p0[8 * j + 1]); pw.y = cvtpk(p0[8 * j + 2], p0[8 * j + 3]); pw.z = cvtpk(p0[8 * j + 4], p0[8 * j + 5]); pw.w = cvtpk(p0[8 * j + 6], p0[8 * j + 7]); }
        else { pw.x = cvtpk(p1[8 * j + 0], p1[8 * j + 1]); pw.y = cvtpk(p1[8 * j + 2], p1[8 * j + 3]); pw.z = cvtpk(p1[8 * j + 4], p1[8 * j + 5]); pw.w = cvtpk(p1[8 * j + 6], p1[8 * j + 7]); }
        const bf16x8 pb = __builtin_bit_cast(bf16x8, pw);
        o0 = __builtin_amdgcn_mfma_f32_32x32x16_bf16(vf[2 * i], pb, o0, 0, 0, 0);
        o1 = __builtin_amdgcn_mfma_f32_32x32x16_bf16(vf[2 * i + 1], pb, o1, 0, 0, 0);
    }
}
__device__ __forceinline__ float max3f(float a, float b, float c) { float r; asm("v_max3_f32 %0, %1, %2, %3" : "=v"(r) : "v"(a), "v"(b), "v"(c)); return r; }
__device__ __forceinline__ float rowmax32(const f32x16& s0, const f32x16& s1) {
    float a = max3f(s0[0], s0[1], s1[0]), b = max3f(s0[2], s0[3], s1[1]); a = max3f(a, s1[2], s1[3]);
#pragma unroll
    for (int r = 4; r < 16; r += 4) { a = max3f(a, s0[r], s0[r + 1]); b = max3f(b, s0[r + 2], s0[r + 3]); a = max3f(a, s1[r], s1[r + 1]); b = max3f(b, s1[r + 2], s1[r + 3]); }
    float m; asm("v_max_f32_e32 %0, %1, %2" : "=v"(m) : "v"(a), "v"(b));
    const float o = __shfl_xor(m, 32); float r; asm("v_max_f32_e32 %0, %1, %2" : "=v"(r) : "v"(m), "v"(o)); return r;
}
__device__ __forceinline__ bool sm_tile(f32x16& s0, f32x16& s1, float& mref, float& thr, float& l, f32x16& o0, f32x16& o1) {
    const float mx = rowmax32(s0, s1);
    bool ch = false;
    if (__any(mx > thr)) {
        const bool up = mx > thr; const float d = up ? mx : 0.f; const float alpha = (thr > 0.f) ? __builtin_amdgcn_exp2f(-d) : 1.f;
        mref += d; thr = up ? 8.f : thr; l *= alpha;
#pragma unroll
        for (int r = 0; r < 16; ++r) { o0[r] *= alpha; o1[r] *= alpha; s0[r] -= d; s1[r] -= d; }
        ch = true;
    }
#pragma unroll
    for (int r = 0; r < 16; ++r) { s0[r] = __builtin_amdgcn_exp2f(s0[r]); s1[r] = __builtin_amdgcn_exp2f(s1[r]); }
    float a0 = s0[0] + s1[0], a1 = s0[1] + s1[1], a2 = s0[2] + s1[2], a3 = s0[3] + s1[3];
#pragma unroll
    for (int r = 4; r < 16; r += 4) { a0 += s0[r] + s1[r]; a1 += s0[r + 1] + s1[r + 1]; a2 += s0[r + 2] + s1[r + 2]; a3 += s0[r + 3] + s1[r + 3]; }
    l += (a0 + a1) + (a2 + a3);
    return ch;
}
__device__ __forceinline__ bool sm_max(f32x16& s0, f32x16& s1, float& mref, float& thr, float& l, f32x16& o0, f32x16& o1) {
    const float mx = rowmax32(s0, s1);
    if (__any(mx > thr)) {
        const bool up = mx > thr; const float d = up ? mx : 0.f; const float alpha = (thr > 0.f) ? __builtin_amdgcn_exp2f(-d) : 1.f;
        mref += d; thr = up ? 8.f : thr; l *= alpha;
#pragma unroll
        for (int r = 0; r < 16; ++r) { o0[r] *= alpha; o1[r] *= alpha; s0[r] -= d; s1[r] -= d; }
        return true;
    }
    return false;
}
__device__ __forceinline__ void sm_exp(f32x16& s0, f32x16& s1, float& l) {
#pragma unroll
    for (int r = 0; r < 16; ++r) { s0[r] = __builtin_amdgcn_exp2f(s0[r]); s1[r] = __builtin_amdgcn_exp2f(s1[r]); }
    float a0 = s0[0] + s1[0], a1 = s0[1] + s1[1], a2 = s0[2] + s1[2], a3 = s0[3] + s1[3];
#pragma unroll
    for (int r = 4; r < 16; r += 4) { a0 += s0[r] + s1[r]; a1 += s0[r + 1] + s1[r + 1]; a2 += s0[r + 2] + s1[r + 2]; a3 += s0[r + 3] + s1[r + 3]; }
    l += (a0 + a1) + (a2 + a3);
}
template <int ND0> __device__ __forceinline__ void tile_pipe(f32x16& s0, f32x16& s1, f32x16& n0, f32x16& n1, float& l, const LAS char* Kn, int pitch,
                                                             const bf16x8* qr, const f32x16& cinit, int r32, int hi) {
    constexpr int NG = 2 * ND0, EPG = (32 + NG - 1) / NG;
    bf16x8 kf[NG];
    const LAS char* kb = Kn + r32 * pitch + hi * 16;
#pragma unroll
    for (int i = 0; i < NG; ++i) kf[i] = *(const LAS bf16x8*)(kb + (i / ND0) * 32 * pitch + (i % ND0) * 32);
    float sum = 0.f;
    __builtin_amdgcn_sched_barrier(0);
#pragma unroll
    for (int g = 0; g < NG; ++g) {
        if (g == 0) n0 = __builtin_amdgcn_mfma_f32_32x32x16_bf16(kf[g], qr[g], cinit, 0, 0, 0);
        else if (g < ND0) n0 = __builtin_amdgcn_mfma_f32_32x32x16_bf16(kf[g], qr[g], n0, 0, 0, 0);
        else if (g == ND0) n1 = __builtin_amdgcn_mfma_f32_32x32x16_bf16(kf[g], qr[g - ND0], cinit, 0, 0, 0);
        else n1 = __builtin_amdgcn_mfma_f32_32x32x16_bf16(kf[g], qr[g - ND0], n1, 0, 0, 0);
#pragma unroll
        for (int e = g * EPG; e < (g + 1) * EPG && e < 32; ++e) {
            if (e < 16) s0[e] = __builtin_amdgcn_exp2f(s0[e]); else s1[e - 16] = __builtin_amdgcn_exp2f(s1[e - 16]);
        }
        __builtin_amdgcn_sched_barrier(0);
    }
    {
        float a0 = s0[0] + s1[0], a1 = s0[1] + s1[1], a2 = s0[2] + s1[2], a3 = s0[3] + s1[3];
#pragma unroll
        for (int r = 4; r < 16; r += 4) { a0 += s0[r] + s1[r]; a1 += s0[r + 1] + s1[r + 1]; a2 += s0[r + 2] + s1[r + 2]; a3 += s0[r + 3] + s1[r + 3]; }
        sum = (a0 + a1) + (a2 + a3);
    }
    l += sum;
}
__device__ __forceinline__ void zero16(f32x16& a) {
#pragma unroll
    for (int r = 0; r < 16; ++r) a[r] = 0.f;
}

__device__ __forceinline__ void store_o_row(bf16* rowbase  , const f32x16& o0, const f32x16& o1, float sc, int hi) {
    u32x2 g[8];
#pragma unroll
    for (int k = 0; k < 8; ++k) { const int a = k & 3;
        if (k < 4) { g[k].x = cvtpk(o0[4 * a] * sc, o0[4 * a + 1] * sc); g[k].y = cvtpk(o0[4 * a + 2] * sc, o0[4 * a + 3] * sc); }
        else { g[k].x = cvtpk(o1[4 * a] * sc, o1[4 * a + 1] * sc); g[k].y = cvtpk(o1[4 * a + 2] * sc, o1[4 * a + 3] * sc); } }
#pragma unroll
    for (int k = 0; k < 8; k += 2) {
        const auto rx = __builtin_amdgcn_permlane32_swap(g[k].x, g[k + 1].x, false, false);
        const auto ry = __builtin_amdgcn_permlane32_swap(g[k].y, g[k + 1].y, false, false);
        u32x4 w; w.x = rx[0]; w.y = ry[0]; w.z = rx[1]; w.w = ry[1];
        *(u32x4*)(rowbase + 8 * k + 8 * hi) = w;
    }
}
__device__ __forceinline__ void mla_unit(int b, int h, int qb, const bf16* QM, const bf16* KM, const bf16* KR, const bf16* VTM, bf16* YM, const float* RT, LAS char* lds, const int wid, const int lane_unused) {
    const int lane = mk_lane();
    const int tid = wid * 64 + lane, r32 = lane & 31, hi = lane >> 5;
    const int q0 = qb * 256 + wid * 32, t = q0 + r32;
    const size_t rowq = (size_t)b * SEQ + t;
    bf16x8 qr[6];
#pragma unroll
    for (int d0 = 0; d0 < 6; ++d0) qr[d0] = *(const bf16x8*)(QM + rowq * 768 + h * 96 + d0 * 16 + hi * 8);
    {
        u32x4 a = __builtin_bit_cast(u32x4, qr[4]), bb = __builtin_bit_cast(u32x4, qr[5]);
        float x1[8] = {bflo(a.x), bfhi(a.x), bflo(a.y), bfhi(a.y), bflo(a.z), bfhi(a.z), bflo(a.w), bfhi(a.w)};
        float x2[8] = {bflo(bb.x), bfhi(bb.x), bflo(bb.y), bfhi(bb.y), bflo(bb.z), bfhi(bb.z), bflo(bb.w), bfhi(bb.w)};
        const unsigned ro = (unsigned)(t * 32 + 16 * hi);
#pragma unroll
        for (int e2 = 0; e2 < 4; ++e2) { const f32x4 cs4 = *(const f32x4*)(RT + (ro + 4u * (unsigned)e2));
            { const int e = 2 * e2; const float y1 = x1[e] * cs4.x - x2[e] * cs4.y, y2 = x1[e] * cs4.y + x2[e] * cs4.x; x1[e] = y1; x2[e] = y2; }
            { const int e = 2 * e2 + 1; const float y1 = x1[e] * cs4.z - x2[e] * cs4.w, y2 = x1[e] * cs4.w + x2[e] * cs4.z; x1[e] = y1; x2[e] = y2; } }
        a.x = cvtpk(x1[0], x1[1]); a.y = cvtpk(x1[2], x1[3]); a.z = cvtpk(x1[4], x1[5]); a.w = cvtpk(x1[6], x1[7]);
        bb.x = cvtpk(x2[0], x2[1]); bb.y = cvtpk(x2[2], x2[3]); bb.z = cvtpk(x2[4], x2[5]); bb.w = cvtpk(x2[6], x2[7]);
        qr[4] = __builtin_bit_cast(bf16x8, a); qr[5] = __builtin_bit_cast(bf16x8, bb);
    }
    float mref = 0.f, thr = -1e29f, l = 0.f; f32x16 o0, o1, cinit; zero16(o0); zero16(o1); zero16(cinit);
    const int NT = (qb + 1) * 4;
    const bf16* kbu = KM + (size_t)b * SEQ * 512 + h * 64; const bf16* rbu = KR + (size_t)b * SEQ * 32; const bf16* vbu = VTM + (size_t)(b * 8 + h) * 64 * SEQ;
    const unsigned koff = (unsigned)((tid >> 3) * 512 + (tid & 7) * 8), roff = (unsigned)(((tid & 255) >> 2) * 32 + (tid & 3) * 8), voff = (unsigned)((tid >> 3) * SEQ + (tid & 7) * 8);
    const int kdst = (tid >> 3) * 208 + (tid & 7) * 16, rdst = ((tid & 255) >> 2) * 208 + 128 + (tid & 3) * 16, vdst = (tid >> 3) * 136 + (tid & 7) * 16;
    u32x4 skA, srA, svA, skB, srB, svB;
#define MLA_LOAD(it, S) do { sk##S = *(const u32x4*)(kbu + (size_t)(it) * 64 * 512 + koff); if (tid < 256) sr##S = *(const u32x4*)(rbu + (size_t)(it) * 64 * 32 + roff); sv##S = *(const u32x4*)(vbu + (size_t)(it) * 64 + voff); } while (0)
#define MLA_STORE(buf, S) do { *(LAS u32x4*)(lds + L_KB + (buf) * KB_SZ + kdst) = sk##S; if (tid < 256) *(LAS u32x4*)(lds + L_KB + (buf) * KB_SZ + rdst) = sr##S; \
        LAS char* vp_ = lds + L_VB + (buf) * VB_SZ + vdst; u32x2 a_; a_.x = sv##S.x; a_.y = sv##S.y; *(LAS u32x2*)vp_ = a_; a_.x = sv##S.z; a_.y = sv##S.w; *(LAS u32x2*)(vp_ + 8) = a_; } while (0)
    srA = (u32x4){0u, 0u, 0u, 0u}; srB = srA;
    MLA_LOAD(0, A); MLA_LOAD(1, B); MLA_STORE(0, A); MLA_STORE(1, B);
    MLA_LOAD(2, A); MLA_LOAD(3, B); MLA_STORE(2, A);
    __syncthreads();
    const int wlast = (q0 + 31) >> 6;
    f32x16 sa0 = qk_sub<6>(lds + L_KB, 208, 0, qr, cinit, r32, hi), sa1 = qk_sub<6>(lds + L_KB, 208, 1, qr, cinit, r32, hi), sb0, sb1;
    const bool grpB = wid >= 4;
    if (grpB) __syncthreads();
#define MLA_ITER(it, LD, ST, C0, C1, N0, N1) do { \
        if ((it) + 4 < NT) MLA_LOAD((it) + 4, LD); \
        if ((it) <= wlast) { const int kv0 = (it) * 64; \
            if (kv0 + 63 > q0) { \
                _Pragma("unroll") for (int r = 0; r < 16; ++r) { const int kp = kv0 + crow(r, hi); if (kp > t) C0[r] = NEGF; if (kp + 32 > t) C1[r] = NEGF; } \
            } \
            if (sm_max(C0, C1, mref, thr, l, o0, o1)) fill16(cinit, -mref); \
            tile_pipe<6>(C0, C1, N0, N1, l, lds + L_KB + (((it) + 1) & 3) * KB_SZ, 208, qr, cinit, r32, hi); } \
        __syncthreads(); \
        if ((it) <= wlast) pv_tile(o0, o1, lds + L_VB + ((it) & 3) * VB_SZ, C0, C1, r32, hi); \
        if ((it) + 3 < NT) MLA_STORE(((it) + 3) & 3, ST); \
        __syncthreads(); } while (0)
    for (int it = 0; it < NT; it += 2) { MLA_ITER(it, A, B, sa0, sa1, sb0, sb1); MLA_ITER(it + 1, B, A, sb0, sb1, sa0, sa1); }
    if (!grpB) __syncthreads();
#undef MLA_ITER
#undef MLA_LOAD
#undef MLA_STORE
    l += __shfl_xor(l, 32);
    const float inv = 1.f / l;
    store_o_row(YM + rowq * 512 + h * 64, o0, o1, inv, hi);
}

__device__ __forceinline__ int next_set(unsigned long long u0, unsigned long long u1, int from) {
    if (from < 64) { const unsigned long long x = u0 >> from; if (x) return from + __builtin_ctzll(x); from = 64; }
    if (from < 128) { const unsigned long long x = u1 >> (from - 64); if (x) return from + __builtin_ctzll(x); }
    return 128;
}
__device__ __forceinline__ void nsa_unit(int b, int g, int tile, const bf16* QN  , bf16* YN  , const bf16* Z1, const bf16* KC, const bf16* VCT, const bf16* VTS, const bf16* VTW, LAS char* lds, const int wid, const int lane_unused) {
    const int lane = mk_lane();
    const int tid = wid * 64 + lane, r32 = lane & 31, hi = lane >> 5;
    const int t0 = tile * 64, cur = tile, tl = r32 >> 2, hh = r32 & 3, head = 4 * g + hh, tok = 8 * wid + tl, t = t0 + tok, bg = b * 2 + g;
    const size_t rowq = (size_t)b * SEQ + t;
    bf16x8 qr[4];
#pragma unroll
    for (int d0 = 0; d0 < 4; ++d0) qr[d0] = *(const bf16x8*)(QN + rowq * 512 + head * 64 + d0 * 16 + hi * 8);
    const float slope = __builtin_amdgcn_exp2f(-(float)(head + 1)) * 1.4426950408889634f;
    f32x16 czero; zero16(czero);
    const bf16* gz = Z1 + rowq * Z1P + 1184 + head * 3;
    const float g0 = sigmoidf(bf2f(gz[0])), g1 = sigmoidf(bf2f(gz[1])), g2 = sigmoidf(bf2f(gz[2]));
    LAS float* imp = (LAS float*)(lds + L_IMP);
    LAS unsigned* selm = (LAS unsigned*)(lds + L_SELM);
    LAS unsigned* wun = (LAS unsigned*)(lds + L_WUN);
    for (int i = lane; i < 8 * IMP_P; i += 64) imp[8 * wid * IMP_P + i] = 0.f;
    f32x16 out0, out1; zero16(out0); zero16(out1);
    const int krow = tid >> 3, kch = tid & 7;
    const int kdst = krow * 144 + kch * 16, vdst = krow * 136 + kch * 16;
    u32x4 sk, sv;
#define NSA_STORE(buf, withv) do { *(LAS u32x4*)(lds + L_KB + (buf) * KB_SZ + kdst) = sk; if (withv) { LAS char* vp_ = lds + L_VB + (buf) * VB_SZ + vdst; u32x2 a_; a_.x = sv.x; a_.y = sv.y; *(LAS u32x2*)vp_ = a_; a_.x = sv.z; a_.y = sv.w; *(LAS u32x2*)(vp_ + 8) = a_; } } while (0)
    u32x4 nk, nv;
#define NSA_STORE_N(buf) do { *(LAS u32x4*)(lds + L_KB + (buf) * KB_SZ + kdst) = nk; { LAS char* vp_ = lds + L_VB + (buf) * VB_SZ + vdst; u32x2 a_; a_.x = nv.x; a_.y = nv.y; *(LAS u32x2*)vp_ = a_; a_.x = nv.z; a_.y = nv.w; *(LAS u32x2*)(vp_ + 8) = a_; } } while (0)
    const bf16* s_ksrc = Z1 + ((size_t)b * SEQ + krow) * Z1P + 256 + g * 64 + kch * 8;
    const bf16* s_vsrc = VTS + ((size_t)(b * 128 + g * 64 + krow)) * SEQ + kch * 8;
    const bf16* w_ksrc = Z1 + ((size_t)b * SEQ + krow) * Z1P + 512 + g * 64 + kch * 8;
    const bf16* w_vsrc = VTW + ((size_t)(b * 128 + g * 64 + krow)) * SEQ + kch * 8;
    const int kt_first = (t0 >= 512) ? (t0 - 512) / 64 : 0, kt_last = t0 / 64;

    const int ncmp = t0 / 16 + 3, nct = (ncmp + 63) / 64;
    const bf16* kcsrc = KC + ((size_t)bg * 512 + krow) * 64 + kch * 8;
    const bf16* vcsrc = VCT + ((size_t)bg * 64 + krow) * 512 + kch * 8;
    float mc = NEGF, lc = 0.f;
    {
        sk = *(const u32x4*)kcsrc; nk = sk; nv = *(const u32x4*)vcsrc; NSA_STORE(0, false); __syncthreads();
        for (int it = 0; it < nct; ++it) {
            const bool more = it + 1 < nct;
            if (more) sk = *(const u32x4*)(kcsrc + (size_t)(it + 1) * 64 * 64);
            const LAS char* Kb = lds + L_KB + (it & 1) * KB_SZ;
            f32x16 s0, s1; qk_pair<4>(s0, s1, Kb, 144, qr, czero, r32, hi);
            float mx = NEGF;
#pragma unroll
            for (int r = 0; r < 16; ++r) { const int i0 = it * 64 + crow(r, hi); const int d0_ = t - (16 * i0 + 31), d1_ = d0_ - 512;
                s0[r] = d0_ >= 0 ? s0[r] - slope * (float)d0_ : NEGF; s1[r] = d1_ >= 0 ? s1[r] - slope * (float)d1_ : NEGF; mx = fmaxf(mx, fmaxf(s0[r], s1[r])); }
            mx = fmaxf(mx, __shfl_xor(mx, 32));
            const float mn = fmaxf(mc, mx), alpha = __builtin_amdgcn_exp2f(mc - mn); mc = mn;
            float sum = 0.f;
#pragma unroll
            for (int r = 0; r < 16; ++r) { sum += (s0[r] > -1e29f ? __builtin_amdgcn_exp2f(s0[r] - mn) : 0.f) + (s1[r] > -1e29f ? __builtin_amdgcn_exp2f(s1[r] - mn) : 0.f); }
            lc = lc * alpha + sum;
            if (more) NSA_STORE((it + 1) & 1, false);
            __syncthreads();
        }
        lc += __shfl_xor(lc, 32);
    }
    {
        const float invl = 1.f / fmaxf(lc, 1e-30f);
        f32x16 o0, o1; zero16(o0); zero16(o1);
        NSA_STORE_N(0); __syncthreads();
        nk = *(const u32x4*)s_ksrc; nv = *(const u32x4*)s_vsrc;
        for (int it = 0; it < nct; ++it) {
            const bool more = it + 1 < nct;
            if (more) { sk = *(const u32x4*)(kcsrc + (size_t)(it + 1) * 64 * 64); sv = *(const u32x4*)(vcsrc + (it + 1) * 64); }
            const LAS char* Kb = lds + L_KB + (it & 1) * KB_SZ; const LAS char* Vb = lds + L_VB + (it & 1) * VB_SZ;
            f32x16 s0, s1; qk_pair<4>(s0, s1, Kb, 144, qr, czero, r32, hi);
#pragma unroll
            for (int r = 0; r < 16; ++r) { const int i0 = it * 64 + crow(r, hi); const int d0_ = t - (16 * i0 + 31), d1_ = d0_ - 512;
                s0[r] = d0_ >= 0 ? __builtin_amdgcn_exp2f(s0[r] - slope * (float)d0_ - mc) * invl : 0.f; s1[r] = d1_ >= 0 ? __builtin_amdgcn_exp2f(s1[r] - slope * (float)d1_ - mc) * invl : 0.f; }
            pv_tile(o0, o1, Vb, s0, s1, r32, hi);
#pragma unroll
            for (int sub = 0; sub < 2; ++sub) {
                f32x16 ps = sub ? s1 : s0;
#pragma unroll
                for (int r = 0; r < 16; ++r) {
                    ps[r] += __builtin_bit_cast(float, __builtin_amdgcn_update_dpp(0, __builtin_bit_cast(int, ps[r]), 0xB1, 0xF, 0xF, true));
                    ps[r] += __builtin_bit_cast(float, __builtin_amdgcn_update_dpp(0, __builtin_bit_cast(int, ps[r]), 0x4E, 0xF, 0xF, true)); }
                LAS float* row = imp + tok * IMP_P + (it * 64 + sub * 32) / 4 + hi;
                if (hh == 0) {
#pragma unroll
                    for (int a = 0; a < 4; ++a) row[2 * a] += (ps[4 * a] + ps[4 * a + 1]) + (ps[4 * a + 2] + 0.5f * ps[4 * a + 3]);
                }
                LDS_WAIT();
                if (hh == 0) {
#pragma unroll
                    for (int a = 0; a < 4; ++a) row[2 * a + 1] += 0.5f * ps[4 * a + 3];
                }
                LDS_WAIT();
            }
            if (more) NSA_STORE((it + 1) & 1, true);
            __syncthreads();
        }
#pragma unroll
        for (int r = 0; r < 16; ++r) { out0[r] += g0 * o0[r]; out1[r] += g0 * o1[r]; }
    }
    {
        const int nlast = cur - 2;
#pragma unroll 1
        for (int tk0 = 0; tk0 < 8; tk0 += 4) {
            const int j0 = lane, j1 = lane + 64;
            const bool val0 = j0 >= 1 && j0 <= nlast, val1 = j1 <= nlast;
            unsigned k0[4], k1[4]; bool s0[4], s1[4];
#pragma unroll
            for (int q = 0; q < 4; ++q) { const LAS float* row = imp + (8 * wid + tk0 + q) * IMP_P;
                k0[q] = __builtin_bit_cast(unsigned, row[j0]); k1[q] = __builtin_bit_cast(unsigned, row[j1]); s0[q] = val0; s1[q] = val1; }
            if (nlast > 13) {
                unsigned T0 = 0u, T1 = 0u, T2 = 0u, T3 = 0u;
#pragma unroll 1
                for (int bit = 30; bit >= 0; --bit) {
                    const unsigned bm = 1u << bit;
                    { const unsigned tr = T0 | bm; const int cnt = __popcll(__ballot(val0 && k0[0] >= tr)) + __popcll(__ballot(val1 && k1[0] >= tr)); if (cnt >= 13) T0 = tr; }
                    { const unsigned tr = T1 | bm; const int cnt = __popcll(__ballot(val0 && k0[1] >= tr)) + __popcll(__ballot(val1 && k1[1] >= tr)); if (cnt >= 13) T1 = tr; }
                    { const unsigned tr = T2 | bm; const int cnt = __popcll(__ballot(val0 && k0[2] >= tr)) + __popcll(__ballot(val1 && k1[2] >= tr)); if (cnt >= 13) T2 = tr; }
                    { const unsigned tr = T3 | bm; const int cnt = __popcll(__ballot(val0 && k0[3] >= tr)) + __popcll(__ballot(val1 && k1[3] >= tr)); if (cnt >= 13) T3 = tr; }
                }
                const unsigned long long below = (1ull << lane) - 1ull;
#pragma unroll
                for (int q = 0; q < 4; ++q) { const unsigned T = q == 0 ? T0 : q == 1 ? T1 : q == 2 ? T2 : T3;
                    const bool gt0 = val0 && k0[q] > T, gt1 = val1 && k1[q] > T, eq0 = val0 && k0[q] == T, eq1 = val1 && k1[q] == T;
                    const int need = 13 - (__popcll(__ballot(gt0)) + __popcll(__ballot(gt1)));
                    const unsigned long long e0 = __ballot(eq0), e1 = __ballot(eq1);
                    const int r0 = __popcll(e0 & below), r1 = __popcll(e0) + __popcll(e1 & below);
                    s0[q] = gt0 || (eq0 && r0 < need); s1[q] = gt1 || (eq1 && r1 < need); }
            }
#pragma unroll
            for (int q = 0; q < 4; ++q) {
                unsigned long long m0 = __ballot(s0[q]), m1 = __ballot(s1[q]);
                m0 |= 1ull;
                if (cur < 64) m0 |= 1ull << cur; else m1 |= 1ull << (cur - 64);
                if (cur >= 1) { if (cur - 1 < 64) m0 |= 1ull << (cur - 1); else m1 |= 1ull << (cur - 65); }
                const int tk = tk0 + q;
                if (lane == 0) { selm[(8 * wid + tk) * 4 + 0] = (unsigned)m0; selm[(8 * wid + tk) * 4 + 1] = (unsigned)(m0 >> 32); selm[(8 * wid + tk) * 4 + 2] = (unsigned)m1; selm[(8 * wid + tk) * 4 + 3] = (unsigned)(m1 >> 32); }
            }
        }
        LDS_WAIT();
        if (lane < 4) { unsigned x = 0; for (int tk = 0; tk < 8; ++tk) x |= selm[(8 * wid + tk) * 4 + lane]; wun[wid * 4 + lane] = x; }
        __syncthreads();
    }
    const unsigned long long tm0 = (unsigned long long)selm[tok * 4 + 0] | ((unsigned long long)selm[tok * 4 + 1] << 32), tm1 = (unsigned long long)selm[tok * 4 + 2] | ((unsigned long long)selm[tok * 4 + 3] << 32);
    unsigned long long wu0, wu1, gu0 = 0, gu1 = 0;
    {
        const unsigned a0 = __builtin_amdgcn_readfirstlane(wun[wid * 4 + 0]), a1 = __builtin_amdgcn_readfirstlane(wun[wid * 4 + 1]), a2 = __builtin_amdgcn_readfirstlane(wun[wid * 4 + 2]), a3 = __builtin_amdgcn_readfirstlane(wun[wid * 4 + 3]);
        wu0 = (unsigned long long)a0 | ((unsigned long long)a1 << 32); wu1 = (unsigned long long)a2 | ((unsigned long long)a3 << 32);
        for (int w = 0; w < 8; ++w) {
            const unsigned b0 = __builtin_amdgcn_readfirstlane(wun[w * 4 + 0]), b1 = __builtin_amdgcn_readfirstlane(wun[w * 4 + 1]), b2 = __builtin_amdgcn_readfirstlane(wun[w * 4 + 2]), b3 = __builtin_amdgcn_readfirstlane(wun[w * 4 + 3]);
            gu0 |= (unsigned long long)b0 | ((unsigned long long)b1 << 32); gu1 |= (unsigned long long)b2 | ((unsigned long long)b3 << 32);
        }
    }
    {
        const bf16* ksrc = s_ksrc; const bf16* vsrc = s_vsrc;
        float mref = 0.f, thr = -1e29f, l = 0.f; f32x16 o0, o1; zero16(o0); zero16(o1);
        const float sl4 = slope * (float)(4 * hi);
        int j = 0;
        NSA_STORE_N(0); __syncthreads();
        nk = *(const u32x4*)(w_ksrc + (size_t)kt_first * 64 * Z1P); nv = *(const u32x4*)(w_vsrc + kt_first * 64);
        int par = 0;
        while (j < 128) {
            const int nj = next_set(gu0, gu1, j + 1);
            const bool more = nj < 128;
            if (more) { sk = *(const u32x4*)(ksrc + (size_t)nj * 64 * Z1P); sv = *(const u32x4*)(vsrc + nj * 64); }
            const bool wsel = ((j < 64 ? (wu0 >> j) : (wu1 >> (j - 64))) & 1ull) != 0;
            if (wsel) {
                const LAS char* Kb = lds + L_KB + par * KB_SZ; const LAS char* Vb = lds + L_VB + par * VB_SZ;
                const bool tsel = ((j < 64 ? (tm0 >> j) : (tm1 >> (j - 64))) & 1ull) != 0;
                f32x16 cin; fill16(cin, tsel ? (sl4 - mref - slope * (float)(t - j * 64)) : NEGF);
                f32x16 s0, s1; qk_pair<4>(s0, s1, Kb, 144, qr, cin, r32, hi);
#pragma unroll
                for (int r = 0; r < 16; ++r) { s0[r] = __builtin_fmaf(slope, (float)((r & 3) + 8 * (r >> 2)), s0[r]); s1[r] = __builtin_fmaf(slope, (float)((r & 3) + 8 * (r >> 2) + 32), s1[r]); }
                if (j == cur) {
#pragma unroll
                    for (int r = 0; r < 16; ++r) { const int d0_ = t - (j * 64 + crow(r, hi)); if (d0_ < 0) s0[r] = NEGF; if (d0_ < 32) s1[r] = NEGF; }
                }
                sm_tile(s0, s1, mref, thr, l, o0, o1);
                pv_tile(o0, o1, Vb, s0, s1, r32, hi);
            }
            if (more) NSA_STORE(par ^ 1, true);
            __syncthreads();
            par ^= 1; j = nj;
        }
        l += __shfl_xor(l, 32);
        const float sc = g1 / fmaxf(l, 1e-30f);
#pragma unroll
        for (int r = 0; r < 16; ++r) { out0[r] += sc * o0[r]; out1[r] += sc * o1[r]; }
    }
    {
        const bf16* ksrc = w_ksrc; const bf16* vsrc = w_vsrc;
        float mref = 0.f, thr = -1e29f, l = 0.f; f32x16 o0, o1; zero16(o0); zero16(o1);
        const float sl4 = slope * (float)(4 * hi);
        const int tw0 = t0 + 8 * wid;
        NSA_STORE_N(0); __syncthreads();
        int par = 0;
        for (int kt = kt_first; kt <= kt_last; ++kt) {
            const bool more = kt < kt_last;
            if (more) { sk = *(const u32x4*)(ksrc + (size_t)(kt + 1) * 64 * Z1P); sv = *(const u32x4*)(vsrc + (kt + 1) * 64); }
            const LAS char* Kb = lds + L_KB + par * KB_SZ; const LAS char* Vb = lds + L_VB + par * VB_SZ;
            f32x16 cin; fill16(cin, sl4 - mref - slope * (float)(t - kt * 64));
            f32x16 s0, s1; qk_pair<4>(s0, s1, Kb, 144, qr, cin, r32, hi);
#pragma unroll
            for (int r = 0; r < 16; ++r) { s0[r] = __builtin_fmaf(slope, (float)((r & 3) + 8 * (r >> 2)), s0[r]); s1[r] = __builtin_fmaf(slope, (float)((r & 3) + 8 * (r >> 2) + 32), s1[r]); }
            if (kt * 64 + 63 > tw0 || kt * 64 < tw0 + 7 - 511) {
#pragma unroll
                for (int r = 0; r < 16; ++r) { const int d0_ = t - (kt * 64 + crow(r, hi)), d1_ = d0_ - 32;
                    if (!(d0_ >= 0 && d0_ < 512)) s0[r] = NEGF; if (!(d1_ >= 0 && d1_ < 512)) s1[r] = NEGF; }
            }
            sm_tile(s0, s1, mref, thr, l, o0, o1);
            pv_tile(o0, o1, Vb, s0, s1, r32, hi);
            if (more) NSA_STORE(par ^ 1, true);
            __syncthreads();
            par ^= 1;
        }
        l += __shfl_xor(l, 32);
        const float sc = g2 / fmaxf(l, 1e-30f);
#pragma unroll
        for (int r = 0; r < 16; ++r) { out0[r] += sc * o0[r]; out1[r] += sc * o1[r]; }
    }
#undef NSA_STORE
#undef NSA_STORE_N
    store_o_row(YN + rowq * 512 + head * 64, out0, out1, 1.f, hi);
}

struct Args { const float* in[27]; float* out; unsigned char* ws; int ph_lo, ph_hi; };
enum { I_X = 0, I_F1PRE, I_F1POST, I_F1G, I_F1U, I_F1D, I_MPRE, I_MPOST, I_WIN, I_CPK, I_CW1K, I_CW2K, I_CPV, I_CW1V, I_CW2V, I_QNG, I_WUQ, I_KVNG, I_WUKV, I_WPN, I_WPM, I_WOUT, I_F2PRE, I_F2POST, I_F2G, I_F2U, I_F2D };

__global__ void __launch_bounds__(NWAVES * 64, 2) fwd_kernel(Args args) {
    extern __shared__ __attribute__((aligned(16))) unsigned char lds_raw[];
    LAS unsigned char* lds = (LAS unsigned char*)lds_raw;
    const int wave = __builtin_amdgcn_readfirstlane((int)threadIdx.x >> 6);
    const int G = gridDim.x, c = blockIdx.x;
    const int NGW = G * NWAVES, NGT = G * NWAVES * 64;
#define IDS() const int lane = mk_lane(); const int tid = wave * 64 + lane; const int gw = c * NWAVES + wave; const int gt = c * (NWAVES * 64) + tid; (void)tid; (void)gw; (void)gt
#define WGU1 ((bf16*)(args.ws + O_WGU1))
#define WD1 ((bf16*)(args.ws + O_WD1))
#define WGU2 ((bf16*)(args.ws + O_WGU2))
#define WD2 ((bf16*)(args.ws + O_WD2))
#define WIN ((bf16*)(args.ws + O_WIN))
#define WPN ((bf16*)(args.ws + O_WPN))
#define WPM ((bf16*)(args.ws + O_WPM))
#define WOUT ((bf16*)(args.ws + O_WOUT))
#define WUQ ((bf16*)(args.ws + O_WUQ))
#define WUKV ((bf16*)(args.ws + O_WUKV))
#define CW1K ((bf16*)(args.ws + O_CW1K))
#define CW1V ((bf16*)(args.ws + O_CW1V))
#define A1 ((bf16*)(args.ws + O_A1))
#define IM2K ((bf16*)(args.ws + O_IM2K))
#define IM2V ((bf16*)(args.ws + O_IM2V))
#define CQN ((bf16*)(args.ws + O_CQN))
#define CKVN ((bf16*)(args.ws + O_CKVN))
#define KR ((bf16*)(args.ws + O_KR))
#define HK ((bf16*)(args.ws + O_HK))
#define HV ((bf16*)(args.ws + O_HV))
#define KC ((bf16*)(args.ws + O_KC))
#define VCT ((bf16*)(args.ws + O_VCT))
#define MG ((bf16*)(args.ws + O_MG))
#define H ((bf16*)(args.ws + O_H))
#define Z1 ((bf16*)(args.ws + O_Z1))
#define QN ((bf16*)(args.ws + O_QN))
#define YM ((bf16*)(args.ws + O_YM))
#define KM ((bf16*)(args.ws + O_KM))
#define GM ((bf16*)(args.ws + O_GM))
#define QM ((bf16*)(args.ws + O_QM))
#define VTM ((bf16*)(args.ws + O_VTM))
#define VTS ((bf16*)(args.ws + O_VTS))
#define VTW ((bf16*)(args.ws + O_VTW))
#define F ((bf16*)(args.ws + O_F))
#define X (args.out)
#define X1B ((bf16*)args.out)
#define X2B ((bf16*)(args.ws + O_X2B))
    typedef const float* cfp_t;
    const __attribute__((address_space(4))) cfp_t* in = (const __attribute__((address_space(4))) cfp_t*)__builtin_amdgcn_kernarg_segment_ptr();
    asm volatile("" : "+s"(in));
    const int lo = args.ph_lo, hi_ph = args.ph_hi;
#define IN(k) (lo <= (k) && (k) < hi_ph)
#if MK_PER_PHASE
#define SEAM(k) do { } while (0)
#else
    if (lo == 0 && hi_ph == NPHASE) {
        if (c == 0) { unsigned* ctl = (unsigned*)(args.ws + O_CTL); for (int i = (int)threadIdx.x; i < 4096; i += NWAVES * 64) __hip_atomic_store(ctl + i, 0u, __ATOMIC_RELAXED, __HIP_MEMORY_SCOPE_AGENT); }
        cg::grid_group grid = cg::this_grid(); grid.sync();
    }
    volatile LAS unsigned* xst = (volatile LAS unsigned*)(lds + 131072 + 512);
    XcdBarrier xbar;
    { const int l_ = mk_lane(); const int t_ = wave * 64 + l_; if (t_ < 2) xst[t_] = 0u; __syncthreads(); xbar = xcd_barrier_post((unsigned*)(args.ws + O_CTL), xst, t_); }
#ifdef DIAG_TS
    unsigned long long* const tsw = (unsigned long long*)(args.ws + O_CTL + 15000);
    if (c == 0 && wave == 0 && mk_lane() == 0) tsw[0] = __builtin_amdgcn_s_memrealtime();
#define SEAM(k) do { if (IN(k) && IN((k) + 1)) { const int l_ = mk_lane(); xcd_barrier(xbar, wave * 64 + l_); if (c == 0 && wave == 0 && l_ == 0) tsw[(k) + 1] = __builtin_amdgcn_s_memrealtime(); } } while (0)
#else
#define SEAM(k) do { if (IN(k) && IN((k) + 1)) { const int l_ = mk_lane(); xcd_barrier(xbar, wave * 64 + l_); } } while (0)
#endif
#endif
#define GEMM_CALL(EPI, A_, B_, M_, N_, K_, cc, E_) do { Gemm g_{(const pg8::bf16_t*)(A_), (const pg8::bf16_t*)(B_), (M_), (N_), (K_)}; StaticOrder S_; S_.init((M_), (N_), G, (cc)); \
        const int l_ = mk_lane(); pg8::gemm_phase<EPI, StaticOrder, true, PG8_SP2>(lds, g_, S_, (E_), wave, l_); } while (0)

    if (IN(0)) {
        IDS();
        LAS float* scr = (LAS float*)(lds + wave * 16384);
        transpose_mat(in[I_F1G], DFF, MapGU{0}, 1024, DFF, WGU1, scr, gw, NGW, lane);
        transpose_mat(in[I_F1U], DFF, MapGU{1}, 1024, DFF, WGU1, scr, gw, NGW, lane);
        transpose_mat(in[I_F1D], 1024, MapPlain{}, 2816, 1024, WD1, scr, gw, NGW, lane);
        transpose_mat(in[I_WIN], 3768, MapWin{}, 1024, 3840, WIN, scr, gw, NGW, lane);
        transpose_mat(in[I_WUQ], 768, MapPlain{}, 256, 768, WUQ, scr, gw, NGW, lane);
        transpose_mat(in[I_WUKV], 1024, MapUkv{}, 128, 1024, WUKV, scr, gw, NGW, lane);
        transpose_mat(in[I_CW1K], 256, MapPlain{}, 2048, 256, CW1K, scr, gw, NGW, lane);
        transpose_mat(in[I_CW1V], 256, MapPlain{}, 2048, 256, CW1V, scr, gw, NGW, lane);
        f32x4 gpre[4]; load_gain(gpre, in[I_F1PRE], lane);
        for (int m = gw; m < MTOK; m += 4 * NGW) {
            f32x4 v[4][4];
#pragma unroll
            for (int q = 0; q < 4; ++q) { const int mq = m + q * NGW; if (mq < MTOK) { const float* xr = in[I_X] + (size_t)mq * DM + 8 * lane;
#pragma unroll
                for (int j = 0; j < 2; ++j) { v[q][2 * j] = *(const f32x4*)(xr + 512 * j); v[q][2 * j + 1] = *(const f32x4*)(xr + 512 * j + 4); } } }
#pragma unroll
            for (int q = 0; q < 4; ++q) { const int mq = m + q * NGW; if (mq < MTOK) rms_row_to_bf16(v[q], gpre, A1 + (size_t)mq * DM, lane); }
        }
        __syncthreads();
    }
    SEAM(0);
    if (IN(1)) GEMM_CALL(EpiSwiglu, A1, WGU1, MTOK, 5632, 1024, c, (EpiSwiglu{H}));
    SEAM(1);
#ifdef PROBE_FFN2
    if (IN(2)) GEMM_CALL(EpiF32, H, WD1, MTOK, 1024, 2816, c, (EpiF32{F, DM}));
    if (IN(1)) GEMM_CALL(EpiSwiglu, A1, WGU1, MTOK, 5632, 1024, c, (EpiSwiglu{H}));
#endif
    if (IN(2)) GEMM_CALL(EpiF32, H, WD1, MTOK, 1024, 2816, c, (EpiF32{F, DM}));
    SEAM(2);
    if (IN(3)) { IDS(); rowop<false, true, true>(F, in[I_X], 0.5f, in[I_F1POST], X1B, in[I_MPRE], A1, gw, NGW, lane); }
    SEAM(3);
    if (IN(4)) GEMM_CALL(EpiWin, A1, WIN, MTOK, 3840, 1024, c, (EpiWin{QN, Z1, GM, VTS, VTW}));
    SEAM(4);
    if (IN(5)) {
        IDS();
        for (int ch0 = gt; ch0 < 2 * 4096 * 256; ch0 += 4 * NGT) {
            u32x4 z[4]; f32x4 p0[4], p1[4];
#pragma unroll
            for (int q = 0; q < 4; ++q) { const int ch = ch0 + q * NGT; z[q] = (u32x4){0u, 0u, 0u, 0u};
                if (ch < 2 * 4096 * 256) { const int kv = ch >> 20, r = (ch >> 8) & 4095, c8 = ch & 255, l = c8 >> 3, d0 = (c8 & 7) * 8, bgi = r >> 9, i = r & 511, b = bgi >> 1, g = bgi & 1;
                    if (i < 511) { z[q] = *(const u32x4*)(Z1 + ((size_t)b * SEQ + 16 * i + l) * Z1P + kv * 128 + g * 64 + d0);
                        const float* pe = (kv ? in[I_CPV] : in[I_CPK]) + l * 64 + d0; p0[q] = *(const f32x4*)pe; p1[q] = *(const f32x4*)(pe + 4); } } }
#pragma unroll
            for (int q = 0; q < 4; ++q) { const int ch = ch0 + q * NGT;
                if (ch < 2 * 4096 * 256) { const int kv = ch >> 20, r = (ch >> 8) & 4095, c8 = ch & 255, i = r & 511;
                    u32x4 o = (u32x4){0u, 0u, 0u, 0u};
                    if (i < 511) { const u32x4 zz = z[q]; const f32x4 a = p0[q], bb = p1[q];
                        o.x = cvtpk(bflo(zz.x) + a.x, bfhi(zz.x) + a.y); o.y = cvtpk(bflo(zz.y) + a.z, bfhi(zz.y) + a.w); o.z = cvtpk(bflo(zz.z) + bb.x, bfhi(zz.z) + bb.y); o.w = cvtpk(bflo(zz.w) + bb.z, bfhi(zz.w) + bb.w); }
                    *(u32x4*)((kv ? IM2V : IM2K) + (size_t)r * 2048 + c8 * 8) = o; } }
        }
        if (gt < SEQ * 16) { float cs, sn; rope_cs(gt >> 4, gt & 15, cs, sn); ((float*)(args.ws + O_ROPE))[2 * gt] = cs; ((float*)(args.ws + O_ROPE))[2 * gt + 1] = sn; }
        for (int m0 = gw; m0 < MTOK; m0 += 4 * NGW) {
            u32x2 wq[4]; unsigned wk[4]; float x1[4], x2[4];
#pragma unroll
            for (int q = 0; q < 4; ++q) { const int m = m0 + q * NGW; if (m < MTOK) { const bf16* zr = Z1 + (size_t)m * Z1P;
                wq[q] = *(const u32x2*)(zr + 768 + 4 * lane); wk[q] = *(const unsigned*)(zr + 1024 + 2 * lane);
                x1[q] = bf2f(zr[1152 + (lane & 15)]); x2[q] = bf2f(zr[1152 + 16 + (lane & 15)]); } }
            const f32x4 gq = *(const f32x4*)(in[I_QNG] + 4 * lane); const float gk0 = in[I_KVNG][2 * lane], gk1 = in[I_KVNG][2 * lane + 1];
#pragma unroll
            for (int q = 0; q < 4; ++q) { const int m = m0 + q * NGW; if (m < MTOK) {
                { const u32x2 w = wq[q]; const float a0 = bflo(w.x), a1 = bfhi(w.x), a2 = bflo(w.y), a3 = bfhi(w.y);
                  const float r = rsqrtf(wave_sum((a0 * a0 + a1 * a1) + (a2 * a2 + a3 * a3)) * (1.f / 256.f) + EPS);
                  u32x2 o; o.x = cvtpk(a0 * r * gq.x, a1 * r * gq.y); o.y = cvtpk(a2 * r * gq.z, a3 * r * gq.w); *(u32x2*)(CQN + (size_t)m * 256 + 4 * lane) = o; }
                { const unsigned w = wk[q]; const float a0 = bflo(w), a1 = bfhi(w);
                  const float r = rsqrtf(wave_sum(a0 * a0 + a1 * a1) * (1.f / 128.f) + EPS);
                  *(unsigned*)(CKVN + (size_t)m * 128 + 2 * lane) = cvtpk(a0 * r * gk0, a1 * r * gk1); }
                if (lane < 16) { float cs, sn; rope_cs(m & 8191, lane, cs, sn);
                  KR[(size_t)m * 32 + lane] = f2bf(x1[q] * cs - x2[q] * sn); KR[(size_t)m * 32 + 16 + lane] = f2bf(x1[q] * sn + x2[q] * cs); } } }
        }
    }
    SEAM(5);
    if (IN(6)) {
        GEMM_CALL(EpiGelu, IM2K, CW1K, 4096, 256, 2048, c, (EpiGelu{HK, 256}));
        GEMM_CALL(EpiGelu, IM2V, CW1V, 4096, 256, 2048, (c + G / 2) % G, (EpiGelu{HV, 256}));
        {
            const bool small = G < 64, busy = !small && (c < 16 || ((c + G - G / 2) % G) < 16);
            if (!busy) {
                const int cr = small ? c : (c < G / 2 ? c - 16 : c - 32), GF = small ? G : G - 32;
                { const int l_ = mk_lane(); Gemm g_{(const pg8::bf16_t*)CQN, (const pg8::bf16_t*)WUQ, MTOK, 768, 256}; StaticOrder S_; S_.init(MTOK, 768, GF, cr); pg8::gemm_phase<EpiQup, StaticOrder, true, PG8_SP2>(lds, g_, S_, (EpiQup{QM}), wave, l_); }
                { const int l_ = mk_lane(); Gemm g_{(const pg8::bf16_t*)CKVN, (const pg8::bf16_t*)WUKV, MTOK, 1024, 128}; StaticOrder S_; S_.init(MTOK, 1024, GF, cr); pg8::gemm_phase<EpiKVup, StaticOrder, true, PG8_SP2>(lds, g_, S_, (EpiKVup{KM, VTM}), wave, l_); }
                IDS();
                const int gwf = cr * NWAVES + wave, NGWF = GF * NWAVES;
                LAS float* scr = (LAS float*)(lds + wave * 16384);
                transpose_mat(in[I_F2G], DFF, MapGU{0}, 1024, DFF, WGU2, scr, gwf, NGWF, lane);
                transpose_mat(in[I_F2U], DFF, MapGU{1}, 1024, DFF, WGU2, scr, gwf, NGWF, lane);
                transpose_mat(in[I_F2D], 1024, MapPlain{}, 2816, 1024, WD2, scr, gwf, NGWF, lane);
                transpose_mat(in[I_WPN], 1024, MapPlain{}, 512, 1024, WPN, scr, gwf, NGWF, lane);
                transpose_mat(in[I_WPM], 1024, MapPlain{}, 512, 1024, WPM, scr, gwf, NGWF, lane);
                transpose_mat(in[I_WOUT], 1024, MapPlain{}, 1024, 1024, WOUT, scr, gwf, NGWF, lane);
            }
        }
    }
    SEAM(6);
    if (IN(7)) {
        IDS();
        for (int pi = gt; pi < 2 * 2048 * 64; pi += NGT) {
            const int kv = pi >> 17, r = (pi >> 6) & 2047, d = pi & 63;
            const bf16* h0 = (kv ? HV : HK) + (size_t)r * 256; const bf16* h1 = h0 + (size_t)2048 * 256; const float* w2 = (kv ? in[I_CW2V] : in[I_CW2K]) + d;
            float acc0 = 0.f, acc1 = 0.f;
#pragma unroll 2
            for (int j8 = 0; j8 < 32; ++j8) { const u32x4 ha = *(const u32x4*)(h0 + j8 * 8), hb = *(const u32x4*)(h1 + j8 * 8); const float* wp = w2 + (size_t)j8 * 8 * 64;
                const float w0 = wp[0], w1 = wp[64], w2_ = wp[128], w3 = wp[192], w4 = wp[256], w5 = wp[320], w6 = wp[384], w7 = wp[448];
                acc0 += bflo(ha.x) * w0 + bfhi(ha.x) * w1 + bflo(ha.y) * w2_ + bfhi(ha.y) * w3 + bflo(ha.z) * w4 + bfhi(ha.z) * w5 + bflo(ha.w) * w6 + bfhi(ha.w) * w7;
                acc1 += bflo(hb.x) * w0 + bfhi(hb.x) * w1 + bflo(hb.y) * w2_ + bfhi(hb.y) * w3 + bflo(hb.z) * w4 + bfhi(hb.z) * w5 + bflo(hb.w) * w6 + bfhi(hb.w) * w7; }
            const int r1 = r + 2048;
            if (kv == 0) { KC[(size_t)r * 64 + d] = f2bf(acc0); KC[(size_t)r1 * 64 + d] = f2bf(acc1); }
            else { VCT[((size_t)(r >> 9) * 64 + d) * 512 + (r & 511)] = f2bf(acc0); VCT[((size_t)(r1 >> 9) * 64 + d) * 512 + (r1 & 511)] = f2bf(acc1); }
        }
    }
    SEAM(7);
    if (IN(8)) {
        IDS();
        LAS char* al = (LAS char*)lds;
#ifdef PROBE_NSA2
        for (int i = 0; i * G < 1024; ++i) { const int p = (i & 1) ? (G - 1 - c) : c, uu = i * G + p;
            if (uu < 1024) { const int tile = 127 - (uu >> 3), bgi = uu & 7; nsa_unit(bgi >> 1, bgi & 1, tile, QN, IM2K, Z1, KC, VCT, VTS, VTW, al, wave, lane); } }
#endif
        if (wave >= 4) __builtin_amdgcn_s_setprio(1);
        const int lane_n = mk_lane();
        {
            unsigned* const qctr = (unsigned*)(args.ws + O_CTL + 15360);
            volatile LAS unsigned* qw = (volatile LAS unsigned*)(lds + 131072 + 1024);
            unsigned mine = 0;
            if (wave == 0 && lane_n == 0) mine = __hip_atomic_fetch_add(qctr, 1u, __ATOMIC_RELAXED, __HIP_MEMORY_SCOPE_AGENT);
            for (;;) {
                if (wave == 0 && lane_n == 0) qw[0] = mine;
                __syncthreads();
                const unsigned k = qw[0];
                __syncthreads();
                if (k >= 2048u) break;
                if (wave == 0 && lane_n == 0) mine = __hip_atomic_fetch_add(qctr, 1u, __ATOMIC_RELAXED, __HIP_MEMORY_SCOPE_AGENT);
                if (k < 896u || k >= 1920u) { const unsigned k1 = (k < 896u) ? k : k - 1024u; const int qb = 31 - (int)(k1 >> 5), bh = (int)(k1 & 31u);
                    mla_unit(bh >> 3, bh & 7, qb, QM, KM, KR, VTM, YM, (const float*)(args.ws + O_ROPE), al, wave, lane_n); }
                else { const unsigned k2 = k - 896u; const int g = 1 - (int)(k2 >> 9), kk = (int)(k2 & 511u), tile = 127 - (kk >> 2), b = kk & 3;
                    nsa_unit(b, g, tile, QN, QN, Z1, KC, VCT, VTS, VTW, al, wave, lane_n); }
            }
        }
    }
    if (IN(8)) __builtin_amdgcn_s_setprio(0);
    SEAM(8);
    if (IN(9)) {
        GEMM_CALL(EpiProj<false>, QN, WPN, MTOK, 1024, 512, c, (EpiProj<false>{GM, MG}));
        GEMM_CALL(EpiProj<true>, YM, WPM, MTOK, 1024, 512, c, (EpiProj<true>{GM, MG}));
    }
    SEAM(9);
    if (IN(10)) GEMM_CALL(EpiF32, MG, WOUT, MTOK, 1024, 1024, c, (EpiF32{F, DM}));
    SEAM(10);
    if (IN(11)) { IDS(); rowop<true, true, true>(F, X1B, 1.0f, in[I_MPOST], X2B, in[I_F2PRE], A1, gw, NGW, lane); }
    SEAM(11);
    if (IN(12)) GEMM_CALL(EpiSwiglu, A1, WGU2, MTOK, 5632, 1024, c, (EpiSwiglu{H}));
    SEAM(12);
    if (IN(13)) GEMM_CALL(EpiF32, H, WD2, MTOK, 1024, 2816, c, (EpiF32{F, DM}));
    SEAM(13);
    if (IN(14)) { IDS(); rowop<true, false, false>(F, X2B, 0.5f, in[I_F2POST], X, nullptr, nullptr, gw, NGW, lane); }
#ifdef DIAG_TS
    { asm volatile("s_waitcnt vmcnt(0)" ::: "memory"); __syncthreads();
      if (c == 0 && wave == 0 && mk_lane() == 0) { const float da = (float)(tsw[DIAG_A + 1] - tsw[DIAG_A]) * 0.01f, db = (float)(tsw[DIAG_B + 1] - tsw[DIAG_B]) * 0.01f; X[0] += da; X[1] += db; } }
#endif
#undef IN
#undef IDS
#undef SEAM
#undef GEMM_CALL
#undef WGU1
#undef WD1
#undef WGU2
#undef WD2
#undef WIN
#undef WPN
#undef WPM
#undef WOUT
#undef WUQ
#undef WUKV
#undef CW1K
#undef CW1V
#undef A1
#undef IM2K
#undef IM2V
#undef CQN
#undef CKVN
#undef KR
#undef HK
#undef HV
#undef KC
#undef VCT
#undef MG
#undef H
#undef Z1
#undef QN
#undef YM
#undef KM
#undef GM
#undef QM
#undef VTM
#undef VTS
#undef VTW
#undef F
#undef X
#undef X1B
#undef X2B
}
}

extern "C" void kernel_launch(void* const* d_in, const int* in_sizes, int n_in, void* d_out, int out_size, void* d_ws, size_t ws_size, hipStream_t stream) {
    using namespace mk;
    static int grid = 0;
    if (grid == 0) {
        if (n_in != 27 || out_size != MTOK * DM || ws_size < O_END) { fprintf(stderr, "kernel_launch: unexpected problem (n_in %d out %d ws %zu)\n", n_in, out_size, ws_size); grid = -1; return; }
        int dev = 0, cus = 0, per_cu = 0;
        hipGetDevice(&dev); hipDeviceGetAttribute(&cus, hipDeviceAttributeMultiprocessorCount, dev);
        if (hipFuncSetAttribute((const void*)fwd_kernel, hipFuncAttributeMaxDynamicSharedMemorySize, LDS_BYTES) != hipSuccess) { fprintf(stderr, "kernel_launch: hipFuncSetAttribute failed\n"); grid = -1; return; }
        if (hipOccupancyMaxActiveBlocksPerMultiprocessor(&per_cu, (const void*)fwd_kernel, NWAVES * 64, LDS_BYTES) != hipSuccess || per_cu < 1) { fprintf(stderr, "kernel_launch: occupancy query says %d\n", per_cu); per_cu = 1; }
        (void)hipGetLastError();
        grid = cus * per_cu;
    }
    if (grid < 0) return;
#if MK_PER_PHASE
    if (hipMemsetAsync((char*)d_ws + O_CTL, 0, 16384, stream) != hipSuccess) { fprintf(stderr, "kernel_launch: memset failed\n"); return; }
#endif
    Args a{};
    for (int i = 0; i < 27; ++i) a.in[i] = (const float*)d_in[i];
    a.out = (float*)d_out; a.ws = (unsigned char*)d_ws;
#if MK_PER_PHASE
    for (int ph = 0; ph < NPHASE; ++ph) { a.ph_lo = ph; a.ph_hi = ph + 1; hipLaunchKernelGGL(fwd_kernel, dim3(grid), dim3(NWAVES * 64), LDS_BYTES, stream, a); }
#else
    a.ph_lo = 0; a.ph_hi = NPHASE;
    void* kargs[] = {&a};
    hipError_t e = hipLaunchCooperativeKernel((const void*)fwd_kernel, dim3(grid), dim3(NWAVES * 64), kargs, LDS_BYTES, stream);
    if (e != hipSuccess) fprintf(stderr, "cooperative launch failed: %s (grid %d)\n", hipGetErrorString(e), grid);
#endif
}
```

```cpp
#include <hip/hip_runtime.h>
#include <hip/hip_cooperative_groups.h>
#include <cstdio>
#include <cstdint>
namespace cg = cooperative_groups;
namespace pg8 {
#define PG8_LAS __attribute__((address_space(3)))
typedef unsigned short bf16_t;
typedef short bf16x8 __attribute__((ext_vector_type(8)));
typedef float f32x4 __attribute__((ext_vector_type(4)));
typedef unsigned u32x4 __attribute__((ext_vector_type(4)));
constexpr int BM = 256, BK = 64, HALF = 128, HTB = HALF * BK * 2  , STAGE_BYTES = 8 * HTB, NXCD = 8, WGM = 8;

__host__ __device__ __forceinline__ int lds_byte(int r, int c) { const int st = (r >> 4) * 2 + (c >> 5), rr = r & 15, cc = c & 31, ob = rr * 64 + cc * 2; return st * 1024 + (ob ^ (((ob >> 9) & 1) << 5)); }
__host__ __device__ __forceinline__ void stage_rc(int b, int& R, int& C) { const int st = b / 1024, sb = b % 1024, swz = sb ^ (((sb >> 9) & 1) << 5); R = (st >> 1) * 16 + swz / 64; C = (st & 1) * 32 + (swz % 64) / 2; }
__host__ __device__ __forceinline__ int perm32(int rho) { const int n = rho >> 4, i = rho & 15; return 8 * (i >> 2) + 4 * n + (i & 3); }

struct Unit { int pm, pn; };
struct Gemm { const bf16_t* A; const bf16_t* Bt; int M, N, K; };

struct StaticOrder {
    int nM, nN, nwg, G, c;
    __host__ __device__ void init(int M, int N, int G_, int c_) { nM = M / BM; nN = N / BM; nwg = nM * nN; G = G_; c = c_; }
    __host__ __device__ bool next(int i, Unit& u) const {
        const long L = (long)i * G + c; if (L >= nwg) return false;
        int wgid = (int)L; { const int q = nwg / NXCD, r = nwg % NXCD, xcd = wgid % NXCD, off = wgid / NXCD; wgid = (xcd < r ? xcd * (q + 1) : r * (q + 1) + (xcd - r) * q) + off; }
        const int nig = WGM * nN, gid = wgid / nig, fm = gid * WGM, gsz = (nM - fm) < WGM ? (nM - fm) : WGM;
        u.pm = fm + ((wgid % nig) % gsz); u.pn = (wgid % nig) / gsz; return true;
    }
    __device__ __forceinline__ void a_ready(const Unit&) const {}
    __device__ __forceinline__ void done(const Unit&) const {}
};

__device__ __forceinline__ unsigned cvt_pk_bf16(float lo, float hi) { unsigned r; asm volatile("v_cvt_pk_bf16_f32 %0, %1, %2" : "=v"(r) : "v"(lo), "v"(hi)); return r; }
typedef float f32x2 __attribute__((ext_vector_type(2)));
template <class Epi, class Sched, bool ALIGN_EPI = false, bool SP2 = false>
__device__ __forceinline__ void gemm_phase(PG8_LAS unsigned char* lds, const Gemm g, const Sched& S, const Epi& E, const int wid, const int lane) {
    const int tid = wid * 64 + lane, wr = wid >> 2, wc = wid & 3, fr = lane & 15, fq = lane >> 4;
    const int K = g.K, nt = K / BK;
    unsigned voffA[2], voffB[2];
#pragma unroll
    for (int i = 0; i < 2; ++i) { int R, C; stage_rc(tid * 16 + i * 8192, R, C); const int Rb = Epi::PERM ? ((R & ~31) + perm32(R & 31)) : R;
        voffA[i] = (unsigned)(R * K + C) * 2u; voffB[i] = (unsigned)(Rb * K + C) * 2u; }
    const size_t kstep = (size_t)(BK * 2);
    const size_t hstep = (size_t)HALF * K * 2;
    const size_t tstep = 2 * hstep;
    const unsigned ldsw = (unsigned)wid * 1024u;
    const int aoff = lds_byte(wr * 64 + fr, fq * 8), boff = lds_byte(wc * 32 + fr, fq * 8);
#define PG8_SA(b, h) (((b) * 2 + (h)) * HTB)
#define PG8_SB(b, h) ((4 + (b) * 2 + (h)) * HTB)
#define PG8_STAGE(bufoff, gbase, voff) do { _Pragma("unroll") for (int _i = 0; _i < 2; ++_i) \
        __builtin_amdgcn_global_load_lds((const unsigned*)((const char*)(gbase) + (voff)[_i]), (PG8_LAS unsigned*)(lds + (bufoff) + ldsw + _i * 8192), 16, 0, 0); } while (0)
#define PG8_LDA(dst, b, h) do { _Pragma("unroll") for (int m = 0; m < 4; ++m) _Pragma("unroll") for (int k = 0; k < 2; ++k) dst[m][k] = *(const PG8_LAS bf16x8*)(lds + PG8_SA(b, h) + aoff + m * 2048 + k * 1024); } while (0)
#define PG8_LDB(dst, b, h) do { _Pragma("unroll") for (int n = 0; n < 2; ++n) _Pragma("unroll") for (int k = 0; k < 2; ++k) dst[n][k] = *(const PG8_LAS bf16x8*)(lds + PG8_SB(b, h) + boff + n * 2048 + k * 1024); } while (0)
#define PG8_MMA(ai, bj, At, Bt) do { __builtin_amdgcn_s_setprio(1); _Pragma("unroll") for (int m = 0; m < 4; ++m) _Pragma("unroll") for (int n = 0; n < 2; ++n) _Pragma("unroll") for (int k = 0; k < 2; ++k) \
        acc[ai][bj][m][n] = __builtin_amdgcn_mfma_f32_16x16x32_bf16(Bt[n][k], At[m][k], acc[ai][bj][m][n], 0, 0, 0); __builtin_amdgcn_s_setprio(0); } while (0)
#define PG8_WAIT_V(n) asm volatile("s_waitcnt vmcnt(" #n ")" ::: "memory")
#define PG8_WAIT_L(n) asm volatile("s_waitcnt lgkmcnt(" #n ")" ::: "memory")
#define PG8_BAR __builtin_amdgcn_s_barrier()
#define PG8_SCHED __builtin_amdgcn_sched_barrier(0)
    Unit cur, nxt; int ui = 0;
    if (!S.next(0, cur)) return;
    f32x4 acc[2][2][4][2];
#pragma unroll
    for (int a = 0; a < 2; ++a)
#pragma unroll
        for (int b = 0; b < 2; ++b)
#pragma unroll
            for (int m = 0; m < 4; ++m)
#pragma unroll
                for (int n = 0; n < 2; ++n) acc[a][b][m][n] = (f32x4){0.f, 0.f, 0.f, 0.f};
    bf16x8 At[4][2], B0[2][2], B1[2][2];
    const char* cA = (const char*)g.A + (size_t)cur.pm * tstep; const char* cB = (const char*)g.Bt + (size_t)cur.pn * tstep;
    S.a_ready(cur);
    if constexpr (SP2) {
        PG8_STAGE(PG8_SB(0, 0), cB, voffB); PG8_STAGE(PG8_SB(0, 1), cB + hstep, voffB); PG8_STAGE(PG8_SA(0, 0), cA, voffA); PG8_STAGE(PG8_SA(0, 1), cA + hstep, voffA);
        if (wr == 1) PG8_BAR;
        PG8_WAIT_V(2); PG8_BAR;
        PG8_STAGE(PG8_SB(1, 0), cB + kstep, voffB); PG8_STAGE(PG8_SA(1, 0), cA + kstep, voffA); PG8_STAGE(PG8_SB(1, 1), cB + hstep + kstep, voffB);
        PG8_WAIT_V(6); PG8_BAR;
    } else {
        PG8_STAGE(PG8_SB(0, 0), cB, voffB); PG8_STAGE(PG8_SA(0, 0), cA, voffA); PG8_STAGE(PG8_SB(0, 1), cB + hstep, voffB); PG8_STAGE(PG8_SA(0, 1), cA + hstep, voffA);
        if (wr == 1) PG8_BAR;
        PG8_WAIT_V(4); PG8_BAR;
        PG8_STAGE(PG8_SB(1, 0), cB + kstep, voffB); PG8_STAGE(PG8_SA(1, 0), cA + kstep, voffA); PG8_STAGE(PG8_SB(1, 1), cB + hstep + kstep, voffB);
        PG8_WAIT_V(6); PG8_BAR;
    }
    for (;;) {
        const bool has_next = S.next(ui + 1, nxt);
        const char* nA = has_next ? (const char*)g.A + (size_t)nxt.pm * tstep : cA; const char* nB = has_next ? (const char*)g.Bt + (size_t)nxt.pn * tstep : cB;
        for (int t = 0; t < nt; t += 2) {
            const bool last = (t == nt - 2);
            const char* a1 = cA + (size_t)(t + 1) * kstep;
            const char* a2 = last ? nA : cA + (size_t)(t + 2) * kstep; const char* b2 = last ? nB : cB + (size_t)(t + 2) * kstep;
            const char* a3 = a2 + kstep; const char* b3 = b2 + kstep;
            if (last && has_next) S.a_ready(nxt);
            if constexpr (SP2) {
            PG8_LDB(B0, 0, 0); PG8_LDB(B1, 0, 1); PG8_SCHED; PG8_LDA(At, 0, 0); PG8_STAGE(PG8_SA(1, 1), a1 + hstep, voffA);
            PG8_WAIT_V(8); PG8_WAIT_L(0); PG8_BAR; PG8_MMA(0, 0, At, B0); PG8_MMA(0, 1, At, B1); PG8_BAR; PG8_SCHED;
            PG8_LDA(At, 0, 1); PG8_STAGE(PG8_SB(0, 0), b2, voffB); PG8_STAGE(PG8_SB(0, 1), b2 + hstep, voffB); PG8_STAGE(PG8_SA(0, 0), a2, voffA);
            PG8_WAIT_V(8); PG8_WAIT_L(0); PG8_BAR; PG8_MMA(1, 0, At, B0); PG8_MMA(1, 1, At, B1); PG8_BAR; PG8_SCHED;
            PG8_LDB(B0, 1, 0); PG8_LDB(B1, 1, 1); PG8_SCHED; PG8_LDA(At, 1, 0); PG8_STAGE(PG8_SA(0, 1), a2 + hstep, voffA);
            PG8_WAIT_V(8); PG8_WAIT_L(0); PG8_BAR; PG8_MMA(0, 0, At, B0); PG8_MMA(0, 1, At, B1); PG8_BAR; PG8_SCHED;
            PG8_LDA(At, 1, 1); PG8_STAGE(PG8_SB(1, 0), b3, voffB); PG8_STAGE(PG8_SB(1, 1), b3 + hstep, voffB); PG8_STAGE(PG8_SA(1, 0), a3, voffA);
            PG8_WAIT_V(8); PG8_WAIT_L(0); PG8_BAR; PG8_MMA(1, 0, At, B0); PG8_MMA(1, 1, At, B1); PG8_BAR; PG8_SCHED;
            } else {
            PG8_LDB(B0, 0, 0); PG8_SCHED; PG8_LDA(At, 0, 0); PG8_STAGE(PG8_SA(1, 1), a1 + hstep, voffA);
            PG8_WAIT_L(8); PG8_BAR; PG8_WAIT_L(0); PG8_MMA(0, 0, At, B0); PG8_BAR; PG8_SCHED;
            PG8_LDB(B1, 0, 1); PG8_STAGE(PG8_SB(0, 0), b2, voffB);
            PG8_BAR; PG8_WAIT_L(0); PG8_MMA(0, 1, At, B1); PG8_BAR;
            PG8_LDA(At, 0, 1); PG8_STAGE(PG8_SA(0, 0), a2, voffA);
            PG8_BAR; PG8_WAIT_L(0); PG8_MMA(1, 0, At, B0); PG8_BAR; PG8_SCHED;
            PG8_STAGE(PG8_SB(0, 1), b2 + hstep, voffB);
            PG8_WAIT_V(6); PG8_BAR; PG8_MMA(1, 1, At, B1); PG8_BAR;
            PG8_LDB(B0, 1, 0); PG8_SCHED; PG8_LDA(At, 1, 0); PG8_STAGE(PG8_SA(0, 1), a2 + hstep, voffA);
            PG8_WAIT_L(8); PG8_BAR; PG8_WAIT_L(0); PG8_MMA(0, 0, At, B0); PG8_BAR; PG8_SCHED;
            PG8_LDB(B1, 1, 1); PG8_STAGE(PG8_SB(1, 0), b3, voffB);
            PG8_BAR; PG8_WAIT_L(0); PG8_MMA(0, 1, At, B1); PG8_BAR;
            PG8_LDA(At, 1, 1); PG8_STAGE(PG8_SA(1, 0), a3, voffA);
            PG8_BAR; PG8_WAIT_L(0); PG8_MMA(1, 0, At, B0); PG8_BAR; PG8_SCHED;
            PG8_STAGE(PG8_SB(1, 1), b3 + hstep, voffB);
            PG8_WAIT_V(6); PG8_BAR; PG8_MMA(1, 1, At, B1); PG8_BAR;
            }
        }
        if constexpr (ALIGN_EPI) { if (wr == 0) PG8_BAR; }
        if constexpr (!Epi::AFTER_DRAIN) { E(acc, cur, wr, wc, fr, fq); S.done(cur); }
        if (!has_next) break;
#pragma unroll
        for (int a = 0; a < 2; ++a)
#pragma unroll
            for (int b = 0; b < 2; ++b)
#pragma unroll
                for (int m = 0; m < 4; ++m)
#pragma unroll
                    for (int n = 0; n < 2; ++n) acc[a][b][m][n] = (f32x4){0.f, 0.f, 0.f, 0.f};
        cur = nxt; cA = nA; cB = nB; ++ui;
        if constexpr (ALIGN_EPI) { if (wr == 1) PG8_BAR; }
    }
    PG8_WAIT_V(0);
    if constexpr (!ALIGN_EPI) { if (wr == 0) PG8_BAR; }
    PG8_BAR;
    if constexpr (Epi::AFTER_DRAIN) { E.fused(acc, cur, wr, wc, fr, fq, lds, wid, lane); S.done(cur); }
#undef PG8_SA
#undef PG8_SB
#undef PG8_STAGE
#undef PG8_LDA
#undef PG8_LDB
#undef PG8_MMA
#undef PG8_WAIT_V
#undef PG8_WAIT_L
#undef PG8_BAR
#undef PG8_SCHED
}
}

#ifndef PG8_SP2
#define PG8_SP2 true
#endif
#ifndef MK_PER_PHASE
#define MK_PER_PHASE 0
#endif

namespace mk {
using pg8::bf16x8; using pg8::f32x4; using pg8::u32x4; using pg8::Unit; using pg8::Gemm; using pg8::StaticOrder;
typedef unsigned short bf16;
typedef float f32x16 __attribute__((ext_vector_type(16)));
typedef unsigned u32x2 __attribute__((ext_vector_type(2)));
typedef float f32x2_t __attribute__((ext_vector_type(2)));
typedef __bf16 bf16x2_t __attribute__((ext_vector_type(2)));
#define LAS __attribute__((address_space(3)))
#define LDS_WAIT() asm volatile("s_waitcnt lgkmcnt(0)" ::: "memory")

#define XB_TMO      128
#define XB_XCNT(j)  (256  + 64 * (j))
#define XB_XSUB(j)  (1280 + 64 * (j))
#define XB_XGEN(j)  (2304 + 64 * (j))
#define XB_TOP      3328
#define XB_TOPGEN   3392
#define XCD_BAR_WORDS 3456
#define XB_SPIN_CAP (1u << 18)

__device__ __forceinline__ unsigned xb_ld(unsigned* p)              { return __hip_atomic_load(p, __ATOMIC_RELAXED, __HIP_MEMORY_SCOPE_AGENT); }
__device__ __forceinline__ unsigned xb_add(unsigned* p, unsigned v) { return __hip_atomic_fetch_add(p, v, __ATOMIC_RELAXED, __HIP_MEMORY_SCOPE_AGENT); }
__device__ __forceinline__ unsigned xb_xcc_id() { return (unsigned)__builtin_amdgcn_s_getreg((3 << 11) | 20) & 0xFu; }
#define XB_SPIN(cond, bar) do { unsigned _sp = 0; while (cond) { __builtin_amdgcn_s_sleep(1); \
    if ((++_sp & 255u) == 0u) { if (xb_ld(&(bar)[XB_TMO])) break; if (_sp > XB_SPIN_CAP) { atomicAdd(&(bar)[XB_TMO], 1u); break; } } } } while (0)

struct XcdBarrier {
    unsigned* bar; unsigned x;
    volatile LAS unsigned* st;
};

__device__ __forceinline__ XcdBarrier xcd_barrier_post(unsigned* bar, volatile LAS unsigned* st, const int tid) {
    XcdBarrier b; b.bar = bar; b.x = xb_xcc_id(); b.st = st;
    if (tid == 0) (void)xb_add(&bar[XB_XCNT(b.x)], 1u);
    return b;
}
__device__ __forceinline__ void xcd_barrier_complete(unsigned* bar, unsigned x, unsigned& nloc, unsigned& nx) {
    const unsigned G = gridDim.x * gridDim.y * gridDim.z;
    unsigned sum, cnt, mine, sp = 0u;
    for (;;) {
        sum = 0u; cnt = 0u; mine = 0u;
#pragma unroll
        for (unsigned j = 0; j < 16; ++j) { const unsigned c = xb_ld(&bar[XB_XCNT(j)]); sum += c; cnt += (c > 0u) ? 1u : 0u; mine = (j == x) ? c : mine; }
        if (sum == G) break;
        __builtin_amdgcn_s_sleep(1);
        if ((++sp & 255u) == 0u) { if (xb_ld(&bar[XB_TMO])) break; if (sp > XB_SPIN_CAP) { atomicAdd(&bar[XB_TMO], 1u); break; } }
    }
    nloc = mine > 0u ? mine : 1u; nx = cnt > 0u ? cnt : 1u;
}

__device__ __forceinline__ void xcd_barrier(const XcdBarrier& b, const int tid) {
    asm volatile("s_waitcnt vmcnt(0)" ::: "memory");
    __syncthreads();
    if (tid == 0) {
        unsigned* bar = b.bar;
        __builtin_amdgcn_s_waitcnt(0);
        unsigned nloc = b.st[0], nx = b.st[1];
        if (nloc == 0u) { xcd_barrier_complete(bar, b.x, nloc, nx); b.st[0] = nloc; b.st[1] = nx; }
        const unsigned old = xb_add(&bar[XB_XSUB(b.x)], 1u);
        const unsigned gen = old / nloc;
        if (old + 1u == (gen + 1u) * nloc) {
            __builtin_amdgcn_fence(__ATOMIC_RELEASE, "agent");
            asm volatile("s_waitcnt vmcnt(0)" ::: "memory");
            const unsigned og = xb_add(&bar[XB_TOP], 1u);
            const unsigned tg = og / nx;
            if (og + 1u == (tg + 1u) * nx) xb_add(&bar[XB_TOPGEN], 1u);
            else XB_SPIN(xb_ld(&bar[XB_TOPGEN]) == tg, bar);
            __builtin_amdgcn_fence(__ATOMIC_ACQUIRE, "agent");
            xb_add(&bar[XB_XGEN(b.x)], 1u);
            asm volatile("s_waitcnt vmcnt(0)" ::: "memory");
        } else {
            XB_SPIN(xb_ld(&bar[XB_XGEN(b.x)]) == gen, bar);
            __builtin_amdgcn_fence(__ATOMIC_ACQUIRE, "agent");
            asm volatile("s_waitcnt vmcnt(0)" ::: "memory");
        }
    }
    __syncthreads();
}

constexpr int NB = 4, SEQ = 8192, DM = 1024, MTOK = NB * SEQ, DFF = 2816;
constexpr float EPS = 1e-6f, NEGF = -1e30f;
constexpr int NPHASE = 15;
constexpr int NWAVES = 8;
constexpr size_t MiB = 1u << 20;
constexpr size_t SZ_WGU = (size_t)5632 * 1024 * 2, SZ_WD = (size_t)1024 * 2816 * 2, SZ_WIN = (size_t)3840 * 1024 * 2;
constexpr size_t O_WGU1 = 0, O_WD1 = O_WGU1 + SZ_WGU, O_WGU2 = O_WD1 + SZ_WD, O_WD2 = O_WGU2 + SZ_WGU, O_WIN = O_WD2 + SZ_WD,
                 O_WPN = O_WIN + SZ_WIN, O_WPM = O_WPN + MiB, O_WOUT = O_WPM + MiB, O_WUQ = O_WOUT + 2 * MiB, O_WUKV = O_WUQ + 768 * 256 * 2,
                 O_CW1K = O_WUKV + 1024 * 128 * 2, O_CW1V = O_CW1K + MiB, O_WEND = O_CW1V + MiB;
static_assert(O_WEND <= 48 * MiB - 16384, "weights");
constexpr size_t O_CTL = 48 * MiB - 16384;
constexpr size_t O_A1 = 48 * MiB;
constexpr size_t O_IM2K = 48 * MiB, O_IM2V = 64 * MiB, O_CQN = 80 * MiB, O_CKVN = 96 * MiB, O_KR = 104 * MiB, O_HK = 106 * MiB, O_HV = 108 * MiB,
                 O_KC = 110 * MiB, O_VCT = 110 * MiB + 512 * 1024;
constexpr size_t O_ROPE = 111 * MiB;
constexpr size_t O_MG = 48 * MiB;
constexpr size_t O_H = 112 * MiB;
constexpr size_t O_Z1 = 112 * MiB, O_QN = 192 * MiB, O_YM = 224 * MiB, O_KM = 256 * MiB;
constexpr size_t O_X2B = 352 * MiB;
constexpr size_t O_F = 288 * MiB, O_GM = 288 * MiB;
constexpr size_t O_QM = 416 * MiB, O_VTM = 464 * MiB, O_VTS = 496 * MiB, O_VTW = 504 * MiB, O_END = 512 * MiB;
constexpr int Z1P = 1280;
constexpr int LDS_BYTES = 147456;
constexpr int L_KB = 0, KB_SZ = 13312, L_VB = 4 * KB_SZ, VB_SZ = 8704, L_IMP = L_VB + 4 * VB_SZ, IMP_P = 132, L_SELM = L_IMP + 64 * IMP_P * 4, L_WUN = L_SELM + 1024, L_ATT_END = L_WUN + 128;
static_assert(L_ATT_END <= 131072, "attention LDS");

__device__ __forceinline__ int mk_lane() { int l; asm volatile("v_mbcnt_lo_u32_b32 %0, -1, 0\n\tv_mbcnt_hi_u32_b32 %0, -1, %0" : "=v"(l)); return l; }
__device__ __forceinline__ void grid_barrier(unsigned* ctr, unsigned target, int tid) {
    asm volatile("s_waitcnt vmcnt(0)" ::: "memory");
    __syncthreads();
    if (tid == 0) {
        __builtin_amdgcn_fence(__ATOMIC_RELEASE, "agent");
        asm volatile("s_waitcnt vmcnt(0)" ::: "memory");
        __hip_atomic_fetch_add(ctr, 1u, __ATOMIC_RELAXED, __HIP_MEMORY_SCOPE_AGENT);
        while (__hip_atomic_load(ctr, __ATOMIC_RELAXED, __HIP_MEMORY_SCOPE_AGENT) < target) __builtin_amdgcn_s_sleep(2);
        __builtin_amdgcn_fence(__ATOMIC_ACQUIRE, "agent");
        asm volatile("s_waitcnt vmcnt(0)" ::: "memory");
    }
    __syncthreads();
}
__device__ __forceinline__ unsigned cvtpk(float lo, float hi) { f32x2_t v = {lo, hi}; bf16x2_t b = __builtin_convertvector(v, bf16x2_t); return __builtin_bit_cast(unsigned, b); }
__device__ __forceinline__ float bflo(unsigned w) { return __builtin_bit_cast(float, w << 16); }
__device__ __forceinline__ float bfhi(unsigned w) { return __builtin_bit_cast(float, w & 0xffff0000u); }
__device__ __forceinline__ float bf2f(bf16 b) { return __builtin_bit_cast(float, (unsigned)b << 16); }
__device__ __forceinline__ bf16 f2bf(float f) { return (bf16)(cvtpk(f, 0.f) & 0xffffu); }
__device__ __forceinline__ float wave_sum(float v) {
#pragma unroll
    for (int o = 1; o < 64; o <<= 1) v += __shfl_xor(v, o);
    return v;
}
__device__ __forceinline__ float sigmoidf(float x) { return __builtin_amdgcn_rcpf(1.f + __builtin_amdgcn_exp2f(-1.4426950408889634f * x)); }
__device__ __forceinline__ float gelu_tanh(float x) { const float u = 0.7978845608028654f * (x + 0.044715f * x * x * x); const float t = 1.f - 2.f * __builtin_amdgcn_rcpf(__builtin_amdgcn_exp2f(2.8853900817779268f * u) + 1.f); return 0.5f * x * (1.f + t); }
__device__ __forceinline__ void rope_cs(int pos, int j, float& c, float& s) {
    const float freq = __builtin_amdgcn_exp2f(-(float)j * 0.8304820237218406f);
    const float ang = (float)pos * freq;
    double rev = (double)ang * 0.15915494309189535; rev -= __builtin_rint(rev);
    const float fr = (float)rev;
    s = __builtin_amdgcn_sinf(fr); c = __builtin_amdgcn_cosf(fr);
}

struct MapPlain { __device__ __forceinline__ int col(int r) const { return r; } __device__ __forceinline__ int drow(int r) const { return r; } };
struct MapGU { int sel; __device__ __forceinline__ int col(int r) const { return r; } __device__ __forceinline__ int drow(int r) const { return (r >> 7) * 256 + sel * 128 + (r & 127); } };
struct MapWin { __device__ __forceinline__ int drow(int r) const { return r; } __device__ __forceinline__ int col(int r) const {
    int col;
    if (r < 1280) col = r; else if (r < 1536) col = 1304 + (r - 1280); else if (r < 1664) col = 1560 + (r - 1536); else if (r < 1696) col = 1688 + (r - 1664);
    else if (r < 1720) col = 1280 + (r - 1696); else if (r < 1792) col = -1; else col = 1720 + (r - 1792);
    return col; } };
struct MapUkv { __device__ __forceinline__ int drow(int r) const { return r; } __device__ __forceinline__ int col(int r) const {
    if (r < 512) return (r >> 6) * 128 + (r & 63); const int rr = r - 512; return (rr >> 6) * 128 + 64 + (rr & 63); } };
template <class Map> __device__ __forceinline__ void transpose_mat(const float* W, int N, const Map mp, int K, int Nvirt, bf16* WT, LAS float* scr, int gw, int NGW, int lane) {
    const int nblk = Nvirt / 32, nitems = (K / 64) * nblk;
    const int c4 = lane & 7, rr = lane >> 3;
    f32x4 ld[8];
    int it = gw;
#define TR_LOAD(itv) do { const int kb_ = (itv) / nblk, nb_ = (itv) % nblk; const int col_ = mp.col(32 * nb_ + 4 * c4); \
        _Pragma("unroll") for (int i = 0; i < 8; ++i) ld[i] = (col_ >= 0) ? *(const f32x4*)(W + (size_t)(64 * kb_ + 8 * i + rr) * N + col_) : (f32x4){0.f, 0.f, 0.f, 0.f}; } while (0)
    if (it < nitems) TR_LOAD(it);
    for (; it < nitems; it += NGW) {
        const int kb = it / nblk, nb = it % nblk, k0 = 64 * kb, n0 = 32 * nb;
#pragma unroll
        for (int i = 0; i < 8; ++i) { LAS float* d = scr + (8 * i + rr) * 33 + 4 * c4; d[0] = ld[i].x; d[1] = ld[i].y; d[2] = ld[i].z; d[3] = ld[i].w; }
        LDS_WAIT();
        if (it + NGW < nitems) TR_LOAD(it + NGW);
        const int c = lane & 7;
#pragma unroll
        for (int j = 0; j < 4; ++j) { const int n = (lane >> 3) + 8 * j; const LAS float* s = scr + (8 * c) * 33 + n;
            u32x4 o; o.x = cvtpk(s[0 * 33], s[1 * 33]); o.y = cvtpk(s[2 * 33], s[3 * 33]); o.z = cvtpk(s[4 * 33], s[5 * 33]); o.w = cvtpk(s[6 * 33], s[7 * 33]);
            *(u32x4*)(WT + (size_t)mp.drow(n0 + n) * K + k0 + 8 * c) = o; }
        LDS_WAIT();
    }
#undef TR_LOAD
}

__device__ __forceinline__ void load_gain(f32x4 (&g)[4], const float* gain, int lane) {
#pragma unroll
    for (int j = 0; j < 2; ++j) { g[2 * j] = *(const f32x4*)(gain + 512 * j + 8 * lane); g[2 * j + 1] = *(const f32x4*)(gain + 512 * j + 8 * lane + 4); }
}
__device__ __forceinline__ void unpack8(const u32x4 w, f32x4& a, f32x4& b) { a.x = bflo(w.x); a.y = bfhi(w.x); a.z = bflo(w.y); a.w = bfhi(w.y); b.x = bflo(w.z); b.y = bfhi(w.z); b.z = bflo(w.w); b.w = bfhi(w.w); }
__device__ __forceinline__ u32x4 pack8(const f32x4 a, const f32x4 b) { u32x4 w; w.x = cvtpk(a.x, a.y); w.y = cvtpk(a.z, a.w); w.z = cvtpk(b.x, b.y); w.w = cvtpk(b.z, b.w); return w; }
__device__ __forceinline__ void rms_row_to_bf16(const f32x4 (&v)[4], const f32x4 (&gain)[4], bf16* orow, int lane) {
    float ss = 0.f;
#pragma unroll
    for (int j = 0; j < 4; ++j) ss += (v[j].x * v[j].x + v[j].y * v[j].y) + (v[j].z * v[j].z + v[j].w * v[j].w);
    const float r = rsqrtf(wave_sum(ss) * (1.f / DM) + EPS);
#pragma unroll
    for (int j = 0; j < 2; ++j) *(u32x4*)(orow + 512 * j + 8 * lane) = pack8(v[2 * j] * r * gain[2 * j], v[2 * j + 1] * r * gain[2 * j + 1]);
}
template <bool BASE_BF16> __device__ __forceinline__ void rowop_load(int m, const bf16* Fb, const void* base, f32x4 (&v)[4], f32x4 (&bs)[4], int lane) {
#pragma unroll
    for (int j = 0; j < 2; ++j) { unpack8(*(const u32x4*)(Fb + (size_t)m * DM + 512 * j + 8 * lane), v[2 * j], v[2 * j + 1]);
        if (BASE_BF16) unpack8(*(const u32x4*)((const bf16*)base + (size_t)m * DM + 512 * j + 8 * lane), bs[2 * j], bs[2 * j + 1]);
        else { const float* bp = (const float*)base + (size_t)m * DM + 512 * j + 8 * lane; bs[2 * j] = *(const f32x4*)bp; bs[2 * j + 1] = *(const f32x4*)(bp + 4); } }
}
template <bool OUT_BF16, bool NEXT> __device__ __forceinline__ void rowop_finish(int m, f32x4 (&v)[4], const f32x4 (&bs)[4], float coef, const f32x4 (&gpost)[4], void* xout, const f32x4 (&gnext)[4], bf16* A1, int lane) {
    float ss = 0.f;
#pragma unroll
    for (int j = 0; j < 4; ++j) ss += (v[j].x * v[j].x + v[j].y * v[j].y) + (v[j].z * v[j].z + v[j].w * v[j].w);
    const float r = rsqrtf(wave_sum(ss) * (1.f / DM) + EPS) * coef;
#pragma unroll
    for (int j = 0; j < 4; ++j) v[j] = bs[j] + v[j] * r * gpost[j];
#pragma unroll
    for (int j = 0; j < 2; ++j) {
        if (OUT_BF16) *(u32x4*)((bf16*)xout + (size_t)m * DM + 512 * j + 8 * lane) = pack8(v[2 * j], v[2 * j + 1]);
        else { float* op = (float*)xout + (size_t)m * DM + 512 * j + 8 * lane; *(f32x4*)op = v[2 * j]; *(f32x4*)(op + 4) = v[2 * j + 1]; } }
    if (NEXT) rms_row_to_bf16(v, gnext, A1 + (size_t)m * DM, lane);
}
template <bool BASE_BF16, bool OUT_BF16, bool NEXT> __device__ __forceinline__ void rowop(const bf16* Fb, const void* base, float coef, const float* gpost_p, void* xout, const float* gnext_p, bf16* A1, int gw, int NGW, int lane) {
    f32x4 gpost[4], gnext[4];
    load_gain(gpost, gpost_p, lane); if (NEXT) load_gain(gnext, gnext_p, lane); else load_gain(gnext, gpost_p, lane);
    for (int m = gw; m < MTOK; m += 2 * NGW) {
        const int m2 = m + NGW; const bool two = m2 < MTOK;
        f32x4 vA[4], bA[4], vB[4], bB[4];
        rowop_load<BASE_BF16>(m, Fb, base, vA, bA, lane);
        if (two) rowop_load<BASE_BF16>(m2, Fb, base, vB, bB, lane);
        rowop_finish<OUT_BF16, NEXT>(m, vA, bA, coef, gpost, xout, gnext, A1, lane);
        if (two) rowop_finish<OUT_BF16, NEXT>(m2, vB, bB, coef, gpost, xout, gnext, A1, lane);
    }
}

#define EPI_ROW(ai, m) ((size_t)u.pm * 256 + (ai) * 128 + wr * 64 + (m) * 16 + fr)
#define EPI_CIN(bj, n) ((bj) * 128 + wc * 32 + (n) * 16 + fq * 4)
#define EPI_C8(bj) ((bj) * 128 + wc * 32 + fq * 8)
struct EpiSwiglu { static constexpr bool PERM = true, AFTER_DRAIN = false; bf16* H;
    __device__ __forceinline__ void operator()(const f32x4 (&acc)[2][2][4][2], const Unit& u, int wr, int wc, int fr, int fq) const {
#pragma unroll
        for (int ai = 0; ai < 2; ++ai)
#pragma unroll
            for (int m = 0; m < 4; ++m) { bf16* rp = H + EPI_ROW(ai, m) * DFF + u.pn * 128 + wc * 32 + fq * 8; float v[8];
#pragma unroll
                for (int n = 0; n < 2; ++n) { const f32x4 g = acc[ai][0][m][n], up = acc[ai][1][m][n];
#pragma unroll
                    for (int e = 0; e < 4; ++e) v[4 * n + e] = g[e] * __builtin_amdgcn_rcpf(1.f + __builtin_amdgcn_exp2f(-1.4426950408889634f * g[e])) * up[e]; }
                u32x4 w; w.x = cvtpk(v[0], v[1]); w.y = cvtpk(v[2], v[3]); w.z = cvtpk(v[4], v[5]); w.w = cvtpk(v[6], v[7]); *(u32x4*)rp = w; }
    }
};
struct EpiF32 { static constexpr bool PERM = true, AFTER_DRAIN = false; bf16* Fb; int ldc;
    __device__ __forceinline__ void operator()(const f32x4 (&acc)[2][2][4][2], const Unit& u, int wr, int wc, int fr, int fq) const {
#pragma unroll
        for (int ai = 0; ai < 2; ++ai)
#pragma unroll
            for (int m = 0; m < 4; ++m) { bf16* rp = Fb + EPI_ROW(ai, m) * ldc + u.pn * 256;
#pragma unroll
                for (int bj = 0; bj < 2; ++bj) { const f32x4 v0 = acc[ai][bj][m][0], v1 = acc[ai][bj][m][1];
                    u32x4 w; w.x = cvtpk(v0[0], v0[1]); w.y = cvtpk(v0[2], v0[3]); w.z = cvtpk(v1[0], v1[1]); w.w = cvtpk(v1[2], v1[3]); *(u32x4*)(rp + EPI_C8(bj)) = w; } }
    }
};
struct EpiWin { static constexpr bool PERM = true, AFTER_DRAIN = false; bf16* QN; bf16* Z1; bf16* GM; bf16* VTS; bf16* VTW;
    __device__ __forceinline__ void operator()(const f32x4 (&acc)[2][2][4][2], const Unit& u, int wr, int wc, int fr, int fq) const {
        const int pn = u.pn;
#pragma unroll
        for (int ai = 0; ai < 2; ++ai)
#pragma unroll
            for (int m = 0; m < 4; ++m) { const size_t row = EPI_ROW(ai, m);
#pragma unroll
                for (int bj = 0; bj < 2; ++bj) { const int c8 = EPI_C8(bj); f32x4 v0 = acc[ai][bj][m][0], v1 = acc[ai][bj][m][1];
                    if ((pn == 3 || pn == 4) && bj == 1) {
                        bf16* vt = (pn == 3) ? VTS : VTW; const int b = (int)(row >> 13), s = (int)(row & 8191), cv = c8 - 128;
#pragma unroll
                        for (int e = 0; e < 4; ++e) { vt[((size_t)(b * 128 + cv + e)) * SEQ + s] = f2bf(v0[e]); vt[((size_t)(b * 128 + cv + 4 + e)) * SEQ + s] = f2bf(v1[e]); }
                    } else {
                        bf16* dst;
                        if (pn < 2) { dst = QN + row * 512 + pn * 256 + c8; v0 = v0 * 0.18033688011112042f; v1 = v1 * 0.18033688011112042f; }
                        else if (pn < 7) dst = Z1 + row * Z1P + (pn - 2) * 256 + c8;
                        else dst = nullptr;
                        if (pn < 7) { u32x4 w; w.x = cvtpk(v0[0], v0[1]); w.y = cvtpk(v0[2], v0[3]); w.z = cvtpk(v1[0], v1[1]); w.w = cvtpk(v1[2], v1[3]); *(u32x4*)dst = w; }
                        else {
                            unsigned lo = 0u, hi2 = 0u;
                            lo = __builtin_amdgcn_cvt_pk_u8_f32(sigmoidf(v0[0]) * 255.f, 0, lo); lo = __builtin_amdgcn_cvt_pk_u8_f32(sigmoidf(v0[1]) * 255.f, 1, lo);
                            lo = __builtin_amdgcn_cvt_pk_u8_f32(sigmoidf(v0[2]) * 255.f, 2, lo); lo = __builtin_amdgcn_cvt_pk_u8_f32(sigmoidf(v0[3]) * 255.f, 3, lo);
                            hi2 = __builtin_amdgcn_cvt_pk_u8_f32(sigmoidf(v1[0]) * 255.f, 0, hi2); hi2 = __builtin_amdgcn_cvt_pk_u8_f32(sigmoidf(v1[1]) * 255.f, 1, hi2);
                            hi2 = __builtin_amdgcn_cvt_pk_u8_f32(sigmoidf(v1[2]) * 255.f, 2, hi2); hi2 = __builtin_amdgcn_cvt_pk_u8_f32(sigmoidf(v1[3]) * 255.f, 3, hi2);
                            u32x2 w; w.x = lo; w.y = hi2; *(u32x2*)((unsigned char*)GM + row * 2048 + (pn - 7) * 256 + c8) = w; }
                    } } }
    }
};
struct EpiGelu { static constexpr bool PERM = false, AFTER_DRAIN = false; bf16* O; int ldc;
    __device__ __forceinline__ void operator()(const f32x4 (&acc)[2][2][4][2], const Unit& u, int wr, int wc, int fr, int fq) const {
#pragma unroll
        for (int ai = 0; ai < 2; ++ai)
#pragma unroll
            for (int m = 0; m < 4; ++m) { bf16* rp = O + EPI_ROW(ai, m) * ldc + u.pn * 256;
#pragma unroll
                for (int bj = 0; bj < 2; ++bj)
#pragma unroll
                    for (int n = 0; n < 2; ++n) { const f32x4 v = acc[ai][bj][m][n];
                        u32x2 w; w.x = cvtpk(gelu_tanh(v[0]), gelu_tanh(v[1])); w.y = cvtpk(gelu_tanh(v[2]), gelu_tanh(v[3])); *(u32x2*)(rp + EPI_CIN(bj, n)) = w; } }
    }
};
struct EpiQup { static constexpr bool PERM = false, AFTER_DRAIN = false; bf16* QM;
    __device__ __forceinline__ void operator()(const f32x4 (&acc)[2][2][4][2], const Unit& u, int wr, int wc, int fr, int fq) const {
        const float sc = 0.14724445614104196f;
#pragma unroll
        for (int ai = 0; ai < 2; ++ai)
#pragma unroll
            for (int m = 0; m < 4; ++m) { bf16* rp = QM + EPI_ROW(ai, m) * 768 + u.pn * 256;
#pragma unroll
                for (int bj = 0; bj < 2; ++bj)
#pragma unroll
                    for (int n = 0; n < 2; ++n) { const f32x4 v = acc[ai][bj][m][n] * sc;
                        u32x2 w; w.x = cvtpk(v[0], v[1]); w.y = cvtpk(v[2], v[3]); *(u32x2*)(rp + EPI_CIN(bj, n)) = w; } }
    }
};
struct EpiKVup { static constexpr bool PERM = false, AFTER_DRAIN = false; bf16* KM; bf16* VTM;
    __device__ __forceinline__ void operator()(const f32x4 (&acc)[2][2][4][2], const Unit& u, int wr, int wc, int fr, int fq) const {
        const int pn = u.pn;
#pragma unroll
        for (int ai = 0; ai < 2; ++ai)
#pragma unroll
            for (int m = 0; m < 4; ++m) { const size_t row = EPI_ROW(ai, m);
#pragma unroll
                for (int bj = 0; bj < 2; ++bj)
#pragma unroll
                    for (int n = 0; n < 2; ++n) { const int cin = EPI_CIN(bj, n); const f32x4 v = acc[ai][bj][m][n];
                        if (pn < 2) { u32x2 w; w.x = cvtpk(v[0], v[1]); w.y = cvtpk(v[2], v[3]); *(u32x2*)(KM + row * 512 + pn * 256 + cin) = w; }
                        else { const int b = (int)(row >> 13), s = (int)(row & 8191), cv = (pn - 2) * 256 + cin;
#pragma unroll
                            for (int e = 0; e < 4; ++e) VTM[((size_t)(b * 512 + cv + e)) * SEQ + s] = f2bf(v[e]); } } }
    }
};
template <bool SECOND> struct EpiProj { static constexpr bool PERM = true, AFTER_DRAIN = false; const bf16* GM; bf16* MG;
    __device__ __forceinline__ void operator()(const f32x4 (&acc)[2][2][4][2], const Unit& u, int wr, int wc, int fr, int fq) const {
#pragma unroll
        for (int ai = 0; ai < 2; ++ai) {
            u32x2 gwv[4][2]; u32x4 pwv[4][2];
#pragma unroll
            for (int m = 0; m < 4; ++m) { const size_t row = EPI_ROW(ai, m);
#pragma unroll
                for (int bj = 0; bj < 2; ++bj) { const int col = u.pn * 256 + EPI_C8(bj);
                    gwv[m][bj] = *(const u32x2*)((const unsigned char*)GM + row * 2048 + (SECOND ? 1024 : 0) + col);
                    if (SECOND) pwv[m][bj] = *(const u32x4*)(MG + row * DM + col); } }
#pragma unroll
            for (int m = 0; m < 4; ++m) { const size_t row = EPI_ROW(ai, m);
#pragma unroll
                for (int bj = 0; bj < 2; ++bj) { const int col = u.pn * 256 + EPI_C8(bj); const f32x4 v0 = acc[ai][bj][m][0], v1 = acc[ai][bj][m][1];
                    const u32x2 gw = gwv[m][bj]; const float q8 = 1.f / 255.f;
                    float o0 = (float)(gw.x & 255u) * q8 * v0[0], o1 = (float)((gw.x >> 8) & 255u) * q8 * v0[1], o2 = (float)((gw.x >> 16) & 255u) * q8 * v0[2], o3 = (float)(gw.x >> 24) * q8 * v0[3];
                    float o4 = (float)(gw.y & 255u) * q8 * v1[0], o5 = (float)((gw.y >> 8) & 255u) * q8 * v1[1], o6 = (float)((gw.y >> 16) & 255u) * q8 * v1[2], o7 = (float)(gw.y >> 24) * q8 * v1[3];
                    if (SECOND) { const u32x4 pw = pwv[m][bj]; o0 += bflo(pw.x); o1 += bfhi(pw.x); o2 += bflo(pw.y); o3 += bfhi(pw.y); o4 += bflo(pw.z); o5 += bfhi(pw.z); o6 += bflo(pw.w); o7 += bfhi(pw.w); }
                    u32x4 w; w.x = cvtpk(o0, o1); w.y = cvtpk(o2, o3); w.z = cvtpk(o4, o5); w.w = cvtpk(o6, o7); *(u32x4*)(MG + row * DM + col) = w; } }
        }
    }
};

__device__ __forceinline__ int crow(int r, int hi) { return (r & 3) + 8 * (r >> 2) + 4 * hi; }
template <int ND0> __device__ __forceinline__ f32x16 qk_sub(const LAS char* Kt, int pitch, int sub, const bf16x8* qr, const f32x16& cin, int r32, int hi) {
    f32x16 acc = cin;
    const LAS char* kb = Kt + (sub * 32 + r32) * pitch + hi * 16;
#pragma unroll
    for (int d0 = 0; d0 < ND0; ++d0) { const bf16x8 kf = *(const LAS bf16x8*)(kb + d0 * 32); acc = __builtin_amdgcn_mfma_f32_32x32x16_bf16(kf, qr[d0], acc, 0, 0, 0); }
    return acc;
}
__device__ __forceinline__ void fill16(f32x16& a, float v) {
#pragma unroll
    for (int r = 0; r < 16; ++r) a[r] = v;
}
__device__ __forceinline__ void pv_sub(f32x16& o0, f32x16& o1, const LAS char* Vt, int sub, const f32x16& p, int r32, int hi) {
#pragma unroll
    for (int j = 0; j < 2; ++j) {
        u32x4 pw; pw.x = cvtpk(p[8 * j + 0], p[8 * j + 1]); pw.y = cvtpk(p[8 * j + 2], p[8 * j + 3]); pw.z = cvtpk(p[8 * j + 4], p[8 * j + 5]); pw.w = cvtpk(p[8 * j + 6], p[8 * j + 7]);
        const bf16x8 pb = __builtin_bit_cast(bf16x8, pw);
#pragma unroll
        for (int dblk = 0; dblk < 2; ++dblk) {
            const LAS char* vp = Vt + (32 * dblk + r32) * 136 + (32 * sub + 16 * j + 4 * hi) * 2;
            const u32x2 lo = *(const LAS u32x2*)vp, h2 = *(const LAS u32x2*)(vp + 16);
            u32x4 vw; vw.x = lo.x; vw.y = lo.y; vw.z = h2.x; vw.w = h2.y;
            const bf16x8 vf = __builtin_bit_cast(bf16x8, vw);
            if (dblk == 0) o0 = __builtin_amdgcn_mfma_f32_32x32x16_bf16(vf, pb, o0, 0, 0, 0); else o1 = __builtin_amdgcn_mfma_f32_32x32x16_bf16(vf, pb, o1, 0, 0, 0);
        }
    }
}
template <int ND0> __device__ __forceinline__ void qk_pair(f32x16& s0, f32x16& s1, const LAS char* Kt, int pitch, const bf16x8* qr, const f32x16& cin, int r32, int hi) {
    bf16x8 kf[2 * ND0];
    const LAS char* kb = Kt + r32 * pitch + hi * 16;
#pragma unroll
    for (int i = 0; i < 2 * ND0; ++i) kf[i] = *(const LAS bf16x8*)(kb + (i / ND0) * 32 * pitch + (i % ND0) * 32);
#pragma unroll
    for (int g = 0; g < ND0; ++g) {
        s0 = __builtin_amdgcn_mfma_f32_32x32x16_bf16(kf[g], qr[g], g == 0 ? cin : s0, 0, 0, 0);
        s1 = __builtin_amdgcn_mfma_f32_32x32x16_bf16(kf[ND0 + g], qr[g], g == 0 ? cin : s1, 0, 0, 0);
    }
}
__device__ __forceinline__ void pv_tile(f32x16& o0, f32x16& o1, const LAS char* Vt, const f32x16& p0, const f32x16& p1, int r32, int hi) {
    bf16x8 vf[8];
#pragma unroll
    for (int i = 0; i < 8; ++i) { const int sub = i >> 2, j = (i >> 1) & 1, dblk = i & 1;
        const LAS char* vp = Vt + (32 * dblk + r32) * 136 + (32 * sub + 16 * j + 4 * hi) * 2;
        const u32x2 lo = *(const LAS u32x2*)vp, h2 = *(const LAS u32x2*)(vp + 16);
        u32x4 vw; vw.x = lo.x; vw.y = lo.y; vw.z = h2.x; vw.w = h2.y; vf[i] = __builtin_bit_cast(bf16x8, vw); }
#pragma unroll
    for (int i = 0; i < 4; ++i) { const int sub = i >> 1, j = i & 1;
        u32x4 pw;
        if (sub == 0) { pw.x = cvtpk(p0[8 * j + 0], p0[8 * j + 1]); pw.y = cvtpk(p0[8 * j + 2], p0[8 * j + 3]); pw.z = cvtpk(p0[8 * j + 4], p0[8 * j + 5]); pw.w = cvtpk(p0[8 * j + 6], p0[8 * j + 7]); }
        else { pw.x = cvtpk(p1[8 * j + 0], p1[8 * j + 1]); pw.y = cvtpk(p1[8 * j + 2], p1[8 * j + 3]); pw.z = cvtpk(p1[8 * j + 4], p1[8 * j + 5]); pw.w = cvtpk(p1[8 * j + 6], p1[8 * j + 7]); }
        const bf16x8 pb = __builtin_bit_cast(bf16x8, pw);
        o0 = __builtin_amdgcn_mfma_f32_32x32x16_bf16(vf[2 * i], pb, o0, 0, 0, 0);
        o1 = __builtin_amdgcn_mfma_f32_32x32x16_bf16(vf[2 * i + 1], pb, o1, 0, 0, 0);
    }
}
__device__ __forceinline__ float max3f(float a, float b, float c) { float r; asm("v_max3_f32 %0, %1, %2, %3" : "=v"(r) : "v"(a), "v"(b), "v"(c)); return r; }
__device__ __forceinline__ float rowmax32(const f32x16& s0, const f32x16& s1) {
    float a = max3f(s0[0], s0[1], s1[0]), b = max3f(s0[2], s0[3], s1[1]); a = max3f(a, s1[2], s1[3]);
#pragma unroll
    for (int r = 4; r < 16; r += 4) { a = max3f(a, s0[r], s0[r + 1]); b = max3f(b, s0[r + 2], s0[r + 3]); a = max3f(a, s1[r], s1[r + 1]); b = max3f(b, s1[r + 2], s1[r + 3]); }
    float m; asm("v_max_f32_e32 %0, %1, %2" : "=v"(m) : "v"(a), "v"(b));
    const float o = __shfl_xor(m, 32); float r; asm("v_max_f32_e32 %0, %1, %2" : "=v"(r) : "v"(m), "v"(o)); return r;
}
__device__ __forceinline__ bool sm_tile(f32x16& s0, f32x16& s1, float& mref, float& thr, float& l, f32x16& o0, f32x16& o1) {
    const float mx = rowmax32(s0, s1);
    bool ch = false;
    if (__any(mx > thr)) {
        const bool up = mx > thr; const float d = up ? mx : 0.f; const float alpha = (thr > 0.f) ? __builtin_amdgcn_exp2f(-d) : 1.f;
        mref += d; thr = up ? 8.f : thr; l *= alpha;
#pragma unroll
        for (int r = 0; r < 16; ++r) { o0[r] *= alpha; o1[r] *= alpha; s0[r] -= d; s1[r] -= d; }
        ch = true;
    }
#pragma unroll
    for (int r = 0; r < 16; ++r) { s0[r] = __builtin_amdgcn_exp2f(s0[r]); s1[r] = __builtin_amdgcn_exp2f(s1[r]); }
    float a0 = s0[0] + s1[0], a1 = s0[1] + s1[1], a2 = s0[2] + s1[2], a3 = s0[3] + s1[3];
#pragma unroll
    for (int r = 4; r < 16; r += 4) { a0 += s0[r] + s1[r]; a1 += s0[r + 1] + s1[r + 1]; a2 += s0[r + 2] + s1[r + 2]; a3 += s0[r + 3] + s1[r + 3]; }
    l += (a0 + a1) + (a2 + a3);
    return ch;
}
__device__ __forceinline__ bool sm_max(f32x16& s0, f32x16& s1, float& mref, float& thr, float& l, f32x16& o0, f32x16& o1) {
    const float mx = rowmax32(s0, s1);
    if (__any(mx > thr)) {
        const bool up = mx > thr; const float d = up ? mx : 0.f; const float alpha = (thr > 0.f) ? __builtin_amdgcn_exp2f(-d) : 1.f;
        mref += d; thr = up ? 8.f : thr; l *= alpha;
#pragma unroll
        for (int r = 0; r < 16; ++r) { o0[r] *= alpha; o1[r] *= alpha; s0[r] -= d; s1[r] -= d; }
        return true;
    }
    return false;
}
__device__ __forceinline__ void sm_exp(f32x16& s0, f32x16& s1, float& l) {
#pragma unroll
    for (int r = 0; r < 16; ++r) { s0[r] = __builtin_amdgcn_exp2f(s0[r]); s1[r] = __builtin_amdgcn_exp2f(s1[r]); }
    float a0 = s0[0] + s1[0], a1 = s0[1] + s1[1], a2 = s0[2] + s1[2], a3 = s0[3] + s1[3];
#pragma unroll
    for (int r = 4; r < 16; r += 4) { a0 += s0[r] + s1[r]; a1 += s0[r + 1] + s1[r + 1]; a2 += s0[r + 2] + s1[r + 2]; a3 += s0[r + 3] + s1[r + 3]; }
    l += (a0 + a1) + (a2 + a3);
}
template <int ND0> __device__ __forceinline__ void tile_pipe(f32x16& s0, f32x16& s1, f32x16& n0, f32x16& n1, float& l, const LAS char* Kn, int pitch,
                                                             const bf16x8* qr, const f32x16& cinit, int r32, int hi) {
    constexpr int NG = 2 * ND0, EPG = (32 + NG - 1) / NG;
    bf16x8 kf[NG];
    const LAS char* kb = Kn + r32 * pitch + hi * 16;
#pragma unroll
    for (int i = 0; i < NG; ++i) kf[i] = *(const LAS bf16x8*)(kb + (i / ND0) * 32 * pitch + (i % ND0) * 32);
    float sum = 0.f;
    __builtin_amdgcn_sched_barrier(0);
#pragma unroll
    for (int g = 0; g < NG; ++g) {
        if (g == 0) n0 = __builtin_amdgcn_mfma_f32_32x32x16_bf16(kf[g], qr[g], cinit, 0, 0, 0);
        else if (g < ND0) n0 = __builtin_amdgcn_mfma_f32_32x32x16_bf16(kf[g], qr[g], n0, 0, 0, 0);
        else if (g == ND0) n1 = __builtin_amdgcn_mfma_f32_32x32x16_bf16(kf[g], qr[g - ND0], cinit, 0, 0, 0);
        else n1 = __builtin_amdgcn_mfma_f32_32x32x16_bf16(kf[g], qr[g - ND0], n1, 0, 0, 0);
#pragma unroll
        for (int e = g * EPG; e < (g + 1) * EPG && e < 32; ++e) {
            if (e < 16) s0[e] = __builtin_amdgcn_exp2f(s0[e]); else s1[e - 16] = __builtin_amdgcn_exp2f(s1[e - 16]);
        }
        __builtin_amdgcn_sched_barrier(0);
    }
    {
        float a0 = s0[0] + s1[0], a1 = s0[1] + s1[1], a2 = s0[2] + s1[2], a3 = s0[3] + s1[3];
#pragma unroll
        for (int r = 4; r < 16; r += 4) { a0 += s0[r] + s1[r]; a1 += s0[r + 1] + s1[r + 1]; a2 += s0[r + 2] + s1[r + 2]; a3 += s0[r + 3] + s1[r + 3]; }
        sum = (a0 + a1) + (a2 + a3);
    }
    l += sum;
}
__device__ __forceinline__ void zero16(f32x16& a) {
#pragma unroll
    for (int r = 0; r < 16; ++r) a[r] = 0.f;
}

__device__ __forceinline__ void store_o_row(bf16* rowbase  , const f32x16& o0, const f32x16& o1, float sc, int hi) {
    u32x2 g[8];
#pragma unroll
    for (int k = 0; k < 8; ++k) { const int a = k & 3;
        if (k < 4) { g[k].x = cvtpk(o0[4 * a] * sc, o0[4 * a + 1] * sc); g[k].y = cvtpk(o0[4 * a + 2] * sc, o0[4 * a + 3] * sc); }
        else { g[k].x = cvtpk(o1[4 * a] * sc, o1[4 * a + 1] * sc); g[k].y = cvtpk(o1[4 * a + 2] * sc, o1[4 * a + 3] * sc); } }
#pragma unroll
    for (int k = 0; k < 8; k += 2) {
        const auto rx = __builtin_amdgcn_permlane32_swap(g[k].x, g[k + 1].x, false, false);
        const auto ry = __builtin_amdgcn_permlane32_swap(g[k].y, g[k + 1].y, false, false);
        u32x4 w; w.x = rx[0]; w.y = ry[0]; w.z = rx[1]; w.w = ry[1];
        *(u32x4*)(rowbase + 8 * k + 8 * hi) = w;
    }
}
__device__ __forceinline__ void mla_unit(int b, int h, int qb, const bf16* QM, const bf16* KM, const bf16* KR, const bf16* VTM, bf16* YM, const float* RT, LAS char* lds, const int wid, const int lane_unused) {
    const int lane = mk_lane();
    const int tid = wid * 64 + lane, r32 = lane & 31, hi = lane >> 5;
    const int q0 = qb * 256 + wid * 32, t = q0 + r32;
    const size_t rowq = (size_t)b * SEQ + t;
    bf16x8 qr[6];
#pragma unroll
    for (int d0 = 0; d0 < 6; ++d0) qr[d0] = *(const bf16x8*)(QM + rowq * 768 + h * 96 + d0 * 16 + hi * 8);
    {
        u32x4 a = __builtin_bit_cast(u32x4, qr[4]), bb = __builtin_bit_cast(u32x4, qr[5]);
        float x1[8] = {bflo(a.x), bfhi(a.x), bflo(a.y), bfhi(a.y), bflo(a.z), bfhi(a.z), bflo(a.w), bfhi(a.w)};
        float x2[8] = {bflo(bb.x), bfhi(bb.x), bflo(bb.y), bfhi(bb.y), bflo(bb.z), bfhi(bb.z), bflo(bb.w), bfhi(bb.w)};
        const unsigned ro = (unsigned)(t * 32 + 16 * hi);
#pragma unroll
        for (int e2 = 0; e2 < 4; ++e2) { const f32x4 cs4 = *(const f32x4*)(RT + (ro + 4u * (unsigned)e2));
            { const int e = 2 * e2; const float y1 = x1[e] * cs4.x - x2[e] * cs4.y, y2 = x1[e] * cs4.y + x2[e] * cs4.x; x1[e] = y1; x2[e] = y2; }
            { const int e = 2 * e2 + 1; const float y1 = x1[e] * cs4.z - x2[e] * cs4.w, y2 = x1[e] * cs4.w + x2[e] * cs4.z; x1[e] = y1; x2[e] = y2; } }
        a.x = cvtpk(x1[0], x1[1]); a.y = cvtpk(x1[2], x1[3]); a.z = cvtpk(x1[4], x1[5]); a.w = cvtpk(x1[6], x1[7]);
        bb.x = cvtpk(x2[0], x2[1]); bb.y = cvtpk(x2[2], x2[3]); bb.z = cvtpk(x2[4], x2[5]); bb.w = cvtpk(x2[6], x2[7]);
        qr[4] = __builtin_bit_cast(bf16x8, a); qr[5] = __builtin_bit_cast(bf16x8, bb);
    }
    float mref = 0.f, thr = -1e29f, l = 0.f; f32x16 o0, o1, cinit; zero16(o0); zero16(o1); zero16(cinit);
    const int NT = (qb + 1) * 4;
    const bf16* kbu = KM + (size_t)b * SEQ * 512 + h * 64; const bf16* rbu = KR + (size_t)b * SEQ * 32; const bf16* vbu = VTM + (size_t)(b * 8 + h) * 64 * SEQ;
    const unsigned koff = (unsigned)((tid >> 3) * 512 + (tid & 7) * 8), roff = (unsigned)(((tid & 255) >> 2) * 32 + (tid & 3) * 8), voff = (unsigned)((tid >> 3) * SEQ + (tid & 7) * 8);
    const int kdst = (tid >> 3) * 208 + (tid & 7) * 16, rdst = ((tid & 255) >> 2) * 208 + 128 + (tid & 3) * 16, vdst = (tid >> 3) * 136 + (tid & 7) * 16;
    u32x4 skA, srA, svA, skB, srB, svB;
#define MLA_LOAD(it, S) do { sk##S = *(const u32x4*)(kbu + (size_t)(it) * 64 * 512 + koff); if (tid < 256) sr##S = *(const u32x4*)(rbu + (size_t)(it) * 64 * 32 + roff); sv##S = *(const u32x4*)(vbu + (size_t)(it) * 64 + voff); } while (0)
#define MLA_STORE(buf, S) do { *(LAS u32x4*)(lds + L_KB + (buf) * KB_SZ + kdst) = sk##S; if (tid < 256) *(LAS u32x4*)(lds + L_KB + (buf) * KB_SZ + rdst) = sr##S; \
        LAS char* vp_ = lds + L_VB + (buf) * VB_SZ + vdst; u32x2 a_; a_.x = sv##S.x; a_.y = sv##S.y; *(LAS u32x2*)vp_ = a_; a_.x = sv##S.z; a_.y = sv##S.w; *(LAS u32x2*)(vp_ + 8) = a_; } while (0)
    srA = (u32x4){0u, 0u, 0u, 0u}; srB = srA;
    MLA_LOAD(0, A); MLA_LOAD(1, B); MLA_STORE(0, A); MLA_STORE(1, B);
    MLA_LOAD(2, A); MLA_LOAD(3, B); MLA_STORE(2, A);
    __syncthreads();
    const int wlast = (q0 + 31) >> 6;
    f32x16 sa0 = qk_sub<6>(lds + L_KB, 208, 0, qr, cinit, r32, hi), sa1 = qk_sub<6>(lds + L_KB, 208, 1, qr, cinit, r32, hi), sb0, sb1;
    const bool grpB = wid >= 4;
    if (grpB) __syncthreads();
#define MLA_ITER(it, LD, ST, C0, C1, N0, N1) do { \
        if ((it) + 4 < NT) MLA_LOAD((it) + 4, LD); \
        if ((it) <= wlast) { const int kv0 = (it) * 64; \
            if (kv0 + 63 > q0) { \
                _Pragma("unroll") for (int r = 0; r < 16; ++r) { const int kp = kv0 + crow(r, hi); if (kp > t) C0[r] = NEGF; if (kp + 32 > t) C1[r] = NEGF; } \
            } \
            if (sm_max(C0, C1, mref, thr, l, o0, o1)) fill16(cinit, -mref); \
            tile_pipe<6>(C0, C1, N0, N1, l, lds + L_KB + (((it) + 1) & 3) * KB_SZ, 208, qr, cinit, r32, hi); } \
        __syncthreads(); \
        if ((it) <= wlast) pv_tile(o0, o1, lds + L_VB + ((it) & 3) * VB_SZ, C0, C1, r32, hi); \
        if ((it) + 3 < NT) MLA_STORE(((it) + 3) & 3, ST); \
        __syncthreads(); } while (0)
    for (int it = 0; it < NT; it += 2) { MLA_ITER(it, A, B, sa0, sa1, sb0, sb1); MLA_ITER(it + 1, B, A, sb0, sb1, sa0, sa1); }
    if (!grpB) __syncthreads();
#undef MLA_ITER
#undef MLA_LOAD
#undef MLA_STORE
    l += __shfl_xor(l, 32);
    const float inv = 1.f / l;
    store_o_row(YM + rowq * 512 + h * 64, o0, o1, inv, hi);
}

__device__ __forceinline__ int next_set(unsigned long long u0, unsigned long long u1, int from) {
    if (from < 64) { const unsigned long long x = u0 >> from; if (x) return from + __builtin_ctzll(x); from = 64; }
    if (from < 128) { const unsigned long long x = u1 >> (from - 64); if (x) return from + __builtin_ctzll(x); }
    return 128;
}
__device__ __forceinline__ void nsa_unit(int b, int g, int tile, const bf16* QN  , bf16* YN  , const bf16* Z1, const bf16* KC, const bf16* VCT, const bf16* VTS, const bf16* VTW, LAS char* lds, const int wid, const int lane_unused) {
    const int lane = mk_lane();
    const int tid = wid * 64 + lane, r32 = lane & 31, hi = lane >> 5;
    const int t0 = tile * 64, cur = tile, tl = r32 >> 2, hh = r32 & 3, head = 4 * g + hh, tok = 8 * wid + tl, t = t0 + tok, bg = b * 2 + g;
    const size_t rowq = (size_t)b * SEQ + t;
    bf16x8 qr[4];
#pragma unroll
    for (int d0 = 0; d0 < 4; ++d0) qr[d0] = *(const bf16x8*)(QN + rowq * 512 + head * 64 + d0 * 16 + hi * 8);
    const float slope = __builtin_amdgcn_exp2f(-(float)(head + 1)) * 1.4426950408889634f;
    f32x16 czero; zero16(czero);
    const bf16* gz = Z1 + rowq * Z1P + 1184 + head * 3;
    const float g0 = sigmoidf(bf2f(gz[0])), g1 = sigmoidf(bf2f(gz[1])), g2 = sigmoidf(bf2f(gz[2]));
    LAS float* imp = (LAS float*)(lds + L_IMP);
    LAS unsigned* selm = (LAS unsigned*)(lds + L_SELM);
    LAS unsigned* wun = (LAS unsigned*)(lds + L_WUN);
    for (int i = lane; i < 8 * IMP_P; i += 64) imp[8 * wid * IMP_P + i] = 0.f;
    f32x16 out0, out1; zero16(out0); zero16(out1);
    const int krow = tid >> 3, kch = tid & 7;
    const int kdst = krow * 144 + kch * 16, vdst = krow * 136 + kch * 16;
    u32x4 sk, sv;
#define NSA_STORE(buf, withv) do { *(LAS u32x4*)(lds + L_KB + (buf) * KB_SZ + kdst) = sk; if (withv) { LAS char* vp_ = lds + L_VB + (buf) * VB_SZ + vdst; u32x2 a_; a_.x = sv.x; a_.y = sv.y; *(LAS u32x2*)vp_ = a_; a_.x = sv.z; a_.y = sv.w; *(LAS u32x2*)(vp_ + 8) = a_; } } while (0)
    u32x4 nk, nv;
#define NSA_STORE_N(buf) do { *(LAS u32x4*)(lds + L_KB + (buf) * KB_SZ + kdst) = nk; { LAS char* vp_ = lds + L_VB + (buf) * VB_SZ + vdst; u32x2 a_; a_.x = nv.x; a_.y = nv.y; *(LAS u32x2*)vp_ = a_; a_.x = nv.z; a_.y = nv.w; *(LAS u32x2*)(vp_ + 8) = a_; } } while (0)
    const bf16* s_ksrc = Z1 + ((size_t)b * SEQ + krow) * Z1P + 256 + g * 64 + kch * 8;
    const bf16* s_vsrc = VTS + ((size_t)(b * 128 + g * 64 + krow)) * SEQ + kch * 8;
    const bf16* w_ksrc = Z1 + ((size_t)b * SEQ + krow) * Z1P + 512 + g * 64 + kch * 8;
    const bf16* w_vsrc = VTW + ((size_t)(b * 128 + g * 64 + krow)) * SEQ + kch * 8;
    const int kt_first = (t0 >= 512) ? (t0 - 512) / 64 : 0, kt_last = t0 / 64;

    const int ncmp = t0 / 16 + 3, nct = (ncmp + 63) / 64;
    const bf16* kcsrc = KC + ((size_t)bg * 512 + krow) * 64 + kch * 8;
    const bf16* vcsrc = VCT + ((size_t)bg * 64 + krow) * 512 + kch * 8;
    float mc = NEGF, lc = 0.f;
    {
        sk = *(const u32x4*)kcsrc; nk = sk; nv = *(const u32x4*)vcsrc; NSA_STORE(0, false); __syncthreads();
        for (int it = 0; it < nct; ++it) {
            const bool more = it + 1 < nct;
            if (more) sk = *(const u32x4*)(kcsrc + (size_t)(it + 1) * 64 * 64);
            const LAS char* Kb = lds + L_KB + (it & 1) * KB_SZ;
            f32x16 s0, s1; qk_pair<4>(s0, s1, Kb, 144, qr, czero, r32, hi);
            float mx = NEGF;
#pragma unroll
            for (int r = 0; r < 16; ++r) { const int i0 = it * 64 + crow(r, hi); const int d0_ = t - (16 * i0 + 31), d1_ = d0_ - 512;
                s0[r] = d0_ >= 0 ? s0[r] - slope * (float)d0_ : NEGF; s1[r] = d1_ >= 0 ? s1[r] - slope * (float)d1_ : NEGF; mx = fmaxf(mx, fmaxf(s0[r], s1[r])); }
            mx = fmaxf(mx, __shfl_xor(mx, 32));
            const float mn = fmaxf(mc, mx), alpha = __builtin_amdgcn_exp2f(mc - mn); mc = mn;
            float sum = 0.f;
#pragma unroll
            for (int r = 0; r < 16; ++r) { sum += (s0[r] > -1e29f ? __builtin_amdgcn_exp2f(s0[r] - mn) : 0.f) + (s1[r] > -1e29f ? __builtin_amdgcn_exp2f(s1[r] - mn) : 0.f); }
            lc = lc * alpha + sum;
            if (more) NSA_STORE((it + 1) & 1, false);
            __syncthreads();
        }
        lc += __shfl_xor(lc, 32);
    }
    {
        const float invl = 1.f / fmaxf(lc, 1e-30f);
        f32x16 o0, o1; zero16(o0); zero16(o1);
        NSA_STORE_N(0); __syncthreads();
        nk = *(const u32x4*)s_ksrc; nv = *(const u32x4*)s_vsrc;
        for (int it = 0; it < nct; ++it) {
            const bool more = it + 1 < nct;
            if (more) { sk = *(const u32x4*)(kcsrc + (size_t)(it + 1) * 64 * 64); sv = *(const u32x4*)(vcsrc + (it + 1) * 64); }
            const LAS char* Kb = lds + L_KB + (it & 1) * KB_SZ; const LAS char* Vb = lds + L_VB + (it & 1) * VB_SZ;
            f32x16 s0, s1; qk_pair<4>(s0, s1, Kb, 144, qr, czero, r32, hi);
#pragma unroll
            for (int r = 0; r < 16; ++r) { const int i0 = it * 64 + crow(r, hi); const int d0_ = t - (16 * i0 + 31), d1_ = d0_ - 512;
                s0[r] = d0_ >= 0 ? __builtin_amdgcn_exp2f(s0[r] - slope * (float)d0_ - mc) * invl : 0.f; s1[r] = d1_ >= 0 ? __builtin_amdgcn_exp2f(s1[r] - slope * (float)d1_ - mc) * invl : 0.f; }
            pv_tile(o0, o1, Vb, s0, s1, r32, hi);
#pragma unroll
            for (int sub = 0; sub < 2; ++sub) {
                f32x16 ps = sub ? s1 : s0;
#pragma unroll
                for (int r = 0; r < 16; ++r) {
                    ps[r] += __builtin_bit_cast(float, __builtin_amdgcn_update_dpp(0, __builtin_bit_cast(int, ps[r]), 0xB1, 0xF, 0xF, true));
                    ps[r] += __builtin_bit_cast(float, __builtin_amdgcn_update_dpp(0, __builtin_bit_cast(int, ps[r]), 0x4E, 0xF, 0xF, true)); }
                LAS float* row = imp + tok * IMP_P + (it * 64 + sub * 32) / 4 + hi;
                if (hh == 0) {
#pragma unroll
                    for (int a = 0; a < 4; ++a) row[2 * a] += (ps[4 * a] + ps[4 * a + 1]) + (ps[4 * a + 2] + 0.5f * ps[4 * a + 3]);
                }
                LDS_WAIT();
                if (hh == 0) {
#pragma unroll
                    for (int a = 0; a < 4; ++a) row[2 * a + 1] += 0.5f * ps[4 * a + 3];
                }
                LDS_WAIT();
            }
            if (more) NSA_STORE((it + 1) & 1, true);
            __syncthreads();
        }
#pragma unroll
        for (int r = 0; r < 16; ++r) { out0[r] += g0 * o0[r]; out1[r] += g0 * o1[r]; }
    }
    {
        const int nlast = cur - 2;
#pragma unroll 1
        for (int tk0 = 0; tk0 < 8; tk0 += 4) {
            const int j0 = lane, j1 = lane + 64;
            const bool val0 = j0 >= 1 && j0 <= nlast, val1 = j1 <= nlast;
            unsigned k0[4], k1[4]; bool s0[4], s1[4];
#pragma unroll
            for (int q = 0; q < 4; ++q) { const LAS float* row = imp + (8 * wid + tk0 + q) * IMP_P;
                k0[q] = __builtin_bit_cast(unsigned, row[j0]); k1[q] = __builtin_bit_cast(unsigned, row[j1]); s0[q] = val0; s1[q] = val1; }
            if (nlast > 13) {
                unsigned T0 = 0u, T1 = 0u, T2 = 0u, T3 = 0u;
#pragma unroll 1
                for (int bit = 30; bit >= 0; --bit) {
                    const unsigned bm = 1u << bit;
                    { const unsigned tr = T0 | bm; const int cnt = __popcll(__ballot(val0 && k0[0] >= tr)) + __popcll(__ballot(val1 && k1[0] >= tr)); if (cnt >= 13) T0 = tr; }
                    { const unsigned tr = T1 | bm; const int cnt = __popcll(__ballot(val0 && k0[1] >= tr)) + __popcll(__ballot(val1 && k1[1] >= tr)); if (cnt >= 13) T1 = tr; }
                    { const unsigned tr = T2 | bm; const int cnt = __popcll(__ballot(val0 && k0[2] >= tr)) + __popcll(__ballot(val1 && k1[2] >= tr)); if (cnt >= 13) T2 = tr; }
                    { const unsigned tr = T3 | bm; const int cnt = __popcll(__ballot(val0 && k0[3] >= tr)) + __popcll(__ballot(val1 && k1[3] >= tr)); if (cnt >= 13) T3 = tr; }
                }
                const unsigned long long below = (1ull << lane) - 1ull;
#pragma unroll
                for (int q = 0; q < 4; ++q) { const unsigned T = q == 0 ? T0 : q == 1 ? T1 : q == 2 ? T2 : T3;
                    const bool gt0 = val0 && k0[q] > T, gt1 = val1 && k1[q] > T, eq0 = val0 && k0[q] == T, eq1 = val1 && k1[q] == T;
                    const int need = 13 - (__popcll(__ballot(gt0)) + __popcll(__ballot(gt1)));
                    const unsigned long long e0 = __ballot(eq0), e1 = __ballot(eq1);
                    const int r0 = __popcll(e0 & below), r1 = __popcll(e0) + __popcll(e1 & below);
                    s0[q] = gt0 || (eq0 && r0 < need); s1[q] = gt1 || (eq1 && r1 < need); }
            }
#pragma unroll
            for (int q = 0; q < 4; ++q) {
                unsigned long long m0 = __ballot(s0[q]), m1 = __ballot(s1[q]);
                m0 |= 1ull;
                if (cur < 64) m0 |= 1ull << cur; else m1 |= 1ull << (cur - 64);
                if (cur >= 1) { if (cur - 1 < 64) m0 |= 1ull << (cur - 1); else m1 |= 1ull << (cur - 65); }
                const int tk = tk0 + q;
                if (lane == 0) { selm[(8 * wid + tk) * 4 + 0] = (unsigned)m0; selm[(8 * wid + tk) * 4 + 1] = (unsigned)(m0 >> 32); selm[(8 * wid + tk) * 4 + 2] = (unsigned)m1; selm[(8 * wid + tk) * 4 + 3] = (unsigned)(m1 >> 32); }
            }
        }
        LDS_WAIT();
        if (lane < 4) { unsigned x = 0; for (int tk = 0; tk < 8; ++tk) x |= selm[(8 * wid + tk) * 4 + lane]; wun[wid * 4 + lane] = x; }
        __syncthreads();
    }
    const unsigned long long tm0 = (unsigned long long)selm[tok * 4 + 0] | ((unsigned long long)selm[tok * 4 + 1] << 32), tm1 = (unsigned long long)selm[tok * 4 + 2] | ((unsigned long long)selm[tok * 4 + 3] << 32);
    unsigned long long wu0, wu1, gu0 = 0, gu1 = 0;
    {
        const unsigned a0 = __builtin_amdgcn_readfirstlane(wun[wid * 4 + 0]), a1 = __builtin_amdgcn_readfirstlane(wun[wid * 4 + 1]), a2 = __builtin_amdgcn_readfirstlane(wun[wid * 4 + 2]), a3 = __builtin_amdgcn_readfirstlane(wun[wid * 4 + 3]);
        wu0 = (unsigned long long)a0 | ((unsigned long long)a1 << 32); wu1 = (unsigned long long)a2 | ((unsigned long long)a3 << 32);
        for (int w = 0; w < 8; ++w) {
            const unsigned b0 = __builtin_amdgcn_readfirstlane(wun[w * 4 + 0]), b1 = __builtin_amdgcn_readfirstlane(wun[w * 4 + 1]), b2 = __builtin_amdgcn_readfirstlane(wun[w * 4 + 2]), b3 = __builtin_amdgcn_readfirstlane(wun[w * 4 + 3]);
            gu0 |= (unsigned long long)b0 | ((unsigned long long)b1 << 32); gu1 |= (unsigned long long)b2 | ((unsigned long long)b3 << 32);
        }
    }
    {
        const bf16* ksrc = s_ksrc; const bf16* vsrc = s_vsrc;
        float mref = 0.f, thr = -1e29f, l = 0.f; f32x16 o0, o1; zero16(o0); zero16(o1);
        const float sl4 = slope * (float)(4 * hi);
        int j = 0;
        NSA_STORE_N(0); __syncthreads();
        nk = *(const u32x4*)(w_ksrc + (size_t)kt_first * 64 * Z1P); nv = *(const u32x4*)(w_vsrc + kt_first * 64);
        int par = 0;
        while (j < 128) {
            const int nj = next_set(gu0, gu1, j + 1);
            const bool more = nj < 128;
            if (more) { sk = *(const u32x4*)(ksrc + (size_t)nj * 64 * Z1P); sv = *(const u32x4*)(vsrc + nj * 64); }
            const bool wsel = ((j < 64 ? (wu0 >> j) : (wu1 >> (j - 64))) & 1ull) != 0;
            if (wsel) {
                const LAS char* Kb = lds + L_KB + par * KB_SZ; const LAS char* Vb = lds + L_VB + par * VB_SZ;
                const bool tsel = ((j < 64 ? (tm0 >> j) : (tm1 >> (j - 64))) & 1ull) != 0;
                f32x16 cin; fill16(cin, tsel ? (sl4 - mref - slope * (float)(t - j * 64)) : NEGF);
                f32x16 s0, s1; qk_pair<4>(s0, s1, Kb, 144, qr, cin, r32, hi);
#pragma unroll
                for (int r = 0; r < 16; ++r) { s0[r] = __builtin_fmaf(slope, (float)((r & 3) + 8 * (r >> 2)), s0[r]); s1[r] = __builtin_fmaf(slope, (float)((r & 3) + 8 * (r >> 2) + 32), s1[r]); }
                if (j == cur) {
#pragma unroll
                    for (int r = 0; r < 16; ++r) { const int d0_ = t - (j * 64 + crow(r, hi)); if (d0_ < 0) s0[r] = NEGF; if (d0_ < 32) s1[r] = NEGF; }
                }
                sm_tile(s0, s1, mref, thr, l, o0, o1);
                pv_tile(o0, o1, Vb, s0, s1, r32, hi);
            }
            if (more) NSA_STORE(par ^ 1, true);
            __syncthreads();
            par ^= 1; j = nj;
        }
        l += __shfl_xor(l, 32);
        const float sc = g1 / fmaxf(l, 1e-30f);
#pragma unroll
        for (int r = 0; r < 16; ++r) { out0[r] += sc * o0[r]; out1[r] += sc * o1[r]; }
    }
    {
        const bf16* ksrc = w_ksrc; const bf16* vsrc = w_vsrc;
        float mref = 0.f, thr = -1e29f, l = 0.f; f32x16 o0, o1; zero16(o0); zero16(o1);
        const float sl4 = slope * (float)(4 * hi);
        const int tw0 = t0 + 8 * wid;
        NSA_STORE_N(0); __syncthreads();
        int par = 0;
        for (int kt = kt_first; kt <= kt_last; ++kt) {
            const bool more = kt < kt_last;
            if (more) { sk = *(const u32x4*)(ksrc + (size_t)(kt + 1) * 64 * Z1P); sv = *(const u32x4*)(vsrc + (kt + 1) * 64); }
            const LAS char* Kb = lds + L_KB + par * KB_SZ; const LAS char* Vb = lds + L_VB + par * VB_SZ;
            f32x16 cin; fill16(cin, sl4 - mref - slope * (float)(t - kt * 64));
            f32x16 s0, s1; qk_pair<4>(s0, s1, Kb, 144, qr, cin, r32, hi);
#pragma unroll
            for (int r = 0; r < 16; ++r) { s0[r] = __builtin_fmaf(slope, (float)((r & 3) + 8 * (r >> 2)), s0[r]); s1[r] = __builtin_fmaf(slope, (float)((r & 3) + 8 * (r >> 2) + 32), s1[r]); }
            if (kt * 64 + 63 > tw0 || kt * 64 < tw0 + 7 - 511) {
#pragma unroll
                for (int r = 0; r < 16; ++r) { const int d0_ = t - (kt * 64 + crow(r, hi)), d1_ = d0_ - 32;
                    if (!(d0_ >= 0 && d0_ < 512)) s0[r] = NEGF; if (!(d1_ >= 0 && d1_ < 512)) s1[r] = NEGF; }
            }
            sm_tile(s0, s1, mref, thr, l, o0, o1);
            pv_tile(o0, o1, Vb, s0, s1, r32, hi);
            if (more) NSA_STORE(par ^ 1, true);
            __syncthreads();
            par ^= 1;
        }
        l += __shfl_xor(l, 32);
        const float sc = g2 / fmaxf(l, 1e-30f);
#pragma unroll
        for (int r = 0; r < 16; ++r) { out0[r] += sc * o0[r]; out1[r] += sc * o1[r]; }
    }
#undef NSA_STORE
#undef NSA_STORE_N
    store_o_row(YN + rowq * 512 + head * 64, out0, out1, 1.f, hi);
}

struct Args { const float* in[27]; float* out; unsigned char* ws; int ph_lo, ph_hi; };
enum { I_X = 0, I_F1PRE, I_F1POST, I_F1G, I_F1U, I_F1D, I_MPRE, I_MPOST, I_WIN, I_CPK, I_CW1K, I_CW2K, I_CPV, I_CW1V, I_CW2V, I_QNG, I_WUQ, I_KVNG, I_WUKV, I_WPN, I_WPM, I_WOUT, I_F2PRE, I_F2POST, I_F2G, I_F2U, I_F2D };

__global__ void __launch_bounds__(NWAVES * 64, 2) fwd_kernel(Args args) {
    extern __shared__ __attribute__((aligned(16))) unsigned char lds_raw[];
    LAS unsigned char* lds = (LAS unsigned char*)lds_raw;
    const int wave = __builtin_amdgcn_readfirstlane((int)threadIdx.x >> 6);
    const int G = gridDim.x, c = blockIdx.x;
    const int NGW = G * NWAVES, NGT = G * NWAVES * 64;
#define IDS() const int lane = mk_lane(); const int tid = wave * 64 + lane; const int gw = c * NWAVES + wave; const int gt = c * (NWAVES * 64) + tid; (void)tid; (void)gw; (void)gt
#define WGU1 ((bf16*)(args.ws + O_WGU1))
#define WD1 ((bf16*)(args.ws + O_WD1))
#define WGU2 ((bf16*)(args.ws + O_WGU2))
#define WD2 ((bf16*)(args.ws + O_WD2))
#define WIN ((bf16*)(args.ws + O_WIN))
#define WPN ((bf16*)(args.ws + O_WPN))
#define WPM ((bf16*)(args.ws + O_WPM))
#define WOUT ((bf16*)(args.ws + O_WOUT))
#define WUQ ((bf16*)(args.ws + O_WUQ))
#define WUKV ((bf16*)(args.ws + O_WUKV))
#define CW1K ((bf16*)(args.ws + O_CW1K))
#define CW1V ((bf16*)(args.ws + O_CW1V))
#define A1 ((bf16*)(args.ws + O_A1))
#define IM2K ((bf16*)(args.ws + O_IM2K))
#define IM2V ((bf16*)(args.ws + O_IM2V))
#define CQN ((bf16*)(args.ws + O_CQN))
#define CKVN ((bf16*)(args.ws + O_CKVN))
#define KR ((bf16*)(args.ws + O_KR))
#define HK ((bf16*)(args.ws + O_HK))
#define HV ((bf16*)(args.ws + O_HV))
#define KC ((bf16*)(args.ws + O_KC))
#define VCT ((bf16*)(args.ws + O_VCT))
#define MG ((bf16*)(args.ws + O_MG))
#define H ((bf16*)(args.ws + O_H))
#define Z1 ((bf16*)(args.ws + O_Z1))
#define QN ((bf16*)(args.ws + O_QN))
#define YM ((bf16*)(args.ws + O_YM))
#define KM ((bf16*)(args.ws + O_KM))
#define GM ((bf16*)(args.ws + O_GM))
#define QM ((bf16*)(args.ws + O_QM))
#define VTM ((bf16*)(args.ws + O_VTM))
#define VTS ((bf16*)(args.ws + O_VTS))
#define VTW ((bf16*)(args.ws + O_VTW))
#define F ((bf16*)(args.ws + O_F))
#define X (args.out)
#define X1B ((bf16*)args.out)
#define X2B ((bf16*)(args.ws + O_X2B))
    typedef const float* cfp_t;
    const __attribute__((address_space(4))) cfp_t* in = (const __attribute__((address_space(4))) cfp_t*)__builtin_amdgcn_kernarg_segment_ptr();
    asm volatile("" : "+s"(in));
    const int lo = args.ph_lo, hi_ph = args.ph_hi;
#define IN(k) (lo <= (k) && (k) < hi_ph)
#if MK_PER_PHASE
#define SEAM(k) do { } while (0)
#else
    if (lo == 0 && hi_ph == NPHASE) {
        if (c == 0) { unsigned* ctl = (unsigned*)(args.ws + O_CTL); for (int i = (int)threadIdx.x; i < 4096; i += NWAVES * 64) __hip_atomic_store(ctl + i, 0u, __ATOMIC_RELAXED, __HIP_MEMORY_SCOPE_AGENT); }
        cg::grid_group grid = cg::this_grid(); grid.sync();
    }
    volatile LAS unsigned* xst = (volatile LAS unsigned*)(lds + 131072 + 512);
    XcdBarrier xbar;
    { const int l_ = mk_lane(); const int t_ = wave * 64 + l_; if (t_ < 2) xst[t_] = 0u; __syncthreads(); xbar = xcd_barrier_post((unsigned*)(args.ws + O_CTL), xst, t_); }
#ifdef DIAG_TS
    unsigned long long* const tsw = (unsigned long long*)(args.ws + O_CTL + 15000);
    if (c == 0 && wave == 0 && mk_lane() == 0) tsw[0] = __builtin_amdgcn_s_memrealtime();
#define SEAM(k) do { if (IN(k) && IN((k) + 1)) { const int l_ = mk_lane(); xcd_barrier(xbar, wave * 64 + l_); if (c == 0 && wave == 0 && l_ == 0) tsw[(k) + 1] = __builtin_amdgcn_s_memrealtime(); } } while (0)
#else
#define SEAM(k) do { if (IN(k) && IN((k) + 1)) { const int l_ = mk_lane(); xcd_barrier(xbar, wave * 64 + l_); } } while (0)
#endif
#endif
#define GEMM_CALL(EPI, A_, B_, M_, N_, K_, cc, E_) do { Gemm g_{(const pg8::bf16_t*)(A_), (const pg8::bf16_t*)(B_), (M_), (N_), (K_)}; StaticOrder S_; S_.init((M_), (N_), G, (cc)); \
        const int l_ = mk_lane(); pg8::gemm_phase<EPI, StaticOrder, true, PG8_SP2>(lds, g_, S_, (E_), wave, l_); } while (0)

    if (IN(0)) {
        IDS();
        LAS float* scr = (LAS float*)(lds + wave * 16384);
        transpose_mat(in[I_F1G], DFF, MapGU{0}, 1024, DFF, WGU1, scr, gw, NGW, lane);
        transpose_mat(in[I_F1U], DFF, MapGU{1}, 1024, DFF, WGU1, scr, gw, NGW, lane);
        transpose_mat(in[I_F1D], 1024, MapPlain{}, 2816, 1024, WD1, scr, gw, NGW, lane);
        transpose_mat(in[I_WIN], 3768, MapWin{}, 1024, 3840, WIN, scr, gw, NGW, lane);
        transpose_mat(in[I_WUQ], 768, MapPlain{}, 256, 768, WUQ, scr, gw, NGW, lane);
        transpose_mat(in[I_WUKV], 1024, MapUkv{}, 128, 1024, WUKV, scr, gw, NGW, lane);
        transpose_mat(in[I_CW1K], 256, MapPlain{}, 2048, 256, CW1K, scr, gw, NGW, lane);
        transpose_mat(in[I_CW1V], 256, MapPlain{}, 2048, 256, CW1V, scr, gw, NGW, lane);
        f32x4 gpre[4]; load_gain(gpre, in[I_F1PRE], lane);
        for (int m = gw; m < MTOK; m += 4 * NGW) {
            f32x4 v[4][4];
#pragma unroll
            for (int q = 0; q < 4; ++q) { const int mq = m + q * NGW; if (mq < MTOK) { const float* xr = in[I_X] + (size_t)mq * DM + 8 * lane;
#pragma unroll
                for (int j = 0; j < 2; ++j) { v[q][2 * j] = *(const f32x4*)(xr + 512 * j); v[q][2 * j + 1] = *(const f32x4*)(xr + 512 * j + 4); } } }
#pragma unroll
            for (int q = 0; q < 4; ++q) { const int mq = m + q * NGW; if (mq < MTOK) rms_row_to_bf16(v[q], gpre, A1 + (size_t)mq * DM, lane); }
        }
        __syncthreads();
    }
    SEAM(0);
    if (IN(1)) GEMM_CALL(EpiSwiglu, A1, WGU1, MTOK, 5632, 1024, c, (EpiSwiglu{H}));
    SEAM(1);
#ifdef PROBE_FFN2
    if (IN(2)) GEMM_CALL(EpiF32, H, WD1, MTOK, 1024, 2816, c, (EpiF32{F, DM}));
    if (IN(1)) GEMM_CALL(EpiSwiglu, A1, WGU1, MTOK, 5632, 1024, c, (EpiSwiglu{H}));
#endif
    if (IN(2)) GEMM_CALL(EpiF32, H, WD1, MTOK, 1024, 2816, c, (EpiF32{F, DM}));
    SEAM(2);
    if (IN(3)) { IDS(); rowop<false, true, true>(F, in[I_X], 0.5f, in[I_F1POST], X1B, in[I_MPRE], A1, gw, NGW, lane); }
    SEAM(3);
    if (IN(4)) GEMM_CALL(EpiWin, A1, WIN, MTOK, 3840, 1024, c, (EpiWin{QN, Z1, GM, VTS, VTW}));
    SEAM(4);
    if (IN(5)) {
        IDS();
        for (int ch0 = gt; ch0 < 2 * 4096 * 256; ch0 += 8 * NGT) {
            u32x4 z[8]; f32x4 p0[8], p1[8];
#pragma unroll
            for (int q = 0; q < 8; ++q) { const int ch = ch0 + q * NGT; z[q] = (u32x4){0u, 0u, 0u, 0u};
                if (ch < 2 * 4096 * 256) { const int kv = ch >> 20, r = (ch >> 8) & 4095, c8 = ch & 255, l = c8 >> 3, d0 = (c8 & 7) * 8, bgi = r >> 9, i = r & 511, b = bgi >> 1, g = bgi & 1;
                    if (i < 511) { z[q] = *(const u32x4*)(Z1 + ((size_t)b * SEQ + 16 * i + l) * Z1P + kv * 128 + g * 64 + d0);
                        const float* pe = (kv ? in[I_CPV] : in[I_CPK]) + l * 64 + d0; p0[q] = *(const f32x4*)pe; p1[q] = *(const f32x4*)(pe + 4); } } }
#pragma unroll
            for (int q = 0; q < 8; ++q) { const int ch = ch0 + q * NGT;
                if (ch < 2 * 4096 * 256) { const int kv = ch >> 20, r = (ch >> 8) & 4095, c8 = ch & 255, i = r & 511;
                    u32x4 o = (u32x4){0u, 0u, 0u, 0u};
                    if (i < 511) { const u32x4 zz = z[q]; const f32x4 a = p0[q], bb = p1[q];
                        o.x = cvtpk(bflo(zz.x) + a.x, bfhi(zz.x) + a.y); o.y = cvtpk(bflo(zz.y) + a.z, bfhi(zz.y) + a.w); o.z = cvtpk(bflo(zz.z) + bb.x, bfhi(zz.z) + bb.y); o.w = cvtpk(bflo(zz.w) + bb.z, bfhi(zz.w) + bb.w); }
                    *(u32x4*)((kv ? IM2V : IM2K) + (size_t)r * 2048 + c8 * 8) = o; } }
        }
        if (gt < SEQ * 16) { float cs, sn; rope_cs(gt >> 4, gt & 15, cs, sn); ((float*)(args.ws + O_ROPE))[2 * gt] = cs; ((float*)(args.ws + O_ROPE))[2 * gt + 1] = sn; }
        for (int m0 = gw; m0 < MTOK; m0 += 4 * NGW) {
            u32x2 wq[4]; unsigned wk[4]; float x1[4], x2[4];
#pragma unroll
            for (int q = 0; q < 4; ++q) { const int m = m0 + q * NGW; if (m < MTOK) { const bf16* zr = Z1 + (size_t)m * Z1P;
                wq[q] = *(const u32x2*)(zr + 768 + 4 * lane); wk[q] = *(const unsigned*)(zr + 1024 + 2 * lane);
                x1[q] = bf2f(zr[1152 + (lane & 15)]); x2[q] = bf2f(zr[1152 + 16 + (lane & 15)]); } }
            const f32x4 gq = *(const f32x4*)(in[I_QNG] + 4 * lane); const float gk0 = in[I_KVNG][2 * lane], gk1 = in[I_KVNG][2 * lane + 1];
#pragma unroll
            for (int q = 0; q < 4; ++q) { const int m = m0 + q * NGW; if (m < MTOK) {
                { const u32x2 w = wq[q]; const float a0 = bflo(w.x), a1 = bfhi(w.x), a2 = bflo(w.y), a3 = bfhi(w.y);
                  const float r = rsqrtf(wave_sum((a0 * a0 + a1 * a1) + (a2 * a2 + a3 * a3)) * (1.f / 256.f) + EPS);
                  u32x2 o; o.x = cvtpk(a0 * r * gq.x, a1 * r * gq.y); o.y = cvtpk(a2 * r * gq.z, a3 * r * gq.w); *(u32x2*)(CQN + (size_t)m * 256 + 4 * lane) = o; }
                { const unsigned w = wk[q]; const float a0 = bflo(w), a1 = bfhi(w);
                  const float r = rsqrtf(wave_sum(a0 * a0 + a1 * a1) * (1.f / 128.f) + EPS);
                  *(unsigned*)(CKVN + (size_t)m * 128 + 2 * lane) = cvtpk(a0 * r * gk0, a1 * r * gk1); }
                if (lane < 16) { float cs, sn; rope_cs(m & 8191, lane, cs, sn);
                  KR[(size_t)m * 32 + lane] = f2bf(x1[q] * cs - x2[q] * sn); KR[(size_t)m * 32 + 16 + lane] = f2bf(x1[q] * sn + x2[q] * cs); } } }
        }
    }
    SEAM(5);
    if (IN(6)) {
        GEMM_CALL(EpiGelu, IM2K, CW1K, 4096, 256, 2048, c, (EpiGelu{HK, 256}));
        GEMM_CALL(EpiGelu, IM2V, CW1V, 4096, 256, 2048, (c + G / 2) % G, (EpiGelu{HV, 256}));
        {
            const bool small = G < 64, busy = !small && (c < 16 || ((c + G - G / 2) % G) < 16);
            if (!busy) {
                const int cr = small ? c : (c < G / 2 ? c - 16 : c - 32), GF = small ? G : G - 32;
                { const int l_ = mk_lane(); Gemm g_{(const pg8::bf16_t*)CQN, (const pg8::bf16_t*)WUQ, MTOK, 768, 256}; StaticOrder S_; S_.init(MTOK, 768, GF, cr); pg8::gemm_phase<EpiQup, StaticOrder, true, PG8_SP2>(lds, g_, S_, (EpiQup{QM}), wave, l_); }
                { const int l_ = mk_lane(); Gemm g_{(const pg8::bf16_t*)CKVN, (const pg8::bf16_t*)WUKV, MTOK, 1024, 128}; StaticOrder S_; S_.init(MTOK, 1024, GF, cr); pg8::gemm_phase<EpiKVup, StaticOrder, true, PG8_SP2>(lds, g_, S_, (EpiKVup{KM, VTM}), wave, l_); }
                IDS();
                const int gwf = cr * NWAVES + wave, NGWF = GF * NWAVES;
                LAS float* scr = (LAS float*)(lds + wave * 16384);
                transpose_mat(in[I_F2G], DFF, MapGU{0}, 1024, DFF, WGU2, scr, gwf, NGWF, lane);
                transpose_mat(in[I_F2U], DFF, MapGU{1}, 1024, DFF, WGU2, scr, gwf, NGWF, lane);
                transpose_mat(in[I_F2D], 1024, MapPlain{}, 2816, 1024, WD2, scr, gwf, NGWF, lane);
                transpose_mat(in[I_WPN], 1024, MapPlain{}, 512, 1024, WPN, scr, gwf, NGWF, lane);
                transpose_mat(in[I_WPM], 1024, MapPlain{}, 512, 1024, WPM, scr, gwf, NGWF, lane);
                transpose_mat(in[I_WOUT], 1024, MapPlain{}, 1024, 1024, WOUT, scr, gwf, NGWF, lane);
            }
        }
    }
    SEAM(6);
    if (IN(7)) {
        IDS();
        for (int pi = gt; pi < 2 * 2048 * 64; pi += NGT) {
            const int kv = pi >> 17, r = (pi >> 6) & 2047, d = pi & 63;
            const bf16* h0 = (kv ? HV : HK) + (size_t)r * 256; const bf16* h1 = h0 + (size_t)2048 * 256; const float* w2 = (kv ? in[I_CW2V] : in[I_CW2K]) + d;
            float acc0 = 0.f, acc1 = 0.f;
#pragma unroll 2
            for (int j8 = 0; j8 < 32; ++j8) { const u32x4 ha = *(const u32x4*)(h0 + j8 * 8), hb = *(const u32x4*)(h1 + j8 * 8); const float* wp = w2 + (size_t)j8 * 8 * 64;
                const float w0 = wp[0], w1 = wp[64], w2_ = wp[128], w3 = wp[192], w4 = wp[256], w5 = wp[320], w6 = wp[384], w7 = wp[448];
                acc0 += bflo(ha.x) * w0 + bfhi(ha.x) * w1 + bflo(ha.y) * w2_ + bfhi(ha.y) * w3 + bflo(ha.z) * w4 + bfhi(ha.z) * w5 + bflo(ha.w) * w6 + bfhi(ha.w) * w7;
                acc1 += bflo(hb.x) * w0 + bfhi(hb.x) * w1 + bflo(hb.y) * w2_ + bfhi(hb.y) * w3 + bflo(hb.z) * w4 + bfhi(hb.z) * w5 + bflo(hb.w) * w6 + bfhi(hb.w) * w7; }
            const int r1 = r + 2048;
            if (kv == 0) { KC[(size_t)r * 64 + d] = f2bf(acc0); KC[(size_t)r1 * 64 + d] = f2bf(acc1); }
            else { VCT[((size_t)(r >> 9) * 64 + d) * 512 + (r & 511)] = f2bf(acc0); VCT[((size_t)(r1 >> 9) * 64 + d) * 512 + (r1 & 511)] = f2bf(acc1); }
        }
    }
    SEAM(7);
    if (IN(8)) {
        IDS();
        LAS char* al = (LAS char*)lds;
#ifdef PROBE_NSA2
        for (int i = 0; i * G < 1024; ++i) { const int p = (i & 1) ? (G - 1 - c) : c, uu = i * G + p;
            if (uu < 1024) { const int tile = 127 - (uu >> 3), bgi = uu & 7; nsa_unit(bgi >> 1, bgi & 1, tile, QN, IM2K, Z1, KC, VCT, VTS, VTW, al, wave, lane); } }
#endif
        if (wave >= 4) __builtin_amdgcn_s_setprio(1);
        const int lane_n = mk_lane();
        {
            unsigned* const qctr = (unsigned*)(args.ws + O_CTL + 15360);
            volatile LAS unsigned* qw = (volatile LAS unsigned*)(lds + 131072 + 1024);
            unsigned mine = 0;
            if (wave == 0 && lane_n == 0) mine = __hip_atomic_fetch_add(qctr, 1u, __ATOMIC_RELAXED, __HIP_MEMORY_SCOPE_AGENT);
            for (;;) {
                if (wave == 0 && lane_n == 0) qw[0] = mine;
                __syncthreads();
                const unsigned k = qw[0];
                __syncthreads();
                if (k >= 2048u) break;
                if (wave == 0 && lane_n == 0) mine = __hip_atomic_fetch_add(qctr, 1u, __ATOMIC_RELAXED, __HIP_MEMORY_SCOPE_AGENT);
                if (k < 896u || k >= 1920u) { const unsigned k1 = (k < 896u) ? k : k - 1024u; const int qb = 31 - (int)(k1 >> 5), bh = (int)(k1 & 31u);
                    mla_unit(bh >> 3, bh & 7, qb, QM, KM, KR, VTM, YM, (const float*)(args.ws + O_ROPE), al, wave, lane_n); }
                else { const unsigned k2 = k - 896u; const int g = 1 - (int)(k2 >> 9), kk = (int)(k2 & 511u), tile = 127 - (kk >> 2), b = kk & 3;
                    nsa_unit(b, g, tile, QN, QN, Z1, KC, VCT, VTS, VTW, al, wave, lane_n); }
            }
        }
    }
    if (IN(8)) __builtin_amdgcn_s_setprio(0);
    SEAM(8);
    if (IN(9)) {
        GEMM_CALL(EpiProj<false>, QN, WPN, MTOK, 1024, 512, c, (EpiProj<false>{GM, MG}));
        GEMM_CALL(EpiProj<true>, YM, WPM, MTOK, 1024, 512, c, (EpiProj<true>{GM, MG}));
    }
    SEAM(9);
    if (IN(10)) GEMM_CALL(EpiF32, MG, WOUT, MTOK, 1024, 1024, c, (EpiF32{F, DM}));
    SEAM(10);
    if (IN(11)) { IDS(); rowop<true, true, true>(F, X1B, 1.0f, in[I_MPOST], X2B, in[I_F2PRE], A1, gw, NGW, lane); }
    SEAM(11);
    if (IN(12)) GEMM_CALL(EpiSwiglu, A1, WGU2, MTOK, 5632, 1024, c, (EpiSwiglu{H}));
    SEAM(12);
    if (IN(13)) GEMM_CALL(EpiF32, H, WD2, MTOK, 1024, 2816, c, (EpiF32{F, DM}));
    SEAM(13);
    if (IN(14)) { IDS(); rowop<true, false, false>(F, X2B, 0.5f, in[I_F2POST], X, nullptr, nullptr, gw, NGW, lane); }
#ifdef DIAG_TS
    { asm volatile("s_waitcnt vmcnt(0)" ::: "memory"); __syncthreads();
      if (c == 0 && wave == 0 && mk_lane() == 0) { const float da = (float)(tsw[DIAG_A + 1] - tsw[DIAG_A]) * 0.01f, db = (float)(tsw[DIAG_B + 1] - tsw[DIAG_B]) * 0.01f; X[0] += da; X[1] += db; } }
#endif
#undef IN
#undef IDS
#undef SEAM
#undef GEMM_CALL
#undef WGU1
#undef WD1
#undef WGU2
#undef WD2
#undef WIN
#undef WPN
#undef WPM
#undef WOUT
#undef WUQ
#undef WUKV
#undef CW1K
#undef CW1V
#undef A1
#undef IM2K
#undef IM2V
#undef CQN
#undef CKVN
#undef KR
#undef HK
#undef HV
#undef KC
#undef VCT
#undef MG
#undef H
#undef Z1
#undef QN
#undef YM
#undef KM
#undef GM
#undef QM
#undef VTM
#undef VTS
#undef VTW
#undef F
#undef X
#undef X1B
#undef X2B
}
}

extern "C" void kernel_launch(void* const* d_in, const int* in_sizes, int n_in, void* d_out, int out_size, void* d_ws, size_t ws_size, hipStream_t stream) {
    using namespace mk;
    static int grid = 0;
    if (grid == 0) {
        if (n_in != 27 || out_size != MTOK * DM || ws_size < O_END) { fprintf(stderr, "kernel_launch: unexpected problem (n_in %d out %d ws %zu)\n", n_in, out_size, ws_size); grid = -1; return; }
        int dev = 0, cus = 0, per_cu = 0;
        hipGetDevice(&dev); hipDeviceGetAttribute(&cus, hipDeviceAttributeMultiprocessorCount, dev);
        if (hipFuncSetAttribute((const void*)fwd_kernel, hipFuncAttributeMaxDynamicSharedMemorySize, LDS_BYTES) != hipSuccess) { fprintf(stderr, "kernel_launch: hipFuncSetAttribute failed\n"); grid = -1; return; }
        if (hipOccupancyMaxActiveBlocksPerMultiprocessor(&per_cu, (const void*)fwd_kernel, NWAVES * 64, LDS_BYTES) != hipSuccess || per_cu < 1) { fprintf(stderr, "kernel_launch: occupancy query says %d\n", per_cu); per_cu = 1; }
        (void)hipGetLastError();
        grid = cus * per_cu;
    }
    if (grid < 0) return;
#if MK_PER_PHASE
    if (hipMemsetAsync((char*)d_ws + O_CTL, 0, 16384, stream) != hipSuccess) { fprintf(stderr, "kernel_launch: memset failed\n"); return; }
#endif
    Args a{};
    for (int i = 0; i < 27; ++i) a.in[i] = (const float*)d_in[i];
    a.out = (float*)d_out; a.ws = (unsigned char*)d_ws;
#if MK_PER_PHASE
    for (int ph = 0; ph < NPHASE; ++ph) { a.ph_lo = ph; a.ph_hi = ph + 1; hipLaunchKernelGGL(fwd_kernel, dim3(grid), dim3(NWAVES * 64), LDS_BYTES, stream, a); }
#else
    a.ph_lo = 0; a.ph_hi = NPHASE;
    void* kargs[] = {&a};
    hipError_t e = hipLaunchCooperativeKernel((const void*)fwd_kernel, dim3(grid), dim3(NWAVES * 64), kargs, LDS_BYTES, stream);
    if (e != hipSuccess) fprintf(stderr, "cooperative launch failed: %s (grid %d)\n", hipGetErrorString(e), grid);
#endif
}
```
